# Optimizing an MI355X kernel written in HIP

```python
import jax, jax.numpy as jnp
from jax import lax
import numpy as np

D_MODEL = 2048
BATCH = 8
SEQ = 2048
DEPTH = 1

LRU_WIDTH = 2560
LRU_HEADS = 20
LRU_HEAD_DIM = LRU_WIDTH // LRU_HEADS
LRU_CONV = 4
LRU_CONV_LEFT = 2
LRU_C = 8.0
CONV_WIDTH = 2048
CONV_GROUPS = 16
SHORT_CONV = 3
SHORT_CONV_LEFT = 1
D_FF = 4 * D_MODEL
ALPHA = float((2 * DEPTH) ** 0.25)
BETA = float((8 * DEPTH) ** -0.25)
LN_EPS = 1e-5
SPLIT_SIZES = (LRU_WIDTH, CONV_WIDTH, CONV_WIDTH, CONV_WIDTH, D_MODEL, D_MODEL)
SPLIT_POINTS = tuple(int(v) for v in np.cumsum(SPLIT_SIZES)[:-1])
IN_COLS = int(sum(SPLIT_SIZES))

kernel_name = "hybrid_rglru_shortconv_deepnorm_block"


def layer_norm(x, g, b):
    xf = x.astype(jnp.float32)
    mu = jnp.mean(xf, axis=-1, keepdims=True)
    var = jnp.mean(jnp.square(xf - mu), axis=-1, keepdims=True)
    y = (xf - mu) * lax.rsqrt(var + LN_EPS)
    return (y * g.astype(jnp.float32) + b.astype(jnp.float32)).astype(x.dtype)


def centred_dwconv(u, w, b, left):
    k_w = w.shape[0]
    s = u.shape[1]
    up = jnp.pad(u, ((0, 0), (left, k_w - 1 - left), (0, 0)))
    return sum(up[:, k:k + s] * w[k] for k in range(k_w)) + b


def _lin_combine(left, right):
    a1, b1 = left
    a2, b2 = right
    return a1 * a2, a2 * b1 + b2


def rg_lru_direction(u, w_a, b_a, w_x, b_x, lam, reverse):
    bsz, s, _ = u.shape
    uh = u.reshape(bsz, s, LRU_HEADS, LRU_HEAD_DIM)
    r = jax.nn.sigmoid(jnp.einsum('bshd,hde->bshe', uh, w_a) + b_a).reshape(bsz, s, LRU_WIDTH)
    i = jax.nn.sigmoid(jnp.einsum('bshd,hde->bshe', uh, w_x) + b_x).reshape(bsz, s, LRU_WIDTH)
    log_a = -LRU_C * r.astype(jnp.float32) * jax.nn.softplus(-lam.astype(jnp.float32))
    a = jnp.exp(log_a)
    gated_x = jnp.sqrt(-jnp.expm1(2.0 * log_a)) * (i * u).astype(jnp.float32)
    _, h = lax.associative_scan(_lin_combine, (a, gated_x), reverse=reverse, axis=1)
    return h.astype(u.dtype)


def setup_inputs(seed: int = 0) -> dict:
    key = jax.random.key(seed)
    ks = jax.random.split(key, 24)
    f32 = jnp.float32
    nrm = lambda k, shape, scale: jax.random.normal(k, shape, f32) * scale
    x = jax.random.normal(ks[0], (BATCH, SEQ, D_MODEL), f32)
    w_in = nrm(ks[1], (D_MODEL, IN_COLS), D_MODEL ** -0.5)
    lru_conv_w = nrm(ks[2], (LRU_CONV, LRU_WIDTH), LRU_CONV ** -0.5)
    lru_conv_b = nrm(ks[3], (LRU_WIDTH,), 0.01)
    lru_w_a = nrm(ks[4], (2, LRU_HEADS, LRU_HEAD_DIM, LRU_HEAD_DIM), LRU_HEAD_DIM ** -0.5)
    lru_b_a = nrm(ks[5], (2, LRU_HEADS, LRU_HEAD_DIM), 0.01)
    lru_w_x = nrm(ks[6], (2, LRU_HEADS, LRU_HEAD_DIM, LRU_HEAD_DIM), LRU_HEAD_DIM ** -0.5)
    lru_b_x = nrm(ks[7], (2, LRU_HEADS, LRU_HEAD_DIM), 0.01)
    a_c = jax.random.uniform(ks[8], (2, LRU_WIDTH), f32, 0.9, 0.999)
    a0 = a_c ** (1.0 / LRU_C)
    lru_lambda = jnp.log(a0) - jnp.log1p(-a0)
    w_lru_out = nrm(ks[9], (LRU_WIDTH, D_MODEL), BETA * LRU_WIDTH ** -0.5)
    sc_conv_w = nrm(ks[10], (SHORT_CONV, CONV_WIDTH), SHORT_CONV ** -0.5)
    sc_conv_b = nrm(ks[11], (CONV_WIDTH,), 0.01)
    w_conv_out = nrm(ks[12], (CONV_WIDTH, D_MODEL), BETA * CONV_WIDTH ** -0.5)
    w_o = nrm(ks[13], (D_MODEL, D_MODEL), BETA * D_MODEL ** -0.5)
    ln1_g = 1.0 + nrm(ks[14], (D_MODEL,), 0.01)
    ln1_b = nrm(ks[15], (D_MODEL,), 0.01)
    mlp_w1 = nrm(ks[16], (D_MODEL, D_FF), D_MODEL ** -0.5)
    mlp_b1 = nrm(ks[17], (D_FF,), 0.01)
    mlp_w2 = nrm(ks[18], (D_FF, D_MODEL), BETA * D_FF ** -0.5)
    mlp_b2 = nrm(ks[19], (D_MODEL,), 0.01)
    ln2_g = 1.0 + nrm(ks[20], (D_MODEL,), 0.01)
    ln2_b = nrm(ks[21], (D_MODEL,), 0.01)
    return {"x": x, "w_in": w_in, "lru_conv_w": lru_conv_w, "lru_conv_b": lru_conv_b,
            "lru_w_a": lru_w_a, "lru_b_a": lru_b_a, "lru_w_x": lru_w_x, "lru_b_x": lru_b_x,
            "lru_lambda": lru_lambda, "w_lru_out": w_lru_out, "sc_conv_w": sc_conv_w,
            "sc_conv_b": sc_conv_b, "w_conv_out": w_conv_out, "w_o": w_o,
            "ln1_g": ln1_g, "ln1_b": ln1_b, "mlp_w1": mlp_w1, "mlp_b1": mlp_b1,
            "mlp_w2": mlp_w2, "mlp_b2": mlp_b2, "ln2_g": ln2_g, "ln2_b": ln2_b}


def reference(x, w_in, lru_conv_w, lru_conv_b, lru_w_a, lru_b_a, lru_w_x, lru_b_x,
              lru_lambda, w_lru_out, sc_conv_w, sc_conv_b, w_conv_out, w_o,
              ln1_g, ln1_b, mlp_w1, mlp_b1, mlp_w2, mlp_b2, ln2_g, ln2_b):
    h = x
    for _ in range(DEPTH):
        proj = jnp.einsum('bsd,dc->bsc', h, w_in)
        lru_x, conv_x, conv_bg, conv_cg, g_lru, g_conv = jnp.split(proj, SPLIT_POINTS, axis=-1)
        u = centred_dwconv(lru_x, lru_conv_w, lru_conv_b, LRU_CONV_LEFT)
        h_fwd = rg_lru_direction(u, lru_w_a[0], lru_b_a[0], lru_w_x[0], lru_b_x[0], lru_lambda[0], False)
        h_bwd = rg_lru_direction(u, lru_w_a[1], lru_b_a[1], lru_w_x[1], lru_b_x[1], lru_lambda[1], True)
        y_lru = jnp.einsum('bsw,wd->bsd', h_fwd + h_bwd, w_lru_out)
        v = centred_dwconv(conv_cg * conv_x, sc_conv_w, sc_conv_b, SHORT_CONV_LEFT)
        y_conv = jnp.einsum('bsc,cd->bsd', conv_bg * v, w_conv_out)
        merged = jax.nn.sigmoid(g_lru) * y_lru + jax.nn.sigmoid(g_conv) * y_conv
        mix_out = jnp.einsum('bsd,de->bse', merged, w_o)
        h = layer_norm(ALPHA * h + mix_out, ln1_g, ln1_b)
        ff = jnp.square(jax.nn.relu(jnp.einsum('bsd,df->bsf', h, mlp_w1) + mlp_b1))
        ff_out = jnp.einsum('bsf,fd->bsd', ff, mlp_w2) + mlp_b2
        h = layer_norm(ALPHA * h + ff_out, ln2_g, ln2_b)
    return h
```

```cpp
#include <hip/hip_runtime.h>
#include <hip/hip_cooperative_groups.h>
#include <cstdio>
#include <cstdint>
namespace cg = cooperative_groups;
namespace pg8 {
#define PG8_LAS __attribute__((address_space(3)))
typedef unsigned short bf16_t;
typedef short bf16x8 __attribute__((ext_vector_type(8)));
typedef float f32x4 __attribute__((ext_vector_type(4)));
typedef unsigned u32x4 __attribute__((ext_vector_type(4)));
constexpr int BM = 256, BK = 64, HALF = 128, HTB = HALF * BK * 2  , STAGE_BYTES = 8 * HTB, NXCD = 8, WGM = 8;

__host__ __device__ __forceinline__ int lds_byte(int r, int c) { const int st = (r >> 4) * 2 + (c >> 5), rr = r & 15, cc = c & 31, ob = rr * 64 + cc * 2; return st * 1024 + (ob ^ (((ob >> 9) & 1) << 5)); }
__host__ __device__ __forceinline__ void stage_rc(int b, int& R, int& C) { const int st = b / 1024, sb = b % 1024, swz = sb ^ (((sb >> 9) & 1) << 5); R = (st >> 1) * 16 + swz / 64; C = (st & 1) * 32 + (swz % 64) / 2; }
__host__ __device__ __forceinline__ int perm32(int rho) { const int n = rho >> 4, i = rho & 15; return 8 * (i >> 2) + 4 * n + (i & 3); }

struct Unit { int pm, pn; };
struct Gemm { const bf16_t* A; const bf16_t* Bt; int M, N, K; };

struct StaticOrder {
    int nM, nN, nwg, G, c;
    __host__ __device__ void init(int M, int N, int G_, int c_) { nM = M / BM; nN = N / BM; nwg = nM * nN; G = G_; c = c_; }
    __host__ __device__ bool next(int i, Unit& u) const {
        const long L = (long)i * G + c; if (L >= nwg) return false;
        int wgid = (int)L; { const int q = nwg / NXCD, r = nwg % NXCD, xcd = wgid % NXCD, off = wgid / NXCD; wgid = (xcd < r ? xcd * (q + 1) : r * (q + 1) + (xcd - r) * q) + off; }
        const int nig = WGM * nN, gid = wgid / nig, fm = gid * WGM, gsz = (nM - fm) < WGM ? (nM - fm) : WGM;
        u.pm = fm + ((wgid % nig) % gsz); u.pn = (wgid % nig) / gsz; return true;
    }
    __device__ __forceinline__ void a_ready(const Unit&) const {}
    __device__ __forceinline__ void done(const Unit&) const {}
};

__device__ __forceinline__ unsigned cvt_pk_bf16(float lo, float hi) { unsigned r; asm volatile("v_cvt_pk_bf16_f32 %0, %1, %2" : "=v"(r) : "v"(lo), "v"(hi)); return r; }
typedef float f32x2 __attribute__((ext_vector_type(2)));
__device__ __forceinline__ float bf_lo(unsigned w) { return __uint_as_float(w << 16); }
__device__ __forceinline__ float bf_hi(unsigned w) { return __uint_as_float(w & 0xffff0000u); }
__device__ __forceinline__ float sigmoidf_fast(float v) { return __builtin_amdgcn_rcpf(1.0f + __builtin_amdgcn_exp2f(v * -1.44269504089f)); }

struct EpiProj {
    static constexpr bool PERM = true, AFTER_DRAIN = false;
    bf16_t* lx; bf16_t* sec; size_t sec_stride;
    __device__ __forceinline__ void operator()(const f32x4 (&acc)[2][2][4][2], const Unit& u, int wr, int wc, int fr, int fq) const {
        bf16_t* base; int ldc, colt;
        if (u.pn < 10) { base = lx; ldc = 2560; colt = u.pn * BM; }
        else { const int s = (u.pn - 10) >> 3; base = sec + (size_t)s * sec_stride; ldc = 2048; colt = ((u.pn - 10) & 7) * BM; }
        const int row0 = u.pm * BM + wr * 64 + fr, col0 = colt + wc * 32 + 8 * fq;
#pragma unroll
        for (int ai = 0; ai < 2; ++ai)
#pragma unroll
            for (int m = 0; m < 4; ++m) { bf16_t* rowp = base + (size_t)(row0 + ai * HALF + m * 16) * ldc + col0;
#pragma unroll
                for (int bj = 0; bj < 2; ++bj) { const f32x4 v0 = acc[ai][bj][m][0], v1 = acc[ai][bj][m][1];
                    u32x4 w; w.x = cvt_pk_bf16(v0[0], v0[1]); w.y = cvt_pk_bf16(v0[2], v0[3]); w.z = cvt_pk_bf16(v1[0], v1[1]); w.w = cvt_pk_bf16(v1[2], v1[3]);
                    *(u32x4*)(rowp + bj * HALF) = w; } }
    }
};
struct EpiGate1 {
    static constexpr bool PERM = true, AFTER_DRAIN = false;
    const bf16_t* g; float* t1;
    __device__ __forceinline__ void operator()(const f32x4 (&acc)[2][2][4][2], const Unit& u, int wr, int wc, int fr, int fq) const {
        const int row0 = u.pm * BM + wr * 64 + fr, col0 = u.pn * BM + wc * 32 + 8 * fq;
#pragma unroll
        for (int ai = 0; ai < 2; ++ai)
#pragma unroll
            for (int m = 0; m < 4; ++m) { const size_t off = (size_t)(row0 + ai * HALF + m * 16) * 2048 + col0;
#pragma unroll
                for (int bj = 0; bj < 2; ++bj) { const u32x4 gw = *(const u32x4*)(g + off + bj * HALF);
                    f32x4 s0, s1; s0[0] = sigmoidf_fast(bf_lo(gw.x)); s0[1] = sigmoidf_fast(bf_hi(gw.x)); s0[2] = sigmoidf_fast(bf_lo(gw.y)); s0[3] = sigmoidf_fast(bf_hi(gw.y));
                    s1[0] = sigmoidf_fast(bf_lo(gw.z)); s1[1] = sigmoidf_fast(bf_hi(gw.z)); s1[2] = sigmoidf_fast(bf_lo(gw.w)); s1[3] = sigmoidf_fast(bf_hi(gw.w));
                    *(f32x4*)(t1 + off + bj * HALF) = s0 * acc[ai][bj][m][0]; *(f32x4*)(t1 + off + bj * HALF + 4) = s1 * acc[ai][bj][m][1]; } }
    }
};
struct EpiGate2 {
    static constexpr bool PERM = true, AFTER_DRAIN = false;
    bf16_t* g; const float* t1;
    __device__ __forceinline__ void operator()(const f32x4 (&acc)[2][2][4][2], const Unit& u, int wr, int wc, int fr, int fq) const {
        const int row0 = u.pm * BM + wr * 64 + fr, col0 = u.pn * BM + wc * 32 + 8 * fq;
#pragma unroll
        for (int ai = 0; ai < 2; ++ai)
#pragma unroll
            for (int m = 0; m < 4; ++m) { const size_t off = (size_t)(row0 + ai * HALF + m * 16) * 2048 + col0;
#pragma unroll
                for (int bj = 0; bj < 2; ++bj) { const u32x4 gw = *(const u32x4*)(g + off + bj * HALF);
                    const f32x4 a0 = *(const f32x4*)(t1 + off + bj * HALF), a1 = *(const f32x4*)(t1 + off + bj * HALF + 4);
                    f32x4 s0, s1; s0[0] = sigmoidf_fast(bf_lo(gw.x)); s0[1] = sigmoidf_fast(bf_hi(gw.x)); s0[2] = sigmoidf_fast(bf_lo(gw.y)); s0[3] = sigmoidf_fast(bf_hi(gw.y));
                    s1[0] = sigmoidf_fast(bf_lo(gw.z)); s1[1] = sigmoidf_fast(bf_hi(gw.z)); s1[2] = sigmoidf_fast(bf_lo(gw.w)); s1[3] = sigmoidf_fast(bf_hi(gw.w));
                    const f32x4 v0 = a0 + s0 * acc[ai][bj][m][0], v1 = a1 + s1 * acc[ai][bj][m][1];
                    u32x4 w; w.x = cvt_pk_bf16(v0[0], v0[1]); w.y = cvt_pk_bf16(v0[2], v0[3]); w.z = cvt_pk_bf16(v1[0], v1[1]); w.w = cvt_pk_bf16(v1[2], v1[3]);
                    *(u32x4*)(g + off + bj * HALF) = w; } }
    }
};
struct EpiResStats {
    static constexpr bool PERM = false, AFTER_DRAIN = false;
    const float* base; float* out; const float* bias; f32x2* st; float alpha;
    __device__ __forceinline__ void operator()(const f32x4 (&acc)[2][2][4][2], const Unit& u, int wr, int wc, int fr, int fq) const {
        const int col0 = u.pn * BM + wc * 32 + 4 * fq;
        f32x4 bv[2][2];
#pragma unroll
        for (int bj = 0; bj < 2; ++bj)
#pragma unroll
            for (int n = 0; n < 2; ++n) bv[bj][n] = bias ? *(const f32x4*)(bias + col0 + bj * HALF + n * 16) : (f32x4){0.f, 0.f, 0.f, 0.f};
#pragma unroll
        for (int ai = 0; ai < 2; ++ai)
#pragma unroll
            for (int m = 0; m < 4; ++m) { const int r = u.pm * BM + ai * HALF + wr * 64 + m * 16 + fr; const size_t off = (size_t)r * 2048 + col0;
                f32x4 v[2][2]; float s = 0.f;
#pragma unroll
                for (int bj = 0; bj < 2; ++bj)
#pragma unroll
                    for (int n = 0; n < 2; ++n) { const f32x4 bs = *(const f32x4*)(base + off + bj * HALF + n * 16); v[bj][n] = bs * alpha + acc[ai][bj][m][n] + bv[bj][n]; }
#pragma unroll
                for (int bj = 0; bj < 2; ++bj)
#pragma unroll
                    for (int n = 0; n < 2; ++n) { *(f32x4*)(out + off + bj * HALF + n * 16) = v[bj][n]; s += (v[bj][n][0] + v[bj][n][1]) + (v[bj][n][2] + v[bj][n][3]); }
                s += __shfl_xor(s, 16); s += __shfl_xor(s, 32);
                const float mw = s * (1.0f / 64.0f); float q = 0.f;
#pragma unroll
                for (int bj = 0; bj < 2; ++bj)
#pragma unroll
                    for (int n = 0; n < 2; ++n) { const f32x4 d = v[bj][n] - mw; q += (d[0] * d[0] + d[1] * d[1]) + (d[2] * d[2] + d[3] * d[3]); }
                q += __shfl_xor(q, 16); q += __shfl_xor(q, 32);
                if (fq == 0) st[(size_t)r * 32 + u.pn * 4 + wc] = (f32x2){mw, q};
                asm volatile("" ::: "memory"); }
    }
};
struct EpiRelu2 {
    static constexpr bool PERM = true, AFTER_DRAIN = false;
    bf16_t* O; int ldc; const float* bias;
    __device__ __forceinline__ void operator()(const f32x4 (&acc)[2][2][4][2], const Unit& u, int wr, int wc, int fr, int fq) const {
        const int row0 = u.pm * BM + wr * 64 + fr, col0 = u.pn * BM + wc * 32 + 8 * fq;
        f32x4 bv[2][2];
#pragma unroll
        for (int bj = 0; bj < 2; ++bj)
#pragma unroll
            for (int n = 0; n < 2; ++n) bv[bj][n] = *(const f32x4*)(bias + col0 + bj * HALF + 4 * n);
#pragma unroll
        for (int ai = 0; ai < 2; ++ai)
#pragma unroll
            for (int m = 0; m < 4; ++m) { bf16_t* rowp = O + (size_t)(row0 + ai * HALF + m * 16) * ldc + col0;
#pragma unroll
                for (int bj = 0; bj < 2; ++bj) { f32x4 v0 = acc[ai][bj][m][0] + bv[bj][0], v1 = acc[ai][bj][m][1] + bv[bj][1];
#pragma unroll
                    for (int j = 0; j < 4; ++j) { const float a = fmaxf(v0[j], 0.f), b = fmaxf(v1[j], 0.f); v0[j] = a * a; v1[j] = b * b; }
                    u32x4 w; w.x = cvt_pk_bf16(v0[0], v0[1]); w.y = cvt_pk_bf16(v0[2], v0[3]); w.z = cvt_pk_bf16(v1[0], v1[1]); w.w = cvt_pk_bf16(v1[2], v1[3]);
                    *(u32x4*)(rowp + bj * HALF) = w; } }
    }
};

template <class Epi, class Sched, bool ALIGN_EPI = false, bool SP2 = false>
__device__ __forceinline__ void gemm_phase(PG8_LAS unsigned char* lds, const Gemm g, const Sched& S, const Epi& E) {
    const int tid = threadIdx.x, wid = __builtin_amdgcn_readfirstlane(tid >> 6), lane = tid & 63, wr = wid >> 2, wc = wid & 3, fr = lane & 15, fq = lane >> 4;
    const int K = g.K, nt = K / BK;
    unsigned voffA[2], voffB[2];
#pragma unroll
    for (int i = 0; i < 2; ++i) { int R, C; stage_rc(tid * 16 + i * 8192, R, C); const int Rb = Epi::PERM ? ((R & ~31) + perm32(R & 31)) : R;
        voffA[i] = (unsigned)(R * K + C) * 2u; voffB[i] = (unsigned)(Rb * K + C) * 2u; }
    const size_t kstep = (size_t)(BK * 2);
    const size_t hstep = (size_t)HALF * K * 2;
    const size_t tstep = 2 * hstep;
    const unsigned ldsw = (unsigned)wid * 1024u;
    const int aoff = lds_byte(wr * 64 + fr, fq * 8), boff = lds_byte(wc * 32 + fr, fq * 8);
#define PG8_SA(b, h) (((b) * 2 + (h)) * HTB)
#define PG8_SB(b, h) ((4 + (b) * 2 + (h)) * HTB)
#define PG8_STAGE(bufoff, gbase, voff) do { _Pragma("unroll") for (int _i = 0; _i < 2; ++_i) \
        __builtin_amdgcn_global_load_lds((const unsigned*)((const char*)(gbase) + (voff)[_i]), (PG8_LAS unsigned*)(lds + (bufoff) + ldsw + _i * 8192), 16, 0, 0); } while (0)
#define PG8_LDA(dst, b, h) do { _Pragma("unroll") for (int m = 0; m < 4; ++m) _Pragma("unroll") for (int k = 0; k < 2; ++k) dst[m][k] = *(const PG8_LAS bf16x8*)(lds + PG8_SA(b, h) + aoff + m * 2048 + k * 1024); } while (0)
#define PG8_LDB(dst, b, h) do { _Pragma("unroll") for (int n = 0; n < 2; ++n) _Pragma("unroll") for (int k = 0; k < 2; ++k) dst[n][k] = *(const PG8_LAS bf16x8*)(lds + PG8_SB(b, h) + boff + n * 2048 + k * 1024); } while (0)
#define PG8_MMA(ai, bj, At, Bt) do { __builtin_amdgcn_s_setprio(1); _Pragma("unroll") for (int m = 0; m < 4; ++m) _Pragma("unroll") for (int n = 0; n < 2; ++n) _Pragma("unroll") for (int k = 0; k < 2; ++k) \
        acc[ai][bj][m][n] = __builtin_amdgcn_mfma_f32_16x16x32_bf16(Bt[n][k], At[m][k], acc[ai][bj][m][n], 0, 0, 0); __builtin_amdgcn_s_setprio(0); } while (0)
#define PG8_WAIT_V(n) asm volatile("s_waitcnt vmcnt(" #n ")" ::: "memory")
#define PG8_WAIT_L(n) asm volatile("s_waitcnt lgkmcnt(" #n ")" ::: "memory")
#define PG8_BAR __builtin_amdgcn_s_barrier()
#define PG8_SCHED __builtin_amdgcn_sched_barrier(0)
    Unit cur, nxt; int ui = 0;
    if (!S.next(0, cur)) return;
    f32x4 acc[2][2][4][2];
#pragma unroll
    for (int a = 0; a < 2; ++a)
#pragma unroll
        for (int b = 0; b < 2; ++b)
#pragma unroll
            for (int m = 0; m < 4; ++m)
#pragma unroll
                for (int n = 0; n < 2; ++n) acc[a][b][m][n] = (f32x4){0.f, 0.f, 0.f, 0.f};
    bf16x8 At[4][2], B0[2][2], B1[2][2];
    const char* cA = (const char*)g.A + (size_t)cur.pm * tstep; const char* cB = (const char*)g.Bt + (size_t)cur.pn * tstep;
    S.a_ready(cur);
    if constexpr (SP2) {
        PG8_STAGE(PG8_SB(0, 0), cB, voffB); PG8_STAGE(PG8_SB(0, 1), cB + hstep, voffB); PG8_STAGE(PG8_SA(0, 0), cA, voffA); PG8_STAGE(PG8_SA(0, 1), cA + hstep, voffA);
        if (wr == 1) PG8_BAR;
        PG8_WAIT_V(2); PG8_BAR;
        PG8_STAGE(PG8_SB(1, 0), cB + kstep, voffB); PG8_STAGE(PG8_SA(1, 0), cA + kstep, voffA); PG8_STAGE(PG8_SB(1, 1), cB + hstep + kstep, voffB);
        PG8_WAIT_V(6); PG8_BAR;
    } else {
        PG8_STAGE(PG8_SB(0, 0), cB, voffB); PG8_STAGE(PG8_SA(0, 0), cA, voffA); PG8_STAGE(PG8_SB(0, 1), cB + hstep, voffB); PG8_STAGE(PG8_SA(0, 1), cA + hstep, voffA);
        if (wr == 1) PG8_BAR;
        PG8_WAIT_V(4); PG8_BAR;
        PG8_STAGE(PG8_SB(1, 0), cB + kstep, voffB); PG8_STAGE(PG8_SA(1, 0), cA + kstep, voffA); PG8_STAGE(PG8_SB(1, 1), cB + hstep + kstep, voffB);
        PG8_WAIT_V(6); PG8_BAR;
    }
    for (;;) {
        const bool has_next = S.next(ui + 1, nxt);
        const char* nA = has_next ? (const char*)g.A + (size_t)nxt.pm * tstep : cA; const char* nB = has_next ? (const char*)g.Bt + (size_t)nxt.pn * tstep : cB;
        for (int t = 0; t < nt; t += 2) {
            const bool last = (t == nt - 2);
            const char* a1 = cA + (size_t)(t + 1) * kstep;
            const char* a2 = last ? nA : cA + (size_t)(t + 2) * kstep; const char* b2 = last ? nB : cB + (size_t)(t + 2) * kstep;
            const char* a3 = a2 + kstep; const char* b3 = b2 + kstep;
            if (last && has_next) S.a_ready(nxt);
            if constexpr (SP2) {
            PG8_LDB(B0, 0, 0); PG8_LDB(B1, 0, 1); PG8_SCHED; PG8_LDA(At, 0, 0); PG8_STAGE(PG8_SA(1, 1), a1 + hstep, voffA);
            PG8_WAIT_V(8); PG8_WAIT_L(0); PG8_BAR; PG8_MMA(0, 0, At, B0); PG8_MMA(0, 1, At, B1); PG8_BAR; PG8_SCHED;
            PG8_LDA(At, 0, 1); PG8_STAGE(PG8_SB(0, 0), b2, voffB); PG8_STAGE(PG8_SB(0, 1), b2 + hstep, voffB); PG8_STAGE(PG8_SA(0, 0), a2, voffA);
            PG8_WAIT_V(8); PG8_WAIT_L(0); PG8_BAR; PG8_MMA(1, 0, At, B0); PG8_MMA(1, 1, At, B1); PG8_BAR; PG8_SCHED;
            PG8_LDB(B0, 1, 0); PG8_LDB(B1, 1, 1); PG8_SCHED; PG8_LDA(At, 1, 0); PG8_STAGE(PG8_SA(0, 1), a2 + hstep, voffA);
            PG8_WAIT_V(8); PG8_WAIT_L(0); PG8_BAR; PG8_MMA(0, 0, At, B0); PG8_MMA(0, 1, At, B1); PG8_BAR; PG8_SCHED;
            PG8_LDA(At, 1, 1); PG8_STAGE(PG8_SB(1, 0), b3, voffB); PG8_STAGE(PG8_SB(1, 1), b3 + hstep, voffB); PG8_STAGE(PG8_SA(1, 0), a3, voffA);
            PG8_WAIT_V(8); PG8_WAIT_L(0); PG8_BAR; PG8_MMA(1, 0, At, B0); PG8_MMA(1, 1, At, B1); PG8_BAR; PG8_SCHED;
            } else {
            PG8_LDB(B0, 0, 0); PG8_SCHED; PG8_LDA(At, 0, 0); PG8_STAGE(PG8_SA(1, 1), a1 + hstep, voffA);
            PG8_WAIT_L(8); PG8_BAR; PG8_WAIT_L(0); PG8_MMA(0, 0, At, B0); PG8_BAR; PG8_SCHED;
            PG8_LDB(B1, 0, 1); PG8_STAGE(PG8_SB(0, 0), b2, voffB);
            PG8_BAR; PG8_WAIT_L(0); PG8_MMA(0, 1, At, B1); PG8_BAR;
            PG8_LDA(At, 0, 1); PG8_STAGE(PG8_SA(0, 0), a2, voffA);
            PG8_BAR; PG8_WAIT_L(0); PG8_MMA(1, 0, At, B0); PG8_BAR; PG8_SCHED;
            PG8_STAGE(PG8_SB(0, 1), b2 + hstep, voffB);
            PG8_WAIT_V(6); PG8_BAR; PG8_MMA(1, 1, At, B1); PG8_BAR;
            PG8_LDB(B0, 1, 0); PG8_SCHED; PG8_LDA(At, 1, 0); PG8_STAGE(PG8_SA(0, 1), a2 + hstep, voffA);
            PG8_WAIT_L(8); PG8_BAR; PG8_WAIT_L(0); PG8_MMA(0, 0, At, B0); PG8_BAR; PG8_SCHED;
            PG8_LDB(B1, 1, 1); PG8_STAGE(PG8_SB(1, 0), b3, voffB);
            PG8_BAR; PG8_WAIT_L(0); PG8_MMA(0, 1, At, B1); PG8_BAR;
            PG8_LDA(At, 1, 1); PG8_STAGE(PG8_SA(1, 0), a3, voffA);
            PG8_BAR; PG8_WAIT_L(0); PG8_MMA(1, 0, At, B0); PG8_BAR; PG8_SCHED;
            PG8_STAGE(PG8_SB(1, 1), b3 + hstep, voffB);
            PG8_WAIT_V(6); PG8_BAR; PG8_MMA(1, 1, At, B1); PG8_BAR;
            }
        }
        if constexpr (ALIGN_EPI) { if (wr == 0) PG8_BAR; }
        if constexpr (!Epi::AFTER_DRAIN) { E(acc, cur, wr, wc, fr, fq); S.done(cur); }
        if (!has_next) break;
#pragma unroll
        for (int a = 0; a < 2; ++a)
#pragma unroll
            for (int b = 0; b < 2; ++b)
#pragma unroll
                for (int m = 0; m < 4; ++m)
#pragma unroll
                    for (int n = 0; n < 2; ++n) acc[a][b][m][n] = (f32x4){0.f, 0.f, 0.f, 0.f};
        cur = nxt; cA = nA; cB = nB; ++ui;
        if constexpr (ALIGN_EPI) { if (wr == 1) PG8_BAR; }
    }
    PG8_WAIT_V(0);
    if constexpr (!ALIGN_EPI) { if (wr == 0) PG8_BAR; }
    PG8_BAR;
    if constexpr (Epi::AFTER_DRAIN) { E.fused(acc, cur, wr, wc, fr, fq, lds, wid, lane); S.done(cur); }
#undef PG8_SA
#undef PG8_SB
#undef PG8_STAGE
#undef PG8_LDA
#undef PG8_LDB
#undef PG8_MMA
#undef PG8_WAIT_V
#undef PG8_WAIT_L
#undef PG8_BAR
#undef PG8_SCHED
}
}
#ifndef MK_ONE_LAUNCH
#define MK_ONE_LAUNCH 0
#endif
#ifndef MK_NAIVE_LRU
#define MK_NAIVE_LRU 1
#endif
constexpr int NWAVES = 8, NTHR = NWAVES * 64;
constexpr int NB = 8, SEQ = 2048, MT = NB * SEQ, DM = 2048, LW = 2560, NH = 20, HD = 128, CW = 2048, DFF = 8192, INC = 12800;
constexpr float ALPHA = 1.18920711500272f;
constexpr float LN_EPS = 1e-5f;
constexpr int NPHASE = 9;
constexpr size_t MiB = 1u << 20;
constexpr size_t WS_CTL = 0, CTL_BYTES = 1 * MiB;
constexpr size_t WS_ST1 = 1 * MiB, WS_ST2 = 5 * MiB;
constexpr size_t WS_WG = 9 * MiB;
constexpr size_t WS_WLO = 12 * MiB, WS_WCO = 22 * MiB, WS_WO = 30 * MiB, WS_W1 = 38 * MiB, WS_W2 = 70 * MiB;
constexpr size_t WS_LX = 102 * MiB;
constexpr size_t WS_SEC = 182 * MiB, SEC_BYTES = 64 * MiB;
constexpr size_t WS_T1 = 102 * MiB;
constexpr size_t WS_FF = 102 * MiB;
constexpr size_t WS_H1B = WS_SEC + 3 * SEC_BYTES;
constexpr size_t WS_END = WS_SEC + 5 * SEC_BYTES;
static_assert(WS_FF + (size_t)MT * DFF * 2 <= WS_H1B, "FF overlay must end before H1B");
constexpr size_t DO_XB = 0, DO_WINT = 64 * MiB, DO_HS = 0;
constexpr int CW_ZQ = 64;
constexpr int LDS_BYTES = 147456, MISC_OFF = 131072;

#define GAS __attribute__((address_space(1)))
#define LAS __attribute__((address_space(3)))
typedef unsigned short bf16;
typedef unsigned v4u __attribute__((ext_vector_type(4)));
typedef unsigned v2u __attribute__((ext_vector_type(2)));
typedef float f32x4 __attribute__((ext_vector_type(4)));
typedef float f32x2 __attribute__((ext_vector_type(2)));
#define LDS_WAIT() asm volatile("s_waitcnt lgkmcnt(0)" ::: "memory")
__device__ __forceinline__ unsigned f2bf(float f) { unsigned u = __builtin_bit_cast(unsigned, f); return (u + 0x7fffu + ((u >> 16) & 1u)) >> 16; }
__device__ __forceinline__ unsigned pk2(float lo, float hi) { return f2bf(lo) | (f2bf(hi) << 16); }
__device__ __forceinline__ float bf2f(unsigned short b) { return __uint_as_float(((unsigned)b) << 16); }
__device__ __forceinline__ float bflo(unsigned w) { return __uint_as_float(w << 16); }
__device__ __forceinline__ float bfhi(unsigned w) { return __uint_as_float(w & 0xffff0000u); }

__device__ __forceinline__ void p0_transpose_item(const float* W, int K, int N, bf16* WT, LAS float* scr, int item, int lane) {
    const int nblk = N / 32, kb = item / nblk, nb = item % nblk, k0 = 64 * kb, n0 = 32 * nb;
#pragma unroll 8
    for (int i = 0; i < 32; ++i) { const int kk = 2 * i + (lane >> 5); scr[kk * 33 + (lane & 31)] = W[(size_t)(k0 + kk) * N + n0 + (lane & 31)]; }
    LDS_WAIT(); asm volatile("" ::: "memory");
    const int c = lane & 7;
#pragma unroll
    for (int j = 0; j < 4; ++j) { const int n = (lane >> 3) + 8 * j; const LAS float* s = scr + (8 * c) * 33 + n;
        v4u o; o.x = pk2(s[0 * 33], s[1 * 33]); o.y = pk2(s[2 * 33], s[3 * 33]); o.z = pk2(s[4 * 33], s[5 * 33]); o.w = pk2(s[6 * 33], s[7 * 33]);
        *(v4u*)(WT + (size_t)(n0 + n) * K + k0 + 8 * c) = o; }
    LDS_WAIT(); asm volatile("" ::: "memory");
}

__device__ __forceinline__ void ln_apply_row(const float* vrow, const f32x2* strow, const float* gam, const float* bet, float* outf, bf16* outb, int lane) {
    const f32x2 p = strow[lane & 31];
    float ms = p.x;
#pragma unroll
    for (int o = 1; o < 32; o <<= 1) ms += __shfl_xor(ms, o);
    const float mean = ms * (1.0f / 32.0f);
    const float dm = p.x - mean; float q = p.y + 64.0f * dm * dm;
#pragma unroll
    for (int o = 1; o < 32; o <<= 1) q += __shfl_xor(q, o);
    const float rstd = 1.0f / sqrtf(q * (1.0f / 2048.0f) + LN_EPS);
    const f32x4* v4 = (const f32x4*)vrow; const f32x4* g4 = (const f32x4*)gam; const f32x4* b4 = (const f32x4*)bet;
#pragma unroll
    for (int j = 0; j < 8; ++j) { const int i = 64 * j + lane; const f32x4 x = v4[i]; const f32x4 y = (x - mean) * rstd * g4[i] + b4[i];
        ((f32x4*)outf)[i] = y;
        if (outb) { v2u w; w.x = pk2(y[0], y[1]); w.y = pk2(y[2], y[3]); ((v2u*)outb)[i] = w; } }
}

__device__ __forceinline__ void z_item(int item, const bf16* CX, bf16* CBZ, const bf16* CC, const float* w, const float* bias, int tid) {
    const int cg = tid & 255, rh = tid >> 8, R0 = item * 32 + rh * 16, t0 = R0 & (SEQ - 1), c0 = cg * 8;
    float w0[8], w1[8], w2[8], bb[8];
#pragma unroll
    for (int j = 0; j < 8; ++j) { w0[j] = w[c0 + j]; w1[j] = w[CW + c0 + j]; w2[j] = w[2 * CW + c0 + j]; bb[j] = bias[c0 + j]; }
    float pv[8], cu[8], nx[8];
#define LOADCX(dst, row, ok) do { if (ok) { const v4u a_ = *(const v4u*)(CX + (size_t)(row) * CW + c0), b_ = *(const v4u*)(CC + (size_t)(row) * CW + c0); \
        dst[0] = bflo(a_.x) * bflo(b_.x); dst[1] = bfhi(a_.x) * bfhi(b_.x); dst[2] = bflo(a_.y) * bflo(b_.y); dst[3] = bfhi(a_.y) * bfhi(b_.y); \
        dst[4] = bflo(a_.z) * bflo(b_.z); dst[5] = bfhi(a_.z) * bfhi(b_.z); dst[6] = bflo(a_.w) * bflo(b_.w); dst[7] = bfhi(a_.w) * bfhi(b_.w); } \
        else { _Pragma("unroll") for (int j_ = 0; j_ < 8; ++j_) dst[j_] = 0.f; } } while (0)
    LOADCX(pv, R0 - 1, t0 > 0);
    LOADCX(cu, R0, true);
    for (int i = 0; i < 16; ++i) {
        LOADCX(nx, R0 + i + 1, (t0 + i + 1) < SEQ);
        const v4u cb = *(const v4u*)(CBZ + (size_t)(R0 + i) * CW + c0);
        float z[8];
#pragma unroll
        for (int j = 0; j < 8; ++j) z[j] = w0[j] * pv[j] + w1[j] * cu[j] + w2[j] * nx[j] + bb[j];
        v4u o; o.x = pk2(bflo(cb.x) * z[0], bfhi(cb.x) * z[1]); o.y = pk2(bflo(cb.y) * z[2], bfhi(cb.y) * z[3]); o.z = pk2(bflo(cb.z) * z[4], bfhi(cb.z) * z[5]); o.w = pk2(bflo(cb.w) * z[6], bfhi(cb.w) * z[7]);
        *(v4u*)(CBZ + (size_t)(R0 + i) * CW + c0) = o;
#pragma unroll
        for (int j = 0; j < 8; ++j) { pv[j] = cu[j]; cu[j] = nx[j]; }
    }
#undef LOADCX
}

#if MK_NAIVE_LRU
__device__ __forceinline__ void lru_naive_item(int b, int hd, const bf16* LX, const float* cw, const float* cb, const float* wa, const float* ba, const float* wx, const float* bx,
                                               const float* lam, bf16* HS, LAS float* us, int tid) {
    const int dir = (tid >> 7) & 1, e = tid & 127; const bool act = tid < 256; const int ch = hd * HD + e;
    const float c0 = cw[ch], c1 = cw[LW + ch], c2 = cw[2 * LW + ch], c3 = cw[3 * LW + ch], cbias = cb[ch];
    const float b_a = ba[(dir * NH + hd) * HD + e], b_x = bx[(dir * NH + hd) * HD + e];
    const float kl = -8.0f * log1pf(expf(-lam[dir * LW + ch]));
    const float* Wa = wa + (size_t)(dir * NH + hd) * HD * HD + e; const float* Wx = wx + (size_t)(dir * NH + hd) * HD * HD + e;
    float h = 0.f;
    for (int s = 0; s < SEQ; ++s) {
        const int t = dir ? (SEQ - 1 - s) : s;
        float u = cbias;
        if (act) { const bf16* p = LX + ((size_t)b * SEQ + t) * LW + ch;
            if (t >= 2) u += c0 * bf2f(p[-2 * LW]); if (t >= 1) u += c1 * bf2f(p[-LW]); u += c2 * bf2f(p[0]); if (t + 1 < SEQ) u += c3 * bf2f(p[LW]);
            us[dir * HD + e] = u; }
        __syncthreads();
        if (act) { float ra = b_a, ri = b_x;
            for (int d = 0; d < HD; ++d) { const float ud = us[dir * HD + d]; ra += ud * Wa[d * HD]; ri += ud * Wx[d * HD]; }
            const float r = 1.0f / (1.0f + expf(-ra)), ig = 1.0f / (1.0f + expf(-ri));
            const float la = kl * r, a = expf(la), g = sqrtf(fmaxf(-expm1f(2.0f * la), 0.f)) * (ig * u);
            h = a * h + g;
            bf16* o = HS + ((size_t)b * SEQ + t) * LW + ch;
            if (s < SEQ / 2) *o = (bf16)f2bf(h); else *o = (bf16)f2bf(bf2f(*o) + h); }
        __syncthreads();
    }
}
#endif

struct Args { const float* in[22]; float* out; unsigned char* ws; int ph_lo, ph_hi; };

__global__ void __launch_bounds__(NTHR, 2) mk_fwd(Args args) {
    extern __shared__ __attribute__((aligned(16))) unsigned char lds_raw[];
    LAS unsigned char* lds = (LAS unsigned char*)lds_raw;
    volatile LAS unsigned* MISC = (volatile LAS unsigned*)(lds + MISC_OFF);
    const int tid = threadIdx.x, lane = tid & 63, wave = __builtin_amdgcn_readfirstlane(tid >> 6);
    const int G = gridDim.x, bx = blockIdx.x;
    const int gw = bx * NWAVES + wave, NGW = G * NWAVES;
    unsigned char* ws = args.ws; unsigned char* dob = (unsigned char*)args.out;
    unsigned* ctl = (unsigned*)(ws + WS_CTL);
    const float* x = args.in[0]; const float* w_in = args.in[1]; const float* lru_conv_w = args.in[2]; const float* lru_conv_b = args.in[3];
    const float* lru_w_a = args.in[4]; const float* lru_b_a = args.in[5]; const float* lru_w_x = args.in[6]; const float* lru_b_x = args.in[7];
    const float* lru_lambda = args.in[8]; const float* w_lru_out = args.in[9]; const float* sc_conv_w = args.in[10]; const float* sc_conv_b = args.in[11];
    const float* w_conv_out = args.in[12]; const float* w_o = args.in[13]; const float* ln1_g = args.in[14]; const float* ln1_b = args.in[15];
    const float* mlp_w1 = args.in[16]; const float* mlp_b1 = args.in[17]; const float* mlp_w2 = args.in[18]; const float* mlp_b2 = args.in[19];
    const float* ln2_g = args.in[20]; const float* ln2_b = args.in[21];
    bf16* XB = (bf16*)(dob + DO_XB); bf16* WINT = (bf16*)(dob + DO_WINT); bf16* HS = (bf16*)(dob + DO_HS); float* OUTF = args.out;
    bf16* WG = (bf16*)(ws + WS_WG); bf16* WLO = (bf16*)(ws + WS_WLO); bf16* WCO = (bf16*)(ws + WS_WCO); bf16* WO = (bf16*)(ws + WS_WO); bf16* W1 = (bf16*)(ws + WS_W1); bf16* W2 = (bf16*)(ws + WS_W2);
    bf16* LX = (bf16*)(ws + WS_LX); bf16* SEC = (bf16*)(ws + WS_SEC); constexpr size_t SEC_ELEMS = SEC_BYTES / 2;
    bf16* CXR = SEC; bf16* CBZ = SEC + SEC_ELEMS; bf16* CCC = SEC + 2 * SEC_ELEMS; bf16* GL = SEC + 3 * SEC_ELEMS; bf16* GC = SEC + 4 * SEC_ELEMS;
    float* T1 = (float*)(ws + WS_T1); bf16* FFB = (bf16*)(ws + WS_FF); bf16* H1B = (bf16*)(ws + WS_H1B);
    f32x2* ST1 = (f32x2*)(ws + WS_ST1); f32x2* ST2 = (f32x2*)(ws + WS_ST2);

    const int lo = args.ph_lo, hi = args.ph_hi;
#if MK_ONE_LAUNCH
    cg::grid_group grid = cg::this_grid();
#define SEAM(k) do { if (lo <= (k) && (k) + 1 < hi) grid.sync(); } while (0)
#else
#define SEAM(k) do { } while (0)
#endif
#define IN(k) (lo <= (k) && (k) < hi)

    if (IN(0)) {
        LAS float* scr = (LAS float*)(lds + wave * 8448);
        constexpr int I_IN = (DM / 64) * (INC / 32), I_LO = (LW / 64) * (DM / 32), I_CO = (CW / 64) * (DM / 32), I_O = (DM / 64) * (DM / 32), I_1 = (DM / 64) * (DFF / 32), I_2 = (DFF / 64) * (DM / 32);
        constexpr int I_G = 2 * 2 * NH * 8;
        constexpr int NITEMS = I_IN + I_LO + I_CO + I_O + I_1 + I_2 + I_G;
        for (int it = gw; it < NITEMS; it += NGW) {
            int r = it;
            if (r < I_IN) { p0_transpose_item(w_in, DM, INC, WINT, scr, r, lane); continue; } r -= I_IN;
            if (r < I_LO) { p0_transpose_item(w_lru_out, LW, DM, WLO, scr, r, lane); continue; } r -= I_LO;
            if (r < I_CO) { p0_transpose_item(w_conv_out, CW, DM, WCO, scr, r, lane); continue; } r -= I_CO;
            if (r < I_O) { p0_transpose_item(w_o, DM, DM, WO, scr, r, lane); continue; } r -= I_O;
            if (r < I_1) { p0_transpose_item(mlp_w1, DM, DFF, W1, scr, r, lane); continue; } r -= I_1;
            if (r < I_2) { p0_transpose_item(mlp_w2, DFF, DM, W2, scr, r, lane); continue; } r -= I_2;
            { const int mat = r >> 3, sub = r & 7, gate = mat / (2 * NH), dh = mat % (2 * NH);
              const float* src = (gate ? lru_w_x : lru_w_a) + (size_t)dh * HD * HD;
              p0_transpose_item(src, HD, HD, WG + (size_t)mat * HD * HD, scr, sub, lane); }
        }
        for (int m = gw; m < MT; m += NGW) {
            const f32x4* xr = (const f32x4*)(x + (size_t)m * DM) + lane; v2u* o8 = (v2u*)(XB + (size_t)m * DM) + lane;
#pragma unroll
            for (int j = 0; j < 8; ++j) { const f32x4 v = xr[64 * j]; v2u w; w.x = pk2(v[0], v[1]); w.y = pk2(v[2], v[3]); o8[64 * j] = w; }
        }
    }
    SEAM(0);
    if (IN(1)) {
        pg8::Gemm g{XB, WINT, MT, INC, DM}; pg8::StaticOrder S; S.init(MT, INC, G, bx);
        pg8::EpiProj E{LX, SEC, SEC_ELEMS};
        pg8::gemm_phase<pg8::EpiProj, pg8::StaticOrder, true, true>(lds, g, S, E);
    }
    SEAM(1);
    if (IN(2)) {
#if MK_NAIVE_LRU
        if (bx < NB * NH) lru_naive_item(bx / NH, bx % NH, LX, lru_conv_w, lru_conv_b, lru_w_a, lru_b_a, lru_w_x, lru_b_x, lru_lambda, HS, (LAS float*)(lds), tid);
#endif
        for (;;) {
            __syncthreads();
            if (tid == 0) MISC[0] = atomicAdd(ctl + CW_ZQ, 1u);
            __syncthreads();
            const int item = (int)MISC[0];
            if (item >= MT / 32) break;
            z_item(item, CXR, CBZ, CCC, sc_conv_w, sc_conv_b, tid);
        }
        __syncthreads();
    }
    SEAM(2);
    if (IN(3)) {
        { pg8::Gemm g{HS, WLO, MT, DM, LW}; pg8::StaticOrder S; S.init(MT, DM, G, bx);
          pg8::EpiGate1 E{GL, T1};
          pg8::gemm_phase<pg8::EpiGate1, pg8::StaticOrder, true, true>(lds, g, S, E); }
        __syncthreads();
        { pg8::Gemm g{CBZ, WCO, MT, DM, CW}; pg8::StaticOrder S; S.init(MT, DM, G, bx);
          pg8::EpiGate2 E{GC, T1};
          pg8::gemm_phase<pg8::EpiGate2, pg8::StaticOrder, true, true>(lds, g, S, E); }
    }
    SEAM(3);
    if (IN(4)) {
        pg8::Gemm g{GC, WO, MT, DM, DM}; pg8::StaticOrder S; S.init(MT, DM, G, bx);
        pg8::EpiResStats E{x, OUTF, nullptr, (pg8::f32x2*)ST1, ALPHA};
        pg8::gemm_phase<pg8::EpiResStats, pg8::StaticOrder, true, true>(lds, g, S, E);
    }
    SEAM(4);
    if (IN(5)) {
        for (int m = gw; m < MT; m += NGW) ln_apply_row(OUTF + (size_t)m * DM, ST1 + (size_t)m * 32, ln1_g, ln1_b, OUTF + (size_t)m * DM, H1B + (size_t)m * DM, lane);
    }
    SEAM(5);
    if (IN(6)) {
        pg8::Gemm g{H1B, W1, MT, DFF, DM}; pg8::StaticOrder S; S.init(MT, DFF, G, bx);
        pg8::EpiRelu2 E{FFB, DFF, mlp_b1};
        pg8::gemm_phase<pg8::EpiRelu2, pg8::StaticOrder, true, true>(lds, g, S, E);
    }
    SEAM(6);
    if (IN(7)) {
        pg8::Gemm g{FFB, W2, MT, DM, DFF}; pg8::StaticOrder S; S.init(MT, DM, G, bx);
        pg8::EpiResStats E{OUTF, OUTF, mlp_b2, (pg8::f32x2*)ST2, ALPHA};
        pg8::gemm_phase<pg8::EpiResStats, pg8::StaticOrder, true, true>(lds, g, S, E);
    }
    SEAM(7);
    if (IN(8)) {
        for (int m = gw; m < MT; m += NGW) ln_apply_row(OUTF + (size_t)m * DM, ST2 + (size_t)m * 32, ln2_g, ln2_b, OUTF + (size_t)m * DM, nullptr, lane);
    }
#undef IN
#undef SEAM
}

extern "C" void kernel_launch(void* const* d_in, const int* in_sizes, int n_in, void* d_out, int out_size, void* d_ws, size_t ws_size, hipStream_t stream) {
    static int grid = 0;
    if (grid == 0) {
        if (n_in != 22 || in_sizes[0] != MT * DM || out_size != MT * DM || ws_size < WS_END) {
            fprintf(stderr, "kernel_launch: unexpected shapes (n_in %d, in0 %d, out %d, ws %zu; need ws >= %zu)\n", n_in, n_in > 0 ? in_sizes[0] : -1, out_size, ws_size, (size_t)WS_END); grid = -1; return; }
        int dev = 0, cus = 0, per_cu = 0;
        if (hipGetDevice(&dev) != hipSuccess || hipDeviceGetAttribute(&cus, hipDeviceAttributeMultiprocessorCount, dev) != hipSuccess) { grid = -1; return; }
        if (hipFuncSetAttribute((const void*)mk_fwd, hipFuncAttributeMaxDynamicSharedMemorySize, LDS_BYTES) != hipSuccess) { fprintf(stderr, "kernel_launch: hipFuncSetAttribute failed\n"); grid = -1; return; }
        if (hipOccupancyMaxActiveBlocksPerMultiprocessor(&per_cu, (const void*)mk_fwd, NTHR, LDS_BYTES) != hipSuccess || per_cu < 1) { fprintf(stderr, "kernel_launch: occupancy query says %d blocks/CU\n", per_cu); (void)hipGetLastError(); grid = -1; return; }
        grid = cus * 1;
        fprintf(stderr, "kernel_launch: %d CUs, occupancy %d blocks/CU, grid %d\n", cus, per_cu, grid);
    }
    if (grid < 0) return;
    (void)hipMemsetAsync((char*)d_ws + WS_CTL, 0, CTL_BYTES, stream);
    Args a{};
    for (int i = 0; i < 22; ++i) a.in[i] = (const float*)d_in[i];
    a.out = (float*)d_out; a.ws = (unsigned char*)d_ws;
#if MK_ONE_LAUNCH
    a.ph_lo = 0; a.ph_hi = NPHASE;
    void* kargs[] = {&a};
    hipError_t e = hipLaunchCooperativeKernel((const void*)mk_fwd, dim3(grid), dim3(NTHR), kargs, LDS_BYTES, stream);
    if (e != hipSuccess) fprintf(stderr, "kernel_launch: cooperative launch failed: %s (grid %d)\n", hipGetErrorString(e), grid);
#else
    for (int p = 0; p < NPHASE; ++p) { a.ph_lo = p; a.ph_hi = p + 1; hipLaunchKernelGGL(mk_fwd, dim3(grid), dim3(NTHR), LDS_BYTES, stream, a); }
#endif
}
```

```cpp
#include <hip/hip_runtime.h>
#include <hip/hip_cooperative_groups.h>
#include <cstdio>
#include <cstdint>
namespace cg = cooperative_groups;
namespace pg8 {
#define PG8_LAS __attribute__((address_space(3)))
typedef unsigned short bf16_t;
typedef short bf16x8 __attribute__((ext_vector_type(8)));
typedef float f32x4 __attribute__((ext_vector_type(4)));
typedef unsigned u32x4 __attribute__((ext_vector_type(4)));
constexpr int BM = 256, BK = 64, HALF = 128, HTB = HALF * BK * 2  , STAGE_BYTES = 8 * HTB, NXCD = 8, WGM = 8;

__host__ __device__ __forceinline__ int lds_byte(int r, int c) { const int st = (r >> 4) * 2 + (c >> 5), rr = r & 15, cc = c & 31, ob = rr * 64 + cc * 2; return st * 1024 + (ob ^ (((ob >> 9) & 1) << 5)); }
__host__ __device__ __forceinline__ void stage_rc(int b, int& R, int& C) { const int st = b / 1024, sb = b % 1024, swz = sb ^ (((sb >> 9) & 1) << 5); R = (st >> 1) * 16 + swz / 64; C = (st & 1) * 32 + (swz % 64) / 2; }
__host__ __device__ __forceinline__ int perm32(int rho) { const int n = rho >> 4, i = rho & 15; return 8 * (i >> 2) + 4 * n + (i & 3); }

struct Unit { int pm, pn; };
struct Gemm { const bf16_t* A; const bf16_t* Bt; int M, N, K; };

struct StaticOrder {
    int nM, nN, nwg, G, c;
    __host__ __device__ void init(int M, int N, int G_, int c_) { nM = M / BM; nN = N / BM; nwg = nM * nN; G = G_; c = c_; }
    __host__ __device__ bool next(int i, Unit& u) const {
        const long L = (long)i * G + c; if (L >= nwg) return false;
        int wgid = (int)L; { const int q = nwg / NXCD, r = nwg % NXCD, xcd = wgid % NXCD, off = wgid / NXCD; wgid = (xcd < r ? xcd * (q + 1) : r * (q + 1) + (xcd - r) * q) + off; }
        const int nig = WGM * nN, gid = wgid / nig, fm = gid * WGM, gsz = (nM - fm) < WGM ? (nM - fm) : WGM;
        u.pm = fm + ((wgid % nig) % gsz); u.pn = (wgid % nig) / gsz; return true;
    }
    __device__ __forceinline__ void a_ready(const Unit&) const {}
    __device__ __forceinline__ void done(const Unit&) const {}
};

__device__ __forceinline__ unsigned cvt_pk_bf16(float lo, float hi) { unsigned r; asm volatile("v_cvt_pk_bf16_f32 %0, %1, %2" : "=v"(r) : "v"(lo), "v"(hi)); return r; }
typedef float f32x2 __attribute__((ext_vector_type(2)));
__device__ __forceinline__ float bf_lo(unsigned w) { return __uint_as_float(w << 16); }
__device__ __forceinline__ float bf_hi(unsigned w) { return __uint_as_float(w & 0xffff0000u); }
__device__ __forceinline__ float sigmoidf_fast(float v) { return __builtin_amdgcn_rcpf(1.0f + __builtin_amdgcn_exp2f(v * -1.44269504089f)); }

struct EpiProj {
    static constexpr bool PERM = true, AFTER_DRAIN = false;
    bf16_t* lx; bf16_t* sec; size_t sec_stride;
    __device__ __forceinline__ void operator()(const f32x4 (&acc)[2][2][4][2], const Unit& u, int wr, int wc, int fr, int fq) const {
        bf16_t* base; int ldc, colt;
        if (u.pn < 10) { base = lx; ldc = 2560; colt = u.pn * BM; }
        else { const int s = (u.pn - 10) >> 3; base = sec + (size_t)s * sec_stride; ldc = 2048; colt = ((u.pn - 10) & 7) * BM; }
        const int row0 = u.pm * BM + wr * 64 + fr, col0 = colt + wc * 32 + 8 * fq;
#pragma unroll
        for (int ai = 0; ai < 2; ++ai)
#pragma unroll
            for (int m = 0; m < 4; ++m) { bf16_t* rowp = base + (size_t)(row0 + ai * HALF + m * 16) * ldc + col0;
#pragma unroll
                for (int bj = 0; bj < 2; ++bj) { const f32x4 v0 = acc[ai][bj][m][0], v1 = acc[ai][bj][m][1];
                    u32x4 w; w.x = cvt_pk_bf16(v0[0], v0[1]); w.y = cvt_pk_bf16(v0[2], v0[3]); w.z = cvt_pk_bf16(v1[0], v1[1]); w.w = cvt_pk_bf16(v1[2], v1[3]);
                    *(u32x4*)(rowp + bj * HALF) = w; } }
    }
};
struct EpiGate1 {
    static constexpr bool PERM = true, AFTER_DRAIN = false;
    const bf16_t* g; float* t1;
    __device__ __forceinline__ void operator()(const f32x4 (&acc)[2][2][4][2], const Unit& u, int wr, int wc, int fr, int fq) const {
        const int row0 = u.pm * BM + wr * 64 + fr, col0 = u.pn * BM + wc * 32 + 8 * fq;
#pragma unroll
        for (int ai = 0; ai < 2; ++ai)
#pragma unroll
            for (int m = 0; m < 4; ++m) { const size_t off = (size_t)(row0 + ai * HALF + m * 16) * 2048 + col0;
#pragma unroll
                for (int bj = 0; bj < 2; ++bj) { const u32x4 gw = *(const u32x4*)(g + off + bj * HALF);
                    f32x4 s0, s1; s0[0] = sigmoidf_fast(bf_lo(gw.x)); s0[1] = sigmoidf_fast(bf_hi(gw.x)); s0[2] = sigmoidf_fast(bf_lo(gw.y)); s0[3] = sigmoidf_fast(bf_hi(gw.y));
                    s1[0] = sigmoidf_fast(bf_lo(gw.z)); s1[1] = sigmoidf_fast(bf_hi(gw.z)); s1[2] = sigmoidf_fast(bf_lo(gw.w)); s1[3] = sigmoidf_fast(bf_hi(gw.w));
                    *(f32x4*)(t1 + off + bj * HALF) = s0 * acc[ai][bj][m][0]; *(f32x4*)(t1 + off + bj * HALF + 4) = s1 * acc[ai][bj][m][1]; } }
    }
};
struct EpiGate2 {
    static constexpr bool PERM = true, AFTER_DRAIN = false;
    bf16_t* g; const float* t1;
    __device__ __forceinline__ void operator()(const f32x4 (&acc)[2][2][4][2], const Unit& u, int wr, int wc, int fr, int fq) const {
        const int row0 = u.pm * BM + wr * 64 + fr, col0 = u.pn * BM + wc * 32 + 8 * fq;
#pragma unroll
        for (int ai = 0; ai < 2; ++ai)
#pragma unroll
            for (int m = 0; m < 4; ++m) { const size_t off = (size_t)(row0 + ai * HALF + m * 16) * 2048 + col0;
#pragma unroll
                for (int bj = 0; bj < 2; ++bj) { const u32x4 gw = *(const u32x4*)(g + off + bj * HALF);
                    const f32x4 a0 = *(const f32x4*)(t1 + off + bj * HALF), a1 = *(const f32x4*)(t1 + off + bj * HALF + 4);
                    f32x4 s0, s1; s0[0] = sigmoidf_fast(bf_lo(gw.x)); s0[1] = sigmoidf_fast(bf_hi(gw.x)); s0[2] = sigmoidf_fast(bf_lo(gw.y)); s0[3] = sigmoidf_fast(bf_hi(gw.y));
                    s1[0] = sigmoidf_fast(bf_lo(gw.z)); s1[1] = sigmoidf_fast(bf_hi(gw.z)); s1[2] = sigmoidf_fast(bf_lo(gw.w)); s1[3] = sigmoidf_fast(bf_hi(gw.w));
                    const f32x4 v0 = a0 + s0 * acc[ai][bj][m][0], v1 = a1 + s1 * acc[ai][bj][m][1];
                    u32x4 w; w.x = cvt_pk_bf16(v0[0], v0[1]); w.y = cvt_pk_bf16(v0[2], v0[3]); w.z = cvt_pk_bf16(v1[0], v1[1]); w.w = cvt_pk_bf16(v1[2], v1[3]);
                    *(u32x4*)(g + off + bj * HALF) = w; } }
    }
};
struct EpiResStats {
    static constexpr bool PERM = false, AFTER_DRAIN = false;
    const float* base; float* out; const float* bias; f32x2* st; float alpha;
    __device__ __forceinline__ void operator()(const f32x4 (&acc)[2][2][4][2], const Unit& u, int wr, int wc, int fr, int fq) const {
        const int col0 = u.pn * BM + wc * 32 + 4 * fq;
        f32x4 bv[2][2];
#pragma unroll
        for (int bj = 0; bj < 2; ++bj)
#pragma unroll
            for (int n = 0; n < 2; ++n) bv[bj][n] = bias ? *(const f32x4*)(bias + col0 + bj * HALF + n * 16) : (f32x4){0.f, 0.f, 0.f, 0.f};
#pragma unroll
        for (int ai = 0; ai < 2; ++ai)
#pragma unroll
            for (int m = 0; m < 4; ++m) { const int r = u.pm * BM + ai * HALF + wr * 64 + m * 16 + fr; const size_t off = (size_t)r * 2048 + col0;
                f32x4 v[2][2]; float s = 0.f;
#pragma unroll
                for (int bj = 0; bj < 2; ++bj)
#pragma unroll
                    for (int n = 0; n < 2; ++n) { const f32x4 bs = *(const f32x4*)(base + off + bj * HALF + n * 16); v[bj][n] = bs * alpha + acc[ai][bj][m][n] + bv[bj][n]; }
#pragma unroll
                for (int bj = 0; bj < 2; ++bj)
#pragma unroll
                    for (int n = 0; n < 2; ++n) { *(f32x4*)(out + off + bj * HALF + n * 16) = v[bj][n]; s += (v[bj][n][0] + v[bj][n][1]) + (v[bj][n][2] + v[bj][n][3]); }
                s += __shfl_xor(s, 16); s += __shfl_xor(s, 32);
                const float mw = s * (1.0f / 64.0f); float q = 0.f;
#pragma unroll
                for (int bj = 0; bj < 2; ++bj)
#pragma unroll
                    for (int n = 0; n < 2; ++n) { const f32x4 d = v[bj][n] - mw; q += (d[0] * d[0] + d[1] * d[1]) + (d[2] * d[2] + d[3] * d[3]); }
                q += __shfl_xor(q, 16); q += __shfl_xor(q, 32);
                if (fq == 0) st[(size_t)r * 32 + u.pn * 4 + wc] = (f32x2){mw, q};
                asm volatile("" ::: "memory"); }
    }
};
struct EpiRelu2 {
    static constexpr bool PERM = true, AFTER_DRAIN = false;
    bf16_t* O; int ldc; const float* bias;
    __device__ __forceinline__ void operator()(const f32x4 (&acc)[2][2][4][2], const Unit& u, int wr, int wc, int fr, int fq) const {
        const int row0 = u.pm * BM + wr * 64 + fr, col0 = u.pn * BM + wc * 32 + 8 * fq;
        f32x4 bv[2][2];
#pragma unroll
        for (int bj = 0; bj < 2; ++bj)
#pragma unroll
            for (int n = 0; n < 2; ++n) bv[bj][n] = *(const f32x4*)(bias + col0 + bj * HALF + 4 * n);
#pragma unroll
        for (int ai = 0; ai < 2; ++ai)
#pragma unroll
            for (int m = 0; m < 4; ++m) { bf16_t* rowp = O + (size_t)(row0 + ai * HALF + m * 16) * ldc + col0;
#pragma unroll
                for (int bj = 0; bj < 2; ++bj) { f32x4 v0 = acc[ai][bj][m][0] + bv[bj][0], v1 = acc[ai][bj][m][1] + bv[bj][1];
#pragma unroll
                    for (int j = 0; j < 4; ++j) { const float a = fmaxf(v0[j], 0.f), b = fmaxf(v1[j], 0.f); v0[j] = a * a; v1[j] = b * b; }
                    u32x4 w; w.x = cvt_pk_bf16(v0[0], v0[1]); w.y = cvt_pk_bf16(v0[2], v0[3]); w.z = cvt_pk_bf16(v1[0], v1[1]); w.w = cvt_pk_bf16(v1[2], v1[3]);
                    *(u32x4*)(rowp + bj * HALF) = w; } }
    }
};

template <class Epi, class Sched, bool ALIGN_EPI = false, bool SP2 = false>
__device__ __forceinline__ void gemm_phase(PG8_LAS unsigned char* lds, const Gemm g, const Sched& S, const Epi& E) {
    const int tid = threadIdx.x, wid = __builtin_amdgcn_readfirstlane(tid >> 6), lane = tid & 63, wr = wid >> 2, wc = wid & 3, fr = lane & 15, fq = lane >> 4;
    const int K = g.K, nt = K / BK;
    unsigned voffA[2], voffB[2];
#pragma unroll
    for (int i = 0; i < 2; ++i) { int R, C; stage_rc(tid * 16 + i * 8192, R, C); const int Rb = Epi::PERM ? ((R & ~31) + perm32(R & 31)) : R;
        voffA[i] = (unsigned)(R * K + C) * 2u; voffB[i] = (unsigned)(Rb * K + C) * 2u; }
    const size_t kstep = (size_t)(BK * 2);
    const size_t hstep = (size_t)HALF * K * 2;
    const size_t tstep = 2 * hstep;
    const unsigned ldsw = (unsigned)wid * 1024u;
    const int aoff = lds_byte(wr * 64 + fr, fq * 8), boff = lds_byte(wc * 32 + fr, fq * 8);
#define PG8_SA(b, h) (((b) * 2 + (h)) * HTB)
#define PG8_SB(b, h) ((4 + (b) * 2 + (h)) * HTB)
#define PG8_STAGE(bufoff, gbase, voff) do { _Pragma("unroll") for (int _i = 0; _i < 2; ++_i) \
        __builtin_amdgcn_global_load_lds((const unsigned*)((const char*)(gbase) + (voff)[_i]), (PG8_LAS unsigned*)(lds + (bufoff) + ldsw + _i * 8192), 16, 0, 0); } while (0)
#define PG8_LDA(dst, b, h) do { _Pragma("unroll") for (int m = 0; m < 4; ++m) _Pragma("unroll") for (int k = 0; k < 2; ++k) dst[m][k] = *(const PG8_LAS bf16x8*)(lds + PG8_SA(b, h) + aoff + m * 2048 + k * 1024); } while (0)
#define PG8_LDB(dst, b, h) do { _Pragma("unroll") for (int n = 0; n < 2; ++n) _Pragma("unroll") for (int k = 0; k < 2; ++k) dst[n][k] = *(const PG8_LAS bf16x8*)(lds + PG8_SB(b, h) + boff + n * 2048 + k * 1024); } while (0)
#define PG8_MMA(ai, bj, At, Bt) do { __builtin_amdgcn_s_setprio(1); _Pragma("unroll") for (int m = 0; m < 4; ++m) _Pragma("unroll") for (int n = 0; n < 2; ++n) _Pragma("unroll") for (int k = 0; k < 2; ++k) \
        acc[ai][bj][m][n] = __builtin_amdgcn_mfma_f32_16x16x32_bf16(Bt[n][k], At[m][k], acc[ai][bj][m][n], 0, 0, 0); __builtin_amdgcn_s_setprio(0); } while (0)
#define PG8_WAIT_V(n) asm volatile("s_waitcnt vmcnt(" #n ")" ::: "memory")
#define PG8_WAIT_L(n) asm volatile("s_waitcnt lgkmcnt(" #n ")" ::: "memory")
#define PG8_BAR __builtin_amdgcn_s_barrier()
#define PG8_SCHED __builtin_amdgcn_sched_barrier(0)
    Unit cur, nxt; int ui = 0;
    if (!S.next(0, cur)) return;
    f32x4 acc[2][2][4][2];
#pragma unroll
    for (int a = 0; a < 2; ++a)
#pragma unroll
        for (int b = 0; b < 2; ++b)
#pragma unroll
            for (int m = 0; m < 4; ++m)
#pragma unroll
                for (int n = 0; n < 2; ++n) acc[a][b][m][n] = (f32x4){0.f, 0.f, 0.f, 0.f};
    bf16x8 At[4][2], B0[2][2], B1[2][2];
    const char* cA = (const char*)g.A + (size_t)cur.pm * tstep; const char* cB = (const char*)g.Bt + (size_t)cur.pn * tstep;
    S.a_ready(cur);
    if constexpr (SP2) {
        PG8_STAGE(PG8_SB(0, 0), cB, voffB); PG8_STAGE(PG8_SB(0, 1), cB + hstep, voffB); PG8_STAGE(PG8_SA(0, 0), cA, voffA); PG8_STAGE(PG8_SA(0, 1), cA + hstep, voffA);
        if (wr == 1) PG8_BAR;
        PG8_WAIT_V(2); PG8_BAR;
        PG8_STAGE(PG8_SB(1, 0), cB + kstep, voffB); PG8_STAGE(PG8_SA(1, 0), cA + kstep, voffA); PG8_STAGE(PG8_SB(1, 1), cB + hstep + kstep, voffB);
        PG8_WAIT_V(6); PG8_BAR;
    } else {
        PG8_STAGE(PG8_SB(0, 0), cB, voffB); PG8_STAGE(PG8_SA(0, 0), cA, voffA); PG8_STAGE(PG8_SB(0, 1), cB + hstep, voffB); PG8_STAGE(PG8_SA(0, 1), cA + hstep, voffA);
        if (wr == 1) PG8_BAR;
        PG8_WAIT_V(4); PG8_BAR;
        PG8_STAGE(PG8_SB(1, 0), cB + kstep, voffB); PG8_STAGE(PG8_SA(1, 0), cA + kstep, voffA); PG8_STAGE(PG8_SB(1, 1), cB + hstep + kstep, voffB);
        PG8_WAIT_V(6); PG8_BAR;
    }
    for (;;) {
        const bool has_next = S.next(ui + 1, nxt);
        const char* nA = has_next ? (const char*)g.A + (size_t)nxt.pm * tstep : cA; const char* nB = has_next ? (const char*)g.Bt + (size_t)nxt.pn * tstep : cB;
        for (int t = 0; t < nt; t += 2) {
            const bool last = (t == nt - 2);
            const char* a1 = cA + (size_t)(t + 1) * kstep;
            const char* a2 = last ? nA : cA + (size_t)(t + 2) * kstep; const char* b2 = last ? nB : cB + (size_t)(t + 2) * kstep;
            const char* a3 = a2 + kstep; const char* b3 = b2 + kstep;
            if (last && has_next) S.a_ready(nxt);
            if constexpr (SP2) {
            PG8_LDB(B0, 0, 0); PG8_LDB(B1, 0, 1); PG8_SCHED; PG8_LDA(At, 0, 0); PG8_STAGE(PG8_SA(1, 1), a1 + hstep, voffA);
            PG8_WAIT_V(8); PG8_WAIT_L(0); PG8_BAR; PG8_MMA(0, 0, At, B0); PG8_MMA(0, 1, At, B1); PG8_BAR; PG8_SCHED;
            PG8_LDA(At, 0, 1); PG8_STAGE(PG8_SB(0, 0), b2, voffB); PG8_STAGE(PG8_SB(0, 1), b2 + hstep, voffB); PG8_STAGE(PG8_SA(0, 0), a2, voffA);
            PG8_WAIT_V(8); PG8_WAIT_L(0); PG8_BAR; PG8_MMA(1, 0, At, B0); PG8_MMA(1, 1, At, B1); PG8_BAR; PG8_SCHED;
            PG8_LDB(B0, 1, 0); PG8_LDB(B1, 1, 1); PG8_SCHED; PG8_LDA(At, 1, 0); PG8_STAGE(PG8_SA(0, 1), a2 + hstep, voffA);
            PG8_WAIT_V(8); PG8_WAIT_L(0); PG8_BAR; PG8_MMA(0, 0, At, B0); PG8_MMA(0, 1, At, B1); PG8_BAR; PG8_SCHED;
            PG8_LDA(At, 1, 1); PG8_STAGE(PG8_SB(1, 0), b3, voffB); PG8_STAGE(PG8_SB(1, 1), b3 + hstep, voffB); PG8_STAGE(PG8_SA(1, 0), a3, voffA);
            PG8_WAIT_V(8); PG8_WAIT_L(0); PG8_BAR; PG8_MMA(1, 0, At, B0); PG8_MMA(1, 1, At, B1); PG8_BAR; PG8_SCHED;
            } else {
            PG8_LDB(B0, 0, 0); PG8_SCHED; PG8_LDA(At, 0, 0); PG8_STAGE(PG8_SA(1, 1), a1 + hstep, voffA);
            PG8_WAIT_L(8); PG8_BAR; PG8_WAIT_L(0); PG8_MMA(0, 0, At, B0); PG8_BAR; PG8_SCHED;
            PG8_LDB(B1, 0, 1); PG8_STAGE(PG8_SB(0, 0), b2, voffB);
            PG8_BAR; PG8_WAIT_L(0); PG8_MMA(0, 1, At, B1); PG8_BAR;
            PG8_LDA(At, 0, 1); PG8_STAGE(PG8_SA(0, 0), a2, voffA);
            PG8_BAR; PG8_WAIT_L(0); PG8_MMA(1, 0, At, B0); PG8_BAR; PG8_SCHED;
            PG8_STAGE(PG8_SB(0, 1), b2 + hstep, voffB);
            PG8_WAIT_V(6); PG8_BAR; PG8_MMA(1, 1, At, B1); PG8_BAR;
            PG8_LDB(B0, 1, 0); PG8_SCHED; PG8_LDA(At, 1, 0); PG8_STAGE(PG8_SA(0, 1), a2 + hstep, voffA);
            PG8_WAIT_L(8); PG8_BAR; PG8_WAIT_L(0); PG8_MMA(0, 0, At, B0); PG8_BAR; PG8_SCHED;
            PG8_LDB(B1, 1, 1); PG8_STAGE(PG8_SB(1, 0), b3, voffB);
            PG8_BAR; PG8_WAIT_L(0); PG8_MMA(0, 1, At, B1); PG8_BAR;
            PG8_LDA(At, 1, 1); PG8_STAGE(PG8_SA(1, 0), a3, voffA);
            PG8_BAR; PG8_WAIT_L(0); PG8_MMA(1, 0, At, B0); PG8_BAR; PG8_SCHED;
            PG8_STAGE(PG8_SB(1, 1), b3 + hstep, voffB);
            PG8_WAIT_V(6); PG8_BAR; PG8_MMA(1, 1, At, B1); PG8_BAR;
            }
        }
        if constexpr (ALIGN_EPI) { if (wr == 0) PG8_BAR; }
        if constexpr (!Epi::AFTER_DRAIN) { E(acc, cur, wr, wc, fr, fq); S.done(cur); }
        if (!has_next) break;
#pragma unroll
        for (int a = 0; a < 2; ++a)
#pragma unroll
            for (int b = 0; b < 2; ++b)
#pragma unroll
                for (int m = 0; m < 4; ++m)
#pragma unroll
                    for (int n = 0; n < 2; ++n) acc[a][b][m][n] = (f32x4){0.f, 0.f, 0.f, 0.f};
        cur = nxt; cA = nA; cB = nB; ++ui;
        if constexpr (ALIGN_EPI) { if (wr == 1) PG8_BAR; }
    }
    PG8_WAIT_V(0);
    if constexpr (!ALIGN_EPI) { if (wr == 0) PG8_BAR; }
    PG8_BAR;
    if constexpr (Epi::AFTER_DRAIN) { E.fused(acc, cur, wr, wc, fr, fq, lds, wid, lane); S.done(cur); }
#undef PG8_SA
#undef PG8_SB
#undef PG8_STAGE
#undef PG8_LDA
#undef PG8_LDB
#undef PG8_MMA
#undef PG8_WAIT_V
#undef PG8_WAIT_L
#undef PG8_BAR
#undef PG8_SCHED
}
}
#ifndef MK_ONE_LAUNCH
#define MK_ONE_LAUNCH 1
#endif
#ifndef MK_NAIVE_LRU
#define MK_NAIVE_LRU 1
#endif
constexpr int NWAVES = 8, NTHR = NWAVES * 64;
constexpr int NB = 8, SEQ = 2048, MT = NB * SEQ, DM = 2048, LW = 2560, NH = 20, HD = 128, CW = 2048, DFF = 8192, INC = 12800;
constexpr float ALPHA = 1.18920711500272f;
constexpr float LN_EPS = 1e-5f;
constexpr int NPHASE = 9;
constexpr size_t MiB = 1u << 20;
constexpr size_t WS_CTL = 0, CTL_BYTES = 1 * MiB;
constexpr size_t WS_ST1 = 1 * MiB, WS_ST2 = 5 * MiB;
constexpr size_t WS_WG = 9 * MiB;
constexpr size_t WS_WLO = 12 * MiB, WS_WCO = 22 * MiB, WS_WO = 30 * MiB, WS_W1 = 38 * MiB, WS_W2 = 70 * MiB;
constexpr size_t WS_LX = 102 * MiB;
constexpr size_t WS_SEC = 182 * MiB, SEC_BYTES = 64 * MiB;
constexpr size_t WS_T1 = 102 * MiB;
constexpr size_t WS_FF = 102 * MiB;
constexpr size_t WS_H1B = WS_SEC + 3 * SEC_BYTES;
constexpr size_t WS_END = WS_SEC + 5 * SEC_BYTES;
static_assert(WS_FF + (size_t)MT * DFF * 2 <= WS_H1B, "FF overlay must end before H1B");
constexpr size_t DO_XB = 0, DO_WINT = 64 * MiB, DO_HS = 0;
constexpr int CW_ZQ = 64;
constexpr int LDS_BYTES = 147456, MISC_OFF = 131072;

#define GAS __attribute__((address_space(1)))
#define LAS __attribute__((address_space(3)))
typedef unsigned short bf16;
typedef unsigned v4u __attribute__((ext_vector_type(4)));
typedef unsigned v2u __attribute__((ext_vector_type(2)));
typedef float f32x4 __attribute__((ext_vector_type(4)));
typedef float f32x2 __attribute__((ext_vector_type(2)));
#define LDS_WAIT() asm volatile("s_waitcnt lgkmcnt(0)" ::: "memory")
__device__ __forceinline__ unsigned f2bf(float f) { unsigned u = __builtin_bit_cast(unsigned, f); return (u + 0x7fffu + ((u >> 16) & 1u)) >> 16; }
__device__ __forceinline__ unsigned pk2(float lo, float hi) { return f2bf(lo) | (f2bf(hi) << 16); }
__device__ __forceinline__ float bf2f(unsigned short b) { return __uint_as_float(((unsigned)b) << 16); }
__device__ __forceinline__ float bflo(unsigned w) { return __uint_as_float(w << 16); }
__device__ __forceinline__ float bfhi(unsigned w) { return __uint_as_float(w & 0xffff0000u); }

__device__ __forceinline__ void p0_transpose_item(const float* W, int K, int N, bf16* WT, LAS float* scr, int item, int lane) {
    const int nblk = N / 32, kb = item / nblk, nb = item % nblk, k0 = 64 * kb, n0 = 32 * nb;
#pragma unroll 8
    for (int i = 0; i < 32; ++i) { const int kk = 2 * i + (lane >> 5); scr[kk * 33 + (lane & 31)] = W[(size_t)(k0 + kk) * N + n0 + (lane & 31)]; }
    LDS_WAIT(); asm volatile("" ::: "memory");
    const int c = lane & 7;
#pragma unroll
    for (int j = 0; j < 4; ++j) { const int n = (lane >> 3) + 8 * j; const LAS float* s = scr + (8 * c) * 33 + n;
        v4u o; o.x = pk2(s[0 * 33], s[1 * 33]); o.y = pk2(s[2 * 33], s[3 * 33]); o.z = pk2(s[4 * 33], s[5 * 33]); o.w = pk2(s[6 * 33], s[7 * 33]);
        *(v4u*)(WT + (size_t)(n0 + n) * K + k0 + 8 * c) = o; }
    LDS_WAIT(); asm volatile("" ::: "memory");
}

__device__ __forceinline__ void ln_apply_row(const float* vrow, const f32x2* strow, const float* gam, const float* bet, float* outf, bf16* outb, int lane) {
    const f32x2 p = strow[lane & 31];
    float ms = p.x;
#pragma unroll
    for (int o = 1; o < 32; o <<= 1) ms += __shfl_xor(ms, o);
    const float mean = ms * (1.0f / 32.0f);
    const float dm = p.x - mean; float q = p.y + 64.0f * dm * dm;
#pragma unroll
    for (int o = 1; o < 32; o <<= 1) q += __shfl_xor(q, o);
    const float rstd = 1.0f / sqrtf(q * (1.0f / 2048.0f) + LN_EPS);
    const f32x4* v4 = (const f32x4*)vrow; const f32x4* g4 = (const f32x4*)gam; const f32x4* b4 = (const f32x4*)bet;
#pragma unroll
    for (int j = 0; j < 8; ++j) { const int i = 64 * j + lane; const f32x4 x = v4[i]; const f32x4 y = (x - mean) * rstd * g4[i] + b4[i];
        ((f32x4*)outf)[i] = y;
        if (outb) { v2u w; w.x = pk2(y[0], y[1]); w.y = pk2(y[2], y[3]); ((v2u*)outb)[i] = w; } }
}

__device__ __forceinline__ void z_item(int item, const bf16* CX, bf16* CBZ, const bf16* CC, const float* w, const float* bias, int tid) {
    const int cg = tid & 255, rh = tid >> 8, R0 = item * 32 + rh * 16, t0 = R0 & (SEQ - 1), c0 = cg * 8;
    float w0[8], w1[8], w2[8], bb[8];
#pragma unroll
    for (int j = 0; j < 8; ++j) { w0[j] = w[c0 + j]; w1[j] = w[CW + c0 + j]; w2[j] = w[2 * CW + c0 + j]; bb[j] = bias[c0 + j]; }
    float pv[8], cu[8], nx[8];
#define LOADCX(dst, row, ok) do { if (ok) { const v4u a_ = *(const v4u*)(CX + (size_t)(row) * CW + c0), b_ = *(const v4u*)(CC + (size_t)(row) * CW + c0); \
        dst[0] = bflo(a_.x) * bflo(b_.x); dst[1] = bfhi(a_.x) * bfhi(b_.x); dst[2] = bflo(a_.y) * bflo(b_.y); dst[3] = bfhi(a_.y) * bfhi(b_.y); \
        dst[4] = bflo(a_.z) * bflo(b_.z); dst[5] = bfhi(a_.z) * bfhi(b_.z); dst[6] = bflo(a_.w) * bflo(b_.w); dst[7] = bfhi(a_.w) * bfhi(b_.w); } \
        else { _Pragma("unroll") for (int j_ = 0; j_ < 8; ++j_) dst[j_] = 0.f; } } while (0)
    LOADCX(pv, R0 - 1, t0 > 0);
    LOADCX(cu, R0, true);
    for (int i = 0; i < 16; ++i) {
        LOADCX(nx, R0 + i + 1, (t0 + i + 1) < SEQ);
        const v4u cb = *(const v4u*)(CBZ + (size_t)(R0 + i) * CW + c0);
        float z[8];
#pragma unroll
        for (int j = 0; j < 8; ++j) z[j] = w0[j] * pv[j] + w1[j] * cu[j] + w2[j] * nx[j] + bb[j];
        v4u o; o.x = pk2(bflo(cb.x) * z[0], bfhi(cb.x) * z[1]); o.y = pk2(bflo(cb.y) * z[2], bfhi(cb.y) * z[3]); o.z = pk2(bflo(cb.z) * z[4], bfhi(cb.z) * z[5]); o.w = pk2(bflo(cb.w) * z[6], bfhi(cb.w) * z[7]);
        *(v4u*)(CBZ + (size_t)(R0 + i) * CW + c0) = o;
#pragma unroll
        for (int j = 0; j < 8; ++j) { pv[j] = cu[j]; cu[j] = nx[j]; }
    }
#undef LOADCX
}

#if MK_NAIVE_LRU
__device__ __forceinline__ void lru_naive_item(int b, int hd, const bf16* LX, const float* cw, const float* cb, const float* wa, const float* ba, const float* wx, const float* bx,
                                               const float* lam, bf16* HS, LAS float* us, int tid) {
    const int dir = (tid >> 7) & 1, e = tid & 127; const bool act = tid < 256; const int ch = hd * HD + e;
    const float c0 = cw[ch], c1 = cw[LW + ch], c2 = cw[2 * LW + ch], c3 = cw[3 * LW + ch], cbias = cb[ch];
    const float b_a = ba[(dir * NH + hd) * HD + e], b_x = bx[(dir * NH + hd) * HD + e];
    const float kl = -8.0f * log1pf(expf(-lam[dir * LW + ch]));
    const float* Wa = wa + (size_t)(dir * NH + hd) * HD * HD + e; const float* Wx = wx + (size_t)(dir * NH + hd) * HD * HD + e;
    float h = 0.f;
    for (int s = 0; s < SEQ; ++s) {
        const int t = dir ? (SEQ - 1 - s) : s;
        float u = cbias;
        if (act) { const bf16* p = LX + ((size_t)b * SEQ + t) * LW + ch;
            if (t >= 2) u += c0 * bf2f(p[-2 * LW]); if (t >= 1) u += c1 * bf2f(p[-LW]); u += c2 * bf2f(p[0]); if (t + 1 < SEQ) u += c3 * bf2f(p[LW]);
            us[dir * HD + e] = u; }
        __syncthreads();
        if (act) { float ra = b_a, ri = b_x;
            for (int d = 0; d < HD; ++d) { const float ud = us[dir * HD + d]; ra += ud * Wa[d * HD]; ri += ud * Wx[d * HD]; }
            const float r = 1.0f / (1.0f + expf(-ra)), ig = 1.0f / (1.0f + expf(-ri));
            const float la = kl * r, a = expf(la), g = sqrtf(fmaxf(-expm1f(2.0f * la), 0.f)) * (ig * u);
            h = a * h + g;
            bf16* o = HS + ((size_t)b * SEQ + t) * LW + ch;
            if (s < SEQ / 2) *o = (bf16)f2bf(h); else *o = (bf16)f2bf(bf2f(*o) + h); }
        __syncthreads();
    }
}
#endif

struct Args { const float* in[22]; float* out; unsigned char* ws; int ph_lo, ph_hi; };

__global__ void __launch_bounds__(NTHR, 2) mk_fwd(Args args) {
    extern __shared__ __attribute__((aligned(16))) unsigned char lds_raw[];
    LAS unsigned char* lds = (LAS unsigned char*)lds_raw;
    volatile LAS unsigned* MISC = (volatile LAS unsigned*)(lds + MISC_OFF);
    const int tid = threadIdx.x, lane = tid & 63, wave = __builtin_amdgcn_readfirstlane(tid >> 6);
    const int G = gridDim.x, bx = blockIdx.x;
    const int gw = bx * NWAVES + wave, NGW = G * NWAVES;
    unsigned char* ws = args.ws; unsigned char* dob = (unsigned char*)args.out;
    unsigned* ctl = (unsigned*)(ws + WS_CTL);
    const float* x = args.in[0]; const float* w_in = args.in[1]; const float* lru_conv_w = args.in[2]; const float* lru_conv_b = args.in[3];
    const float* lru_w_a = args.in[4]; const float* lru_b_a = args.in[5]; const float* lru_w_x = args.in[6]; const float* lru_b_x = args.in[7];
    const float* lru_lambda = args.in[8]; const float* w_lru_out = args.in[9]; const float* sc_conv_w = args.in[10]; const float* sc_conv_b = args.in[11];
    const float* w_conv_out = args.in[12]; const float* w_o = args.in[13]; const float* ln1_g = args.in[14]; const float* ln1_b = args.in[15];
    const float* mlp_w1 = args.in[16]; const float* mlp_b1 = args.in[17]; const float* mlp_w2 = args.in[18]; const float* mlp_b2 = args.in[19];
    const float* ln2_g = args.in[20]; const float* ln2_b = args.in[21];
    bf16* XB = (bf16*)(dob + DO_XB); bf16* WINT = (bf16*)(dob + DO_WINT); bf16* HS = (bf16*)(dob + DO_HS); float* OUTF = args.out;
    bf16* WG = (bf16*)(ws + WS_WG); bf16* WLO = (bf16*)(ws + WS_WLO); bf16* WCO = (bf16*)(ws + WS_WCO); bf16* WO = (bf16*)(ws + WS_WO); bf16* W1 = (bf16*)(ws + WS_W1); bf16* W2 = (bf16*)(ws + WS_W2);
    bf16* LX = (bf16*)(ws + WS_LX); bf16* SEC = (bf16*)(ws + WS_SEC); constexpr size_t SEC_ELEMS = SEC_BYTES / 2;
    bf16* CXR = SEC; bf16* CBZ = SEC + SEC_ELEMS; bf16* CCC = SEC + 2 * SEC_ELEMS; bf16* GL = SEC + 3 * SEC_ELEMS; bf16* GC = SEC + 4 * SEC_ELEMS;
    float* T1 = (float*)(ws + WS_T1); bf16* FFB = (bf16*)(ws + WS_FF); bf16* H1B = (bf16*)(ws + WS_H1B);
    f32x2* ST1 = (f32x2*)(ws + WS_ST1); f32x2* ST2 = (f32x2*)(ws + WS_ST2);

    const int lo = args.ph_lo, hi = args.ph_hi;
#if MK_ONE_LAUNCH
    cg::grid_group grid = cg::this_grid();
#define SEAM(k) do { if (lo <= (k) && (k) + 1 < hi) grid.sync(); } while (0)
#else
#define SEAM(k) do { } while (0)
#endif
#define IN(k) (lo <= (k) && (k) < hi)

    if (IN(0)) {
        LAS float* scr = (LAS float*)(lds + wave * 8448);
        constexpr int I_IN = (DM / 64) * (INC / 32), I_LO = (LW / 64) * (DM / 32), I_CO = (CW / 64) * (DM / 32), I_O = (DM / 64) * (DM / 32), I_1 = (DM / 64) * (DFF / 32), I_2 = (DFF / 64) * (DM / 32);
        constexpr int I_G = 2 * 2 * NH * 8;
        constexpr int NITEMS = I_IN + I_LO + I_CO + I_O + I_1 + I_2 + I_G;
        for (int it = gw; it < NITEMS; it += NGW) {
            int r = it;
            if (r < I_IN) { p0_transpose_item(w_in, DM, INC, WINT, scr, r, lane); continue; } r -= I_IN;
            if (r < I_LO) { p0_transpose_item(w_lru_out, LW, DM, WLO, scr, r, lane); continue; } r -= I_LO;
            if (r < I_CO) { p0_transpose_item(w_conv_out, CW, DM, WCO, scr, r, lane); continue; } r -= I_CO;
            if (r < I_O) { p0_transpose_item(w_o, DM, DM, WO, scr, r, lane); continue; } r -= I_O;
            if (r < I_1) { p0_transpose_item(mlp_w1, DM, DFF, W1, scr, r, lane); continue; } r -= I_1;
            if (r < I_2) { p0_transpose_item(mlp_w2, DFF, DM, W2, scr, r, lane); continue; } r -= I_2;
            { const int mat = r >> 3, sub = r & 7, gate = mat / (2 * NH), dh = mat % (2 * NH);
              const float* src = (gate ? lru_w_x : lru_w_a) + (size_t)dh * HD * HD;
              p0_transpose_item(src, HD, HD, WG + (size_t)mat * HD * HD, scr, sub, lane); }
        }
        for (int m = gw; m < MT; m += NGW) {
            const f32x4* xr = (const f32x4*)(x + (size_t)m * DM) + lane; v2u* o8 = (v2u*)(XB + (size_t)m * DM) + lane;
#pragma unroll
            for (int j = 0; j < 8; ++j) { const f32x4 v = xr[64 * j]; v2u w; w.x = pk2(v[0], v[1]); w.y = pk2(v[2], v[3]); o8[64 * j] = w; }
        }
    }
    SEAM(0);
    if (IN(1)) {
        pg8::Gemm g{XB, WINT, MT, INC, DM}; pg8::StaticOrder S; S.init(MT, INC, G, bx);
        pg8::EpiProj E{LX, SEC, SEC_ELEMS};
        pg8::gemm_phase<pg8::EpiProj, pg8::StaticOrder, true, true>(lds, g, S, E);
    }
    SEAM(1);
    if (IN(2)) {
#if MK_NAIVE_LRU
        if (bx < NB * NH) lru_naive_item(bx / NH, bx % NH, LX, lru_conv_w, lru_conv_b, lru_w_a, lru_b_a, lru_w_x, lru_b_x, lru_lambda, HS, (LAS float*)(lds), tid);
#endif
        for (;;) {
            __syncthreads();
            if (tid == 0) MISC[0] = atomicAdd(ctl + CW_ZQ, 1u);
            __syncthreads();
            const int item = (int)MISC[0];
            if (item >= MT / 32) break;
            z_item(item, CXR, CBZ, CCC, sc_conv_w, sc_conv_b, tid);
        }
        __syncthreads();
    }
    SEAM(2);
    if (IN(3)) {
        { pg8::Gemm g{HS, WLO, MT, DM, LW}; pg8::StaticOrder S; S.init(MT, DM, G, bx);
          pg8::EpiGate1 E{GL, T1};
          pg8::gemm_phase<pg8::EpiGate1, pg8::StaticOrder, true, true>(lds, g, S, E); }
        __syncthreads();
        { pg8::Gemm g{CBZ, WCO, MT, DM, CW}; pg8::StaticOrder S; S.init(MT, DM, G, bx);
          pg8::EpiGate2 E{GC, T1};
          pg8::gemm_phase<pg8::EpiGate2, pg8::StaticOrder, true, true>(lds, g, S, E); }
    }
    SEAM(3);
    if (IN(4)) {
        pg8::Gemm g{GC, WO, MT, DM, DM}; pg8::StaticOrder S; S.init(MT, DM, G, bx);
        pg8::EpiResStats E{x, OUTF, nullptr, (pg8::f32x2*)ST1, ALPHA};
        pg8::gemm_phase<pg8::EpiResStats, pg8::StaticOrder, true, true>(lds, g, S, E);
    }
    SEAM(4);
    if (IN(5)) {
        for (int m = gw; m < MT; m += NGW) ln_apply_row(OUTF + (size_t)m * DM, ST1 + (size_t)m * 32, ln1_g, ln1_b, OUTF + (size_t)m * DM, H1B + (size_t)m * DM, lane);
    }
    SEAM(5);
    if (IN(6)) {
        pg8::Gemm g{H1B, W1, MT, DFF, DM}; pg8::StaticOrder S; S.init(MT, DFF, G, bx);
        pg8::EpiRelu2 E{FFB, DFF, mlp_b1};
        pg8::gemm_phase<pg8::EpiRelu2, pg8::StaticOrder, true, true>(lds, g, S, E);
    }
    SEAM(6);
    if (IN(7)) {
        pg8::Gemm g{FFB, W2, MT, DM, DFF}; pg8::StaticOrder S; S.init(MT, DM, G, bx);
        pg8::EpiResStats E{OUTF, OUTF, mlp_b2, (pg8::f32x2*)ST2, ALPHA};
        pg8::gemm_phase<pg8::EpiResStats, pg8::StaticOrder, true, true>(lds, g, S, E);
    }
    SEAM(7);
    if (IN(8)) {
        for (int m = gw; m < MT; m += NGW) ln_apply_row(OUTF + (size_t)m * DM, ST2 + (size_t)m * 32, ln2_g, ln2_b, OUTF + (size_t)m * DM, nullptr, lane);
    }
#undef IN
#undef SEAM
}

extern "C" void kernel_launch(void* const* d_in, const int* in_sizes, int n_in, void* d_out, int out_size, void* d_ws, size_t ws_size, hipStream_t stream) {
    static int grid = 0;
    if (grid == 0) {
        if (n_in != 22 || in_sizes[0] != MT * DM || out_size != MT * DM || ws_size < WS_END) {
            fprintf(stderr, "kernel_launch: unexpected shapes (n_in %d, in0 %d, out %d, ws %zu; need ws >= %zu)\n", n_in, n_in > 0 ? in_sizes[0] : -1, out_size, ws_size, (size_t)WS_END); grid = -1; return; }
        int dev = 0, cus = 0, per_cu = 0;
        if (hipGetDevice(&dev) != hipSuccess || hipDeviceGetAttribute(&cus, hipDeviceAttributeMultiprocessorCount, dev) != hipSuccess) { grid = -1; return; }
        if (hipFuncSetAttribute((const void*)mk_fwd, hipFuncAttributeMaxDynamicSharedMemorySize, LDS_BYTES) != hipSuccess) { fprintf(stderr, "kernel_launch: hipFuncSetAttribute failed\n"); grid = -1; return; }
        if (hipOccupancyMaxActiveBlocksPerMultiprocessor(&per_cu, (const void*)mk_fwd, NTHR, LDS_BYTES) != hipSuccess || per_cu < 1) { fprintf(stderr, "kernel_launch: occupancy query says %d blocks/CU\n", per_cu); (void)hipGetLastError(); grid = -1; return; }
        grid = cus * 1;
        fprintf(stderr, "kernel_launch: %d CUs, occupancy %d blocks/CU, grid %d\n", cus, per_cu, grid);
    }
    if (grid < 0) return;
    (void)hipMemsetAsync((char*)d_ws + WS_CTL, 0, CTL_BYTES, stream);
    Args a{};
    for (int i = 0; i < 22; ++i) a.in[i] = (const float*)d_in[i];
    a.out = (float*)d_out; a.ws = (unsigned char*)d_ws;
#if MK_ONE_LAUNCH
    a.ph_lo = 0; a.ph_hi = NPHASE;
    void* kargs[] = {&a};
    hipError_t e = hipLaunchCooperativeKernel((const void*)mk_fwd, dim3(grid), dim3(NTHR), kargs, LDS_BYTES, stream);
    if (e != hipSuccess) fprintf(stderr, "kernel_launch: cooperative launch failed: %s (grid %d)\n", hipGetErrorString(e), grid);
#else
    for (int p = 0; p < NPHASE; ++p) { a.ph_lo = p; a.ph_hi = p + 1; hipLaunchKernelGGL(mk_fwd, dim3(grid), dim3(NTHR), LDS_BYTES, stream, a); }
#endif
}
```

```cpp
#include <hip/hip_runtime.h>
#include <hip/hip_cooperative_groups.h>
#include <cstdio>
#include <cstdint>
namespace cg = cooperative_groups;
namespace pg8 {
#define PG8_LAS __attribute__((address_space(3)))
typedef unsigned short bf16_t;
typedef short bf16x8 __attribute__((ext_vector_type(8)));
typedef float f32x4 __attribute__((ext_vector_type(4)));
typedef unsigned u32x4 __attribute__((ext_vector_type(4)));
constexpr int BM = 256, BK = 64, HALF = 128, HTB = HALF * BK * 2  , STAGE_BYTES = 8 * HTB, NXCD = 8, WGM = 8;

__host__ __device__ __forceinline__ int lds_byte(int r, int c) { const int st = (r >> 4) * 2 + (c >> 5), rr = r & 15, cc = c & 31, ob = rr * 64 + cc * 2; return st * 1024 + (ob ^ (((ob >> 9) & 1) << 5)); }
__host__ __device__ __forceinline__ void stage_rc(int b, int& R, int& C) { const int st = b / 1024, sb = b % 1024, swz = sb ^ (((sb >> 9) & 1) << 5); R = (st >> 1) * 16 + swz / 64; C = (st & 1) * 32 + (swz % 64) / 2; }
__host__ __device__ __forceinline__ int perm32(int rho) { const int n = rho >> 4, i = rho & 15; return 8 * (i >> 2) + 4 * n + (i & 3); }

struct Unit { int pm, pn; };
struct Gemm { const bf16_t* A; const bf16_t* Bt; int M, N, K; };

struct StaticOrder {
    int nM, nN, nwg, G, c;
    __host__ __device__ void init(int M, int N, int G_, int c_) { nM = M / BM; nN = N / BM; nwg = nM * nN; G = G_; c = c_; }
    __host__ __device__ bool next(int i, Unit& u) const {
        const long L = (long)i * G + c; if (L >= nwg) return false;
        int wgid = (int)L; { const int q = nwg / NXCD, r = nwg % NXCD, xcd = wgid % NXCD, off = wgid / NXCD; wgid = (xcd < r ? xcd * (q + 1) : r * (q + 1) + (xcd - r) * q) + off; }
        const int nig = WGM * nN, gid = wgid / nig, fm = gid * WGM, gsz = (nM - fm) < WGM ? (nM - fm) : WGM;
        u.pm = fm + ((wgid % nig) % gsz); u.pn = (wgid % nig) / gsz; return true;
    }
    __device__ __forceinline__ void a_ready(const Unit&) const {}
    __device__ __forceinline__ void done(const Unit&) const {}
};

__device__ __forceinline__ unsigned cvt_pk_bf16(float lo, float hi) { unsigned r; asm volatile("v_cvt_pk_bf16_f32 %0, %1, %2" : "=v"(r) : "v"(lo), "v"(hi)); return r; }
typedef float f32x2 __attribute__((ext_vector_type(2)));
__device__ __forceinline__ float bf_lo(unsigned w) { return __uint_as_float(w << 16); }
__device__ __forceinline__ float bf_hi(unsigned w) { return __uint_as_float(w & 0xffff0000u); }
__device__ __forceinline__ float sigmoidf_fast(float v) { return __builtin_amdgcn_rcpf(1.0f + __builtin_amdgcn_exp2f(v * -1.44269504089f)); }

struct EpiProj {
    static constexpr bool PERM = true, AFTER_DRAIN = false;
    bf16_t* lx; bf16_t* sec; size_t sec_stride;
    __device__ __forceinline__ void operator()(const f32x4 (&acc)[2][2][4][2], const Unit& u, int wr, int wc, int fr, int fq) const {
        bf16_t* base; int ldc, colt;
        if (u.pn < 10) { base = lx; ldc = 2560; colt = u.pn * BM; }
        else { const int s = (u.pn - 10) >> 3; base = sec + (size_t)s * sec_stride; ldc = 2048; colt = ((u.pn - 10) & 7) * BM; }
        const int row0 = u.pm * BM + wr * 64 + fr, col0 = colt + wc * 32 + 8 * fq;
#pragma unroll
        for (int ai = 0; ai < 2; ++ai)
#pragma unroll
            for (int m = 0; m < 4; ++m) { bf16_t* rowp = base + (size_t)(row0 + ai * HALF + m * 16) * ldc + col0;
#pragma unroll
                for (int bj = 0; bj < 2; ++bj) { const f32x4 v0 = acc[ai][bj][m][0], v1 = acc[ai][bj][m][1];
                    u32x4 w; w.x = cvt_pk_bf16(v0[0], v0[1]); w.y = cvt_pk_bf16(v0[2], v0[3]); w.z = cvt_pk_bf16(v1[0], v1[1]); w.w = cvt_pk_bf16(v1[2], v1[3]);
                    *(u32x4*)(rowp + bj * HALF) = w; } }
    }
};
struct EpiGate1 {
    static constexpr bool PERM = true, AFTER_DRAIN = false;
    const bf16_t* g; float* t1;
    __device__ __forceinline__ void operator()(const f32x4 (&acc)[2][2][4][2], const Unit& u, int wr, int wc, int fr, int fq) const {
        const int row0 = u.pm * BM + wr * 64 + fr, col0 = u.pn * BM + wc * 32 + 8 * fq;
#pragma unroll
        for (int ai = 0; ai < 2; ++ai)
#pragma unroll
            for (int m = 0; m < 4; ++m) { const size_t off = (size_t)(row0 + ai * HALF + m * 16) * 2048 + col0;
#pragma unroll
                for (int bj = 0; bj < 2; ++bj) { const u32x4 gw = *(const u32x4*)(g + off + bj * HALF);
                    f32x4 s0, s1; s0[0] = sigmoidf_fast(bf_lo(gw.x)); s0[1] = sigmoidf_fast(bf_hi(gw.x)); s0[2] = sigmoidf_fast(bf_lo(gw.y)); s0[3] = sigmoidf_fast(bf_hi(gw.y));
                    s1[0] = sigmoidf_fast(bf_lo(gw.z)); s1[1] = sigmoidf_fast(bf_hi(gw.z)); s1[2] = sigmoidf_fast(bf_lo(gw.w)); s1[3] = sigmoidf_fast(bf_hi(gw.w));
                    *(f32x4*)(t1 + off + bj * HALF) = s0 * acc[ai][bj][m][0]; *(f32x4*)(t1 + off + bj * HALF + 4) = s1 * acc[ai][bj][m][1]; } }
    }
};
struct EpiGate2 {
    static constexpr bool PERM = true, AFTER_DRAIN = false;
    bf16_t* g; const float* t1;
    __device__ __forceinline__ void operator()(const f32x4 (&acc)[2][2][4][2], const Unit& u, int wr, int wc, int fr, int fq) const {
        const int row0 = u.pm * BM + wr * 64 + fr, col0 = u.pn * BM + wc * 32 + 8 * fq;
#pragma unroll
        for (int ai = 0; ai < 2; ++ai)
#pragma unroll
            for (int m = 0; m < 4; ++m) { const size_t off = (size_t)(row0 + ai * HALF + m * 16) * 2048 + col0;
#pragma unroll
                for (int bj = 0; bj < 2; ++bj) { const u32x4 gw = *(const u32x4*)(g + off + bj * HALF);
                    const f32x4 a0 = *(const f32x4*)(t1 + off + bj * HALF), a1 = *(const f32x4*)(t1 + off + bj * HALF + 4);
                    f32x4 s0, s1; s0[0] = sigmoidf_fast(bf_lo(gw.x)); s0[1] = sigmoidf_fast(bf_hi(gw.x)); s0[2] = sigmoidf_fast(bf_lo(gw.y)); s0[3] = sigmoidf_fast(bf_hi(gw.y));
                    s1[0] = sigmoidf_fast(bf_lo(gw.z)); s1[1] = sigmoidf_fast(bf_hi(gw.z)); s1[2] = sigmoidf_fast(bf_lo(gw.w)); s1[3] = sigmoidf_fast(bf_hi(gw.w));
                    const f32x4 v0 = a0 + s0 * acc[ai][bj][m][0], v1 = a1 + s1 * acc[ai][bj][m][1];
                    u32x4 w; w.x = cvt_pk_bf16(v0[0], v0[1]); w.y = cvt_pk_bf16(v0[2], v0[3]); w.z = cvt_pk_bf16(v1[0], v1[1]); w.w = cvt_pk_bf16(v1[2], v1[3]);
                    *(u32x4*)(g + off + bj * HALF) = w; } }
    }
};
struct EpiResStats {
    static constexpr bool PERM = false, AFTER_DRAIN = false;
    const float* base; float* out; const float* bias; f32x2* st; float alpha;
    __device__ __forceinline__ void operator()(const f32x4 (&acc)[2][2][4][2], const Unit& u, int wr, int wc, int fr, int fq) const {
        const int col0 = u.pn * BM + wc * 32 + 4 * fq;
        f32x4 bv[2][2];
#pragma unroll
        for (int bj = 0; bj < 2; ++bj)
#pragma unroll
            for (int n = 0; n < 2; ++n) bv[bj][n] = bias ? *(const f32x4*)(bias + col0 + bj * HALF + n * 16) : (f32x4){0.f, 0.f, 0.f, 0.f};
#pragma unroll
        for (int ai = 0; ai < 2; ++ai)
#pragma unroll
            for (int m = 0; m < 4; ++m) { const int r = u.pm * BM + ai * HALF + wr * 64 + m * 16 + fr; const size_t off = (size_t)r * 2048 + col0;
                f32x4 v[2][2]; float s = 0.f;
#pragma unroll
                for (int bj = 0; bj < 2; ++bj)
#pragma unroll
                    for (int n = 0; n < 2; ++n) { const f32x4 bs = *(const f32x4*)(base + off + bj * HALF + n * 16); v[bj][n] = bs * alpha + acc[ai][bj][m][n] + bv[bj][n]; }
#pragma unroll
                for (int bj = 0; bj < 2; ++bj)
#pragma unroll
                    for (int n = 0; n < 2; ++n) { *(f32x4*)(out + off + bj * HALF + n * 16) = v[bj][n]; s += (v[bj][n][0] + v[bj][n][1]) + (v[bj][n][2] + v[bj][n][3]); }
                s += __shfl_xor(s, 16); s += __shfl_xor(s, 32);
                const float mw = s * (1.0f / 64.0f); float q = 0.f;
#pragma unroll
                for (int bj = 0; bj < 2; ++bj)
#pragma unroll
                    for (int n = 0; n < 2; ++n) { const f32x4 d = v[bj][n] - mw; q += (d[0] * d[0] + d[1] * d[1]) + (d[2] * d[2] + d[3] * d[3]); }
                q += __shfl_xor(q, 16); q += __shfl_xor(q, 32);
                if (fq == 0) st[(size_t)r * 32 + u.pn * 4 + wc] = (f32x2){mw, q};
                asm volatile("" ::: "memory"); }
    }
};
struct EpiRelu2 {
    static constexpr bool PERM = true, AFTER_DRAIN = false;
    bf16_t* O; int ldc; const float* bias;
    __device__ __forceinline__ void operator()(const f32x4 (&acc)[2][2][4][2], const Unit& u, int wr, int wc, int fr, int fq) const {
        const int row0 = u.pm * BM + wr * 64 + fr, col0 = u.pn * BM + wc * 32 + 8 * fq;
        f32x4 bv[2][2];
#pragma unroll
        for (int bj = 0; bj < 2; ++bj)
#pragma unroll
            for (int n = 0; n < 2; ++n) bv[bj][n] = *(const f32x4*)(bias + col0 + bj * HALF + 4 * n);
#pragma unroll
        for (int ai = 0; ai < 2; ++ai)
#pragma unroll
            for (int m = 0; m < 4; ++m) { bf16_t* rowp = O + (size_t)(row0 + ai * HALF + m * 16) * ldc + col0;
#pragma unroll
                for (int bj = 0; bj < 2; ++bj) { f32x4 v0 = acc[ai][bj][m][0] + bv[bj][0], v1 = acc[ai][bj][m][1] + bv[bj][1];
#pragma unroll
                    for (int j = 0; j < 4; ++j) { const float a = fmaxf(v0[j], 0.f), b = fmaxf(v1[j], 0.f); v0[j] = a * a; v1[j] = b * b; }
                    u32x4 w; w.x = cvt_pk_bf16(v0[0], v0[1]); w.y = cvt_pk_bf16(v0[2], v0[3]); w.z = cvt_pk_bf16(v1[0], v1[1]); w.w = cvt_pk_bf16(v1[2], v1[3]);
                    *(u32x4*)(rowp + bj * HALF) = w; } }
    }
};

template <class Epi, class Sched, bool ALIGN_EPI = false, bool SP2 = false>
__device__ __forceinline__ void gemm_phase(PG8_LAS unsigned char* lds, const Gemm g, const Sched& S, const Epi& E) {
    const int tid = threadIdx.x, wid = __builtin_amdgcn_readfirstlane(tid >> 6), lane = tid & 63, wr = wid >> 2, wc = wid & 3, fr = lane & 15, fq = lane >> 4;
    const int K = g.K, nt = K / BK;
    unsigned voffA[2], voffB[2];
#pragma unroll
    for (int i = 0; i < 2; ++i) { int R, C; stage_rc(tid * 16 + i * 8192, R, C); const int Rb = Epi::PERM ? ((R & ~31) + perm32(R & 31)) : R;
        voffA[i] = (unsigned)(R * K + C) * 2u; voffB[i] = (unsigned)(Rb * K + C) * 2u; }
    const size_t kstep = (size_t)(BK * 2);
    const size_t hstep = (size_t)HALF * K * 2;
    const size_t tstep = 2 * hstep;
    const unsigned ldsw = (unsigned)wid * 1024u;
    const int aoff = lds_byte(wr * 64 + fr, fq * 8), boff = lds_byte(wc * 32 + fr, fq * 8);
#define PG8_SA(b, h) (((b) * 2 + (h)) * HTB)
#define PG8_SB(b, h) ((4 + (b) * 2 + (h)) * HTB)
#define PG8_STAGE(bufoff, gbase, voff) do { _Pragma("unroll") for (int _i = 0; _i < 2; ++_i) \
        __builtin_amdgcn_global_load_lds((const unsigned*)((const char*)(gbase) + (voff)[_i]), (PG8_LAS unsigned*)(lds + (bufoff) + ldsw + _i * 8192), 16, 0, 0); } while (0)
#define PG8_LDA(dst, b, h) do { _Pragma("unroll") for (int m = 0; m < 4; ++m) _Pragma("unroll") for (int k = 0; k < 2; ++k) dst[m][k] = *(const PG8_LAS bf16x8*)(lds + PG8_SA(b, h) + aoff + m * 2048 + k * 1024); } while (0)
#define PG8_LDB(dst, b, h) do { _Pragma("unroll") for (int n = 0; n < 2; ++n) _Pragma("unroll") for (int k = 0; k < 2; ++k) dst[n][k] = *(const PG8_LAS bf16x8*)(lds + PG8_SB(b, h) + boff + n * 2048 + k * 1024); } while (0)
#define PG8_MMA(ai, bj, At, Bt) do { __builtin_amdgcn_s_setprio(1); _Pragma("unroll") for (int m = 0; m < 4; ++m) _Pragma("unroll") for (int n = 0; n < 2; ++n) _Pragma("unroll") for (int k = 0; k < 2; ++k) \
        acc[ai][bj][m][n] = __builtin_amdgcn_mfma_f32_16x16x32_bf16(Bt[n][k], At[m][k], acc[ai][bj][m][n], 0, 0, 0); __builtin_amdgcn_s_setprio(0); } while (0)
#define PG8_WAIT_V(n) asm volatile("s_waitcnt vmcnt(" #n ")" ::: "memory")
#define PG8_WAIT_L(n) asm volatile("s_waitcnt lgkmcnt(" #n ")" ::: "memory")
#define PG8_BAR __builtin_amdgcn_s_barrier()
#define PG8_SCHED __builtin_amdgcn_sched_barrier(0)
    Unit cur, nxt; int ui = 0;
    if (!S.next(0, cur)) return;
    f32x4 acc[2][2][4][2];
#pragma unroll
    for (int a = 0; a < 2; ++a)
#pragma unroll
        for (int b = 0; b < 2; ++b)
#pragma unroll
            for (int m = 0; m < 4; ++m)
#pragma unroll
                for (int n = 0; n < 2; ++n) acc[a][b][m][n] = (f32x4){0.f, 0.f, 0.f, 0.f};
    bf16x8 At[4][2], B0[2][2], B1[2][2];
    const char* cA = (const char*)g.A + (size_t)cur.pm * tstep; const char* cB = (const char*)g.Bt + (size_t)cur.pn * tstep;
    S.a_ready(cur);
    if constexpr (SP2) {
        PG8_STAGE(PG8_SB(0, 0), cB, voffB); PG8_STAGE(PG8_SB(0, 1), cB + hstep, voffB); PG8_STAGE(PG8_SA(0, 0), cA, voffA); PG8_STAGE(PG8_SA(0, 1), cA + hstep, voffA);
        if (wr == 1) PG8_BAR;
        PG8_WAIT_V(2); PG8_BAR;
        PG8_STAGE(PG8_SB(1, 0), cB + kstep, voffB); PG8_STAGE(PG8_SA(1, 0), cA + kstep, voffA); PG8_STAGE(PG8_SB(1, 1), cB + hstep + kstep, voffB);
        PG8_WAIT_V(6); PG8_BAR;
    } else {
        PG8_STAGE(PG8_SB(0, 0), cB, voffB); PG8_STAGE(PG8_SA(0, 0), cA, voffA); PG8_STAGE(PG8_SB(0, 1), cB + hstep, voffB); PG8_STAGE(PG8_SA(0, 1), cA + hstep, voffA);
        if (wr == 1) PG8_BAR;
        PG8_WAIT_V(4); PG8_BAR;
        PG8_STAGE(PG8_SB(1, 0), cB + kstep, voffB); PG8_STAGE(PG8_SA(1, 0), cA + kstep, voffA); PG8_STAGE(PG8_SB(1, 1), cB + hstep + kstep, voffB);
        PG8_WAIT_V(6); PG8_BAR;
    }
    for (;;) {
        const bool has_next = S.next(ui + 1, nxt);
        const char* nA = has_next ? (const char*)g.A + (size_t)nxt.pm * tstep : cA; const char* nB = has_next ? (const char*)g.Bt + (size_t)nxt.pn * tstep : cB;
        for (int t = 0; t < nt; t += 2) {
            const bool last = (t == nt - 2);
            const char* a1 = cA + (size_t)(t + 1) * kstep;
            const char* a2 = last ? nA : cA + (size_t)(t + 2) * kstep; const char* b2 = last ? nB : cB + (size_t)(t + 2) * kstep;
            const char* a3 = a2 + kstep; const char* b3 = b2 + kstep;
            if (last && has_next) S.a_ready(nxt);
            if constexpr (SP2) {
            PG8_LDB(B0, 0, 0); PG8_LDB(B1, 0, 1); PG8_SCHED; PG8_LDA(At, 0, 0); PG8_STAGE(PG8_SA(1, 1), a1 + hstep, voffA);
            PG8_WAIT_V(8); PG8_WAIT_L(0); PG8_BAR; PG8_MMA(0, 0, At, B0); PG8_MMA(0, 1, At, B1); PG8_BAR; PG8_SCHED;
            PG8_LDA(At, 0, 1); PG8_STAGE(PG8_SB(0, 0), b2, voffB); PG8_STAGE(PG8_SB(0, 1), b2 + hstep, voffB); PG8_STAGE(PG8_SA(0, 0), a2, voffA);
            PG8_WAIT_V(8); PG8_WAIT_L(0); PG8_BAR; PG8_MMA(1, 0, At, B0); PG8_MMA(1, 1, At, B1); PG8_BAR; PG8_SCHED;
            PG8_LDB(B0, 1, 0); PG8_LDB(B1, 1, 1); PG8_SCHED; PG8_LDA(At, 1, 0); PG8_STAGE(PG8_SA(0, 1), a2 + hstep, voffA);
            PG8_WAIT_V(8); PG8_WAIT_L(0); PG8_BAR; PG8_MMA(0, 0, At, B0); PG8_MMA(0, 1, At, B1); PG8_BAR; PG8_SCHED;
            PG8_LDA(At, 1, 1); PG8_STAGE(PG8_SB(1, 0), b3, voffB); PG8_STAGE(PG8_SB(1, 1), b3 + hstep, voffB); PG8_STAGE(PG8_SA(1, 0), a3, voffA);
            PG8_WAIT_V(8); PG8_WAIT_L(0); PG8_BAR; PG8_MMA(1, 0, At, B0); PG8_MMA(1, 1, At, B1); PG8_BAR; PG8_SCHED;
            } else {
            PG8_LDB(B0, 0, 0); PG8_SCHED; PG8_LDA(At, 0, 0); PG8_STAGE(PG8_SA(1, 1), a1 + hstep, voffA);
            PG8_WAIT_L(8); PG8_BAR; PG8_WAIT_L(0); PG8_MMA(0, 0, At, B0); PG8_BAR; PG8_SCHED;
            PG8_LDB(B1, 0, 1); PG8_STAGE(PG8_SB(0, 0), b2, voffB);
            PG8_BAR; PG8_WAIT_L(0); PG8_MMA(0, 1, At, B1); PG8_BAR;
            PG8_LDA(At, 0, 1); PG8_STAGE(PG8_SA(0, 0), a2, voffA);
            PG8_BAR; PG8_WAIT_L(0); PG8_MMA(1, 0, At, B0); PG8_BAR; PG8_SCHED;
            PG8_STAGE(PG8_SB(0, 1), b2 + hstep, voffB);
            PG8_WAIT_V(6); PG8_BAR; PG8_MMA(1, 1, At, B1); PG8_BAR;
            PG8_LDB(B0, 1, 0); PG8_SCHED; PG8_LDA(At, 1, 0); PG8_STAGE(PG8_SA(0, 1), a2 + hstep, voffA);
            PG8_WAIT_L(8); PG8_BAR; PG8_WAIT_L(0); PG8_MMA(0, 0, At, B0); PG8_BAR; PG8_SCHED;
            PG8_LDB(B1, 1, 1); PG8_STAGE(PG8_SB(1, 0), b3, voffB);
            PG8_BAR; PG8_WAIT_L(0); PG8_MMA(0, 1, At, B1); PG8_BAR;
            PG8_LDA(At, 1, 1); PG8_STAGE(PG8_SA(1, 0), a3, voffA);
            PG8_BAR; PG8_WAIT_L(0); PG8_MMA(1, 0, At, B0); PG8_BAR; PG8_SCHED;
            PG8_STAGE(PG8_SB(1, 1), b3 + hstep, voffB);
            PG8_WAIT_V(6); PG8_BAR; PG8_MMA(1, 1, At, B1); PG8_BAR;
            }
        }
        if constexpr (ALIGN_EPI) { if (wr == 0) PG8_BAR; }
        if constexpr (!Epi::AFTER_DRAIN) { E(acc, cur, wr, wc, fr, fq); S.done(cur); }
        if (!has_next) break;
#pragma unroll
        for (int a = 0; a < 2; ++a)
#pragma unroll
            for (int b = 0; b < 2; ++b)
#pragma unroll
                for (int m = 0; m < 4; ++m)
#pragma unroll
                    for (int n = 0; n < 2; ++n) acc[a][b][m][n] = (f32x4){0.f, 0.f, 0.f, 0.f};
        cur = nxt; cA = nA; cB = nB; ++ui;
        if constexpr (ALIGN_EPI) { if (wr == 1) PG8_BAR; }
    }
    PG8_WAIT_V(0);
    if constexpr (!ALIGN_EPI) { if (wr == 0) PG8_BAR; }
    PG8_BAR;
    if constexpr (Epi::AFTER_DRAIN) { E.fused(acc, cur, wr, wc, fr, fq, lds, wid, lane); S.done(cur); }
#undef PG8_SA
#undef PG8_SB
#undef PG8_STAGE
#undef PG8_LDA
#undef PG8_LDB
#undef PG8_MMA
#undef PG8_WAIT_V
#undef PG8_WAIT_L
#undef PG8_BAR
#undef PG8_SCHED
}
}
#ifndef MK_ONE_LAUNCH
#define MK_ONE_LAUNCH 1
#endif
#ifndef MK_NAIVE_LRU
#define MK_NAIVE_LRU 0
#endif
constexpr int NWAVES = 8, NTHR = NWAVES * 64;
constexpr int NB = 8, SEQ = 2048, MT = NB * SEQ, DM = 2048, LW = 2560, NH = 20, HD = 128, CW = 2048, DFF = 8192, INC = 12800;
constexpr float ALPHA = 1.18920711500272f;
constexpr float LN_EPS = 1e-5f;
constexpr int NPHASE = 9;
constexpr size_t MiB = 1u << 20;
constexpr size_t WS_CTL = 0, CTL_BYTES = 1 * MiB;
constexpr size_t WS_ST1 = 1 * MiB, WS_ST2 = 5 * MiB;
constexpr size_t WS_WG = 9 * MiB;
constexpr size_t WS_WLO = 12 * MiB, WS_WCO = 22 * MiB, WS_WO = 30 * MiB, WS_W1 = 38 * MiB, WS_W2 = 70 * MiB;
constexpr size_t WS_LX = 102 * MiB;
constexpr size_t WS_SEC = 182 * MiB, SEC_BYTES = 64 * MiB;
constexpr size_t WS_T1 = 102 * MiB;
constexpr size_t WS_FF = 102 * MiB;
constexpr size_t WS_H1B = WS_SEC + 3 * SEC_BYTES;
constexpr size_t WS_END = WS_SEC + 5 * SEC_BYTES;
static_assert(WS_FF + (size_t)MT * DFF * 2 <= WS_H1B, "FF overlay must end before H1B");
constexpr size_t DO_XB = 0, DO_WINT = 64 * MiB, DO_HS = 0;
constexpr int CW_ZQ = 64;
constexpr int LDS_BYTES = 147456, MISC_OFF = 131072;

#define GAS __attribute__((address_space(1)))
#define LAS __attribute__((address_space(3)))
typedef unsigned short bf16;
typedef unsigned v4u __attribute__((ext_vector_type(4)));
typedef unsigned v2u __attribute__((ext_vector_type(2)));
typedef float f32x4 __attribute__((ext_vector_type(4)));
typedef float f32x2 __attribute__((ext_vector_type(2)));
#define LDS_WAIT() asm volatile("s_waitcnt lgkmcnt(0)" ::: "memory")
__device__ __forceinline__ unsigned f2bf(float f) { unsigned u = __builtin_bit_cast(unsigned, f); return (u + 0x7fffu + ((u >> 16) & 1u)) >> 16; }
__device__ __forceinline__ unsigned pk2(float lo, float hi) { return f2bf(lo) | (f2bf(hi) << 16); }
__device__ __forceinline__ float bf2f(unsigned short b) { return __uint_as_float(((unsigned)b) << 16); }
__device__ __forceinline__ float bflo(unsigned w) { return __uint_as_float(w << 16); }
__device__ __forceinline__ float bfhi(unsigned w) { return __uint_as_float(w & 0xffff0000u); }

__device__ __forceinline__ void p0_transpose_item(const float* W, int K, int N, bf16* WT, LAS float* scr, int item, int lane) {
    const int nblk = N / 32, kb = item / nblk, nb = item % nblk, k0 = 64 * kb, n0 = 32 * nb;
#pragma unroll 8
    for (int i = 0; i < 32; ++i) { const int kk = 2 * i + (lane >> 5); scr[kk * 33 + (lane & 31)] = W[(size_t)(k0 + kk) * N + n0 + (lane & 31)]; }
    LDS_WAIT(); asm volatile("" ::: "memory");
    const int c = lane & 7;
#pragma unroll
    for (int j = 0; j < 4; ++j) { const int n = (lane >> 3) + 8 * j; const LAS float* s = scr + (8 * c) * 33 + n;
        v4u o; o.x = pk2(s[0 * 33], s[1 * 33]); o.y = pk2(s[2 * 33], s[3 * 33]); o.z = pk2(s[4 * 33], s[5 * 33]); o.w = pk2(s[6 * 33], s[7 * 33]);
        *(v4u*)(WT + (size_t)(n0 + n) * K + k0 + 8 * c) = o; }
    LDS_WAIT(); asm volatile("" ::: "memory");
}

__device__ __forceinline__ void ln_apply_row(const float* vrow, const f32x2* strow, const float* gam, const float* bet, float* outf, bf16* outb, int lane) {
    const f32x2 p = strow[lane & 31];
    float ms = p.x;
#pragma unroll
    for (int o = 1; o < 32; o <<= 1) ms += __shfl_xor(ms, o);
    const float mean = ms * (1.0f / 32.0f);
    const float dm = p.x - mean; float q = p.y + 64.0f * dm * dm;
#pragma unroll
    for (int o = 1; o < 32; o <<= 1) q += __shfl_xor(q, o);
    const float rstd = 1.0f / sqrtf(q * (1.0f / 2048.0f) + LN_EPS);
    const f32x4* v4 = (const f32x4*)vrow; const f32x4* g4 = (const f32x4*)gam; const f32x4* b4 = (const f32x4*)bet;
#pragma unroll
    for (int j = 0; j < 8; ++j) { const int i = 64 * j + lane; const f32x4 x = v4[i]; const f32x4 y = (x - mean) * rstd * g4[i] + b4[i];
        ((f32x4*)outf)[i] = y;
        if (outb) { v2u w; w.x = pk2(y[0], y[1]); w.y = pk2(y[2], y[3]); ((v2u*)outb)[i] = w; } }
}

__device__ __forceinline__ void z_item(int item, const bf16* CX, bf16* CBZ, const bf16* CC, const float* w, const float* bias, int tid) {
    const int cg = tid & 255, rh = tid >> 8, R0 = item * 32 + rh * 16, t0 = R0 & (SEQ - 1), c0 = cg * 8;
    float w0[8], w1[8], w2[8], bb[8];
#pragma unroll
    for (int j = 0; j < 8; ++j) { w0[j] = w[c0 + j]; w1[j] = w[CW + c0 + j]; w2[j] = w[2 * CW + c0 + j]; bb[j] = bias[c0 + j]; }
    float pv[8], cu[8], nx[8];
#define LOADCX(dst, row, ok) do { if (ok) { const v4u a_ = *(const v4u*)(CX + (size_t)(row) * CW + c0), b_ = *(const v4u*)(CC + (size_t)(row) * CW + c0); \
        dst[0] = bflo(a_.x) * bflo(b_.x); dst[1] = bfhi(a_.x) * bfhi(b_.x); dst[2] = bflo(a_.y) * bflo(b_.y); dst[3] = bfhi(a_.y) * bfhi(b_.y); \
        dst[4] = bflo(a_.z) * bflo(b_.z); dst[5] = bfhi(a_.z) * bfhi(b_.z); dst[6] = bflo(a_.w) * bflo(b_.w); dst[7] = bfhi(a_.w) * bfhi(b_.w); } \
        else { _Pragma("unroll") for (int j_ = 0; j_ < 8; ++j_) dst[j_] = 0.f; } } while (0)
    LOADCX(pv, R0 - 1, t0 > 0);
    LOADCX(cu, R0, true);
    for (int i = 0; i < 16; ++i) {
        LOADCX(nx, R0 + i + 1, (t0 + i + 1) < SEQ);
        const v4u cb = *(const v4u*)(CBZ + (size_t)(R0 + i) * CW + c0);
        float z[8];
#pragma unroll
        for (int j = 0; j < 8; ++j) z[j] = w0[j] * pv[j] + w1[j] * cu[j] + w2[j] * nx[j] + bb[j];
        v4u o; o.x = pk2(bflo(cb.x) * z[0], bfhi(cb.x) * z[1]); o.y = pk2(bflo(cb.y) * z[2], bfhi(cb.y) * z[3]); o.z = pk2(bflo(cb.z) * z[4], bfhi(cb.z) * z[5]); o.w = pk2(bflo(cb.w) * z[6], bfhi(cb.w) * z[7]);
        *(v4u*)(CBZ + (size_t)(R0 + i) * CW + c0) = o;
#pragma unroll
        for (int j = 0; j < 8; ++j) { pv[j] = cu[j]; cu[j] = nx[j]; }
    }
#undef LOADCX
}

#if MK_NAIVE_LRU
__device__ __forceinline__ void lru_naive_item(int b, int hd, const bf16* LX, const float* cw, const float* cb, const float* wa, const float* ba, const float* wx, const float* bx,
                                               const float* lam, bf16* HS, LAS float* us, int tid) {
    const int dir = (tid >> 7) & 1, e = tid & 127; const bool act = tid < 256; const int ch = hd * HD + e;
    const float c0 = cw[ch], c1 = cw[LW + ch], c2 = cw[2 * LW + ch], c3 = cw[3 * LW + ch], cbias = cb[ch];
    const float b_a = ba[(dir * NH + hd) * HD + e], b_x = bx[(dir * NH + hd) * HD + e];
    const float kl = -8.0f * log1pf(expf(-lam[dir * LW + ch]));
    const float* Wa = wa + (size_t)(dir * NH + hd) * HD * HD + e; const float* Wx = wx + (size_t)(dir * NH + hd) * HD * HD + e;
    float h = 0.f;
    for (int s = 0; s < SEQ; ++s) {
        const int t = dir ? (SEQ - 1 - s) : s;
        float u = cbias;
        if (act) { const bf16* p = LX + ((size_t)b * SEQ + t) * LW + ch;
            if (t >= 2) u += c0 * bf2f(p[-2 * LW]); if (t >= 1) u += c1 * bf2f(p[-LW]); u += c2 * bf2f(p[0]); if (t + 1 < SEQ) u += c3 * bf2f(p[LW]);
            us[dir * HD + e] = u; }
        __syncthreads();
        if (act) { float ra = b_a, ri = b_x;
            for (int d = 0; d < HD; ++d) { const float ud = us[dir * HD + d]; ra += ud * Wa[d * HD]; ri += ud * Wx[d * HD]; }
            const float r = 1.0f / (1.0f + expf(-ra)), ig = 1.0f / (1.0f + expf(-ri));
            const float la = kl * r, a = expf(la), g = sqrtf(fmaxf(-expm1f(2.0f * la), 0.f)) * (ig * u);
            h = a * h + g;
            bf16* o = HS + ((size_t)b * SEQ + t) * LW + ch;
            if (s < SEQ / 2) *o = (bf16)f2bf(h); else *o = (bf16)f2bf(bf2f(*o) + h); }
        __syncthreads();
    }
}
#endif


#if !MK_NAIVE_LRU
__device__ __forceinline__ void lru_fast_item(int b, int hd, const bf16* LX, const float* cw, const float* cb, const bf16* WGt, const float* ba, const float* bx, const float* lam, bf16* HS,
                                              LAS unsigned char* lds, int tid, int lane, int wave) {
    constexpr int T = 64, S = SEQ / T; constexpr float L2E = 1.44269504089f;
    typedef short bf16x8 __attribute__((ext_vector_type(8)));
    const int q = lane >> 4, c = lane & 15, chl = 16 * wave + c, ch = hd * HD + chl;
    float nba[2], nbx[2], kl2[2], hc[2];
    bf16x8 Bf[2][2][4];
#pragma unroll
    for (int d = 0; d < 2; ++d) { nba[d] = -L2E * ba[(d * NH + hd) * HD + chl]; nbx[d] = -L2E * bx[(d * NH + hd) * HD + chl]; kl2[d] = -8.0f * L2E * log1pf(expf(-lam[d * LW + ch])); hc[d] = 0.f;
#pragma unroll
        for (int g = 0; g < 2; ++g)
#pragma unroll
            for (int ks = 0; ks < 4; ++ks) Bf[d][g][ks] = *(const bf16x8*)(WGt + ((size_t)((g * 2 + d) * NH + hd) * HD + chl) * HD + 32 * ks + 8 * q); }
    LAS float* cwl = (LAS float*)(lds + 65536);
    for (int i = tid; i < 640; i += NTHR) { const int k = i >> 7, e = i & 127; cwl[i] = (k < 4) ? cw[k * LW + hd * HD + e] : cb[hd * HD + e]; }
    const int cg = tid & 15, rr = tid >> 4, cdir = rr >> 4, run = rr & 15;
    const bf16* lxb = LX + (size_t)b * SEQ * LW + hd * HD + 8 * cg;
    v4u xr[7];
#define LRU_LOAD7(step) do { const int ts_ = (cdir ? SEQ - ((step) + 1) * T : (step) * T) + 4 * run - 2; \
        _Pragma("unroll") for (int k_ = 0; k_ < 7; ++k_) { const int tok_ = ts_ + k_; xr[k_] = (tok_ >= 0 && tok_ < SEQ) ? *(const v4u*)(lxb + (size_t)tok_ * LW) : (v4u){0u, 0u, 0u, 0u}; } } while (0)
#define LRU_CONV_WRITE(buf) do { float wk_[5][8]; \
        _Pragma("unroll") for (int k_ = 0; k_ < 5; ++k_) { const f32x4 a_ = *(const LAS f32x4*)(cwl + k_ * 128 + 8 * cg), b_ = *(const LAS f32x4*)(cwl + k_ * 128 + 8 * cg + 4); \
            wk_[k_][0] = a_[0]; wk_[k_][1] = a_[1]; wk_[k_][2] = a_[2]; wk_[k_][3] = a_[3]; wk_[k_][4] = b_[0]; wk_[k_][5] = b_[1]; wk_[k_][6] = b_[2]; wk_[k_][7] = b_[3]; } \
        LAS unsigned char* ub_ = lds + (cdir * 2 + (buf)) * 16384; \
        _Pragma("unroll") for (int i_ = 0; i_ < 4; ++i_) { float o_[8]; \
            _Pragma("unroll") for (int j_ = 0; j_ < 8; ++j_) o_[j_] = wk_[4][j_]; \
            _Pragma("unroll") for (int k_ = 0; k_ < 4; ++k_) { const v4u x_ = xr[i_ + k_]; \
                o_[0] += wk_[k_][0] * bflo(x_.x); o_[1] += wk_[k_][1] * bfhi(x_.x); o_[2] += wk_[k_][2] * bflo(x_.y); o_[3] += wk_[k_][3] * bfhi(x_.y); \
                o_[4] += wk_[k_][4] * bflo(x_.z); o_[5] += wk_[k_][5] * bfhi(x_.z); o_[6] += wk_[k_][6] * bflo(x_.w); o_[7] += wk_[k_][7] * bfhi(x_.w); } \
            const int row_ = 4 * run + i_; v4u w_; w_.x = pk2(o_[0], o_[1]); w_.y = pk2(o_[2], o_[3]); w_.z = pk2(o_[4], o_[5]); w_.w = pk2(o_[6], o_[7]); \
            *(LAS v4u*)(ub_ + row_ * 256 + ((cg ^ (row_ & 15)) << 4)) = w_; } } while (0)
    __syncthreads();
    LRU_LOAD7(0);
    LRU_CONV_WRITE(0);
    __syncthreads();
    for (int s = 0; s < S; ++s) {
        if (s + 1 < S) LRU_LOAD7(s + 1);
        const bool first_half = s < S / 2;
#pragma unroll
        for (int d = 0; d < 2; ++d) {
            const LAS unsigned char* ub = lds + (d * 2 + (s & 1)) * 16384;
            const int tile0 = d ? SEQ - (s + 1) * T : s * T;
#pragma unroll 1
            for (int rbi = 0; rbi < 4; ++rbi) {
                const int rb = d ? 3 - rbi : rbi;
                pg8::f32x4 accA = {0.f, 0.f, 0.f, 0.f}, accX = {0.f, 0.f, 0.f, 0.f};
                const LAS unsigned char* arow = ub + (16 * rb + c) * 256;
#pragma unroll
                for (int ks = 0; ks < 4; ++ks) { const bf16x8 af = *(const LAS bf16x8*)(arow + (((q + 4 * ks) ^ c) << 4));
                    accA = __builtin_amdgcn_mfma_f32_16x16x32_bf16(af, Bf[d][0][ks], accA, 0, 0, 0);
                    accX = __builtin_amdgcn_mfma_f32_16x16x32_bf16(af, Bf[d][1][ks], accX, 0, 0, 0); }
                float av[4], gv[4];
#pragma unroll
                for (int i = 0; i < 4; ++i) { const int rowi = 16 * rb + 4 * q + i;
                    const float u = bf2f(*(const LAS unsigned short*)(ub + rowi * 256 + (((chl >> 3) ^ (rowi & 15)) << 4) + (chl & 7) * 2));
                    const float r = __builtin_amdgcn_rcpf(1.0f + __builtin_amdgcn_exp2f(accA[i] * -L2E + nba[d]));
                    const float ig = __builtin_amdgcn_rcpf(1.0f + __builtin_amdgcn_exp2f(accX[i] * -L2E + nbx[d]));
                    const float a = __builtin_amdgcn_exp2f(kl2[d] * r);
                    av[i] = a; gv[i] = __builtin_amdgcn_sqrtf(fmaxf(1.0f - a * a, 0.f)) * (ig * u); }
                float Ap[4], Hp[4], hv[4];
                if (d == 0) {
                    Ap[0] = av[0]; Hp[0] = gv[0];
#pragma unroll
                    for (int i = 1; i < 4; ++i) { Ap[i] = av[i] * Ap[i - 1]; Hp[i] = av[i] * Hp[i - 1] + gv[i]; }
                    float IA = Ap[3], IH = Hp[3];
                    { const float pa = __shfl_up(IA, 16), ph = __shfl_up(IH, 16); if (q >= 1) { IH = IA * ph + IH; IA = IA * pa; } }
                    { const float pa = __shfl_up(IA, 32), ph = __shfl_up(IH, 32); if (q >= 2) { IH = IA * ph + IH; IA = IA * pa; } }
                    float EA = __shfl_up(IA, 16), EH = __shfl_up(IH, 16); if (q == 0) { EA = 1.f; EH = 0.f; }
                    const float hin = EA * hc[d] + EH;
#pragma unroll
                    for (int i = 0; i < 4; ++i) hv[i] = Ap[i] * hin + Hp[i];
                    hc[d] = __shfl(hv[3], 48 + c);
                } else {
                    Ap[3] = av[3]; Hp[3] = gv[3];
#pragma unroll
                    for (int i = 2; i >= 0; --i) { Ap[i] = av[i] * Ap[i + 1]; Hp[i] = av[i] * Hp[i + 1] + gv[i]; }
                    float IA = Ap[0], IH = Hp[0];
                    { const float pa = __shfl_down(IA, 16), ph = __shfl_down(IH, 16); if (q <= 2) { IH = IA * ph + IH; IA = IA * pa; } }
                    { const float pa = __shfl_down(IA, 32), ph = __shfl_down(IH, 32); if (q <= 1) { IH = IA * ph + IH; IA = IA * pa; } }
                    float EA = __shfl_down(IA, 16), EH = __shfl_down(IH, 16); if (q == 3) { EA = 1.f; EH = 0.f; }
                    const float hin = EA * hc[d] + EH;
#pragma unroll
                    for (int i = 0; i < 4; ++i) hv[i] = Ap[i] * hin + Hp[i];
                    hc[d] = __shfl(hv[0], c);
                }
                bf16* op = HS + ((size_t)b * SEQ + tile0 + 16 * rb + 4 * q) * LW + ch;
                if (first_half) {
#pragma unroll
                    for (int i = 0; i < 4; ++i) op[(size_t)i * LW] = (bf16)f2bf(hv[i]);
                } else {
#pragma unroll
                    for (int i = 0; i < 4; ++i) op[(size_t)i * LW] = (bf16)f2bf(bf2f(op[(size_t)i * LW]) + hv[i]);
                }
            }
        }
        if (s + 1 < S) LRU_CONV_WRITE((s + 1) & 1);
        asm volatile("s_waitcnt vmcnt(0)" ::: "memory");
        __syncthreads();
    }
#undef LRU_LOAD7
#undef LRU_CONV_WRITE
}
#endif

struct Args { const float* in[22]; float* out; unsigned char* ws; int ph_lo, ph_hi; };

__global__ void __launch_bounds__(NTHR, 2) mk_fwd(Args args) {
    extern __shared__ __attribute__((aligned(16))) unsigned char lds_raw[];
    LAS unsigned char* lds = (LAS unsigned char*)lds_raw;
    volatile LAS unsigned* MISC = (volatile LAS unsigned*)(lds + MISC_OFF);
    const int tid = threadIdx.x, lane = tid & 63, wave = __builtin_amdgcn_readfirstlane(tid >> 6);
    const int G = gridDim.x, bx = blockIdx.x;
    const int gw = bx * NWAVES + wave, NGW = G * NWAVES;
    unsigned char* ws = args.ws; unsigned char* dob = (unsigned char*)args.out;
    unsigned* ctl = (unsigned*)(ws + WS_CTL);
    const float* x = args.in[0]; const float* w_in = args.in[1]; const float* lru_conv_w = args.in[2]; const float* lru_conv_b = args.in[3];
    const float* lru_w_a = args.in[4]; const float* lru_b_a = args.in[5]; const float* lru_w_x = args.in[6]; const float* lru_b_x = args.in[7];
    const float* lru_lambda = args.in[8]; const float* w_lru_out = args.in[9]; const float* sc_conv_w = args.in[10]; const float* sc_conv_b = args.in[11];
    const float* w_conv_out = args.in[12]; const float* w_o = args.in[13]; const float* ln1_g = args.in[14]; const float* ln1_b = args.in[15];
    const float* mlp_w1 = args.in[16]; const float* mlp_b1 = args.in[17]; const float* mlp_w2 = args.in[18]; const float* mlp_b2 = args.in[19];
    const float* ln2_g = args.in[20]; const float* ln2_b = args.in[21];
    bf16* XB = (bf16*)(dob + DO_XB); bf16* WINT = (bf16*)(dob + DO_WINT); bf16* HS = (bf16*)(dob + DO_HS); float* OUTF = args.out;
    bf16* WG = (bf16*)(ws + WS_WG); bf16* WLO = (bf16*)(ws + WS_WLO); bf16* WCO = (bf16*)(ws + WS_WCO); bf16* WO = (bf16*)(ws + WS_WO); bf16* W1 = (bf16*)(ws + WS_W1); bf16* W2 = (bf16*)(ws + WS_W2);
    bf16* LX = (bf16*)(ws + WS_LX); bf16* SEC = (bf16*)(ws + WS_SEC); constexpr size_t SEC_ELEMS = SEC_BYTES / 2;
    bf16* CXR = SEC; bf16* CBZ = SEC + SEC_ELEMS; bf16* CCC = SEC + 2 * SEC_ELEMS; bf16* GL = SEC + 3 * SEC_ELEMS; bf16* GC = SEC + 4 * SEC_ELEMS;
    float* T1 = (float*)(ws + WS_T1); bf16* FFB = (bf16*)(ws + WS_FF); bf16* H1B = (bf16*)(ws + WS_H1B);
    f32x2* ST1 = (f32x2*)(ws + WS_ST1); f32x2* ST2 = (f32x2*)(ws + WS_ST2);

    const int lo = args.ph_lo, hi = args.ph_hi;
#if MK_ONE_LAUNCH
    cg::grid_group grid = cg::this_grid();
#define SEAM(k) do { if (lo <= (k) && (k) + 1 < hi) grid.sync(); } while (0)
#else
#define SEAM(k) do { } while (0)
#endif
#define IN(k) (lo <= (k) && (k) < hi)

    if (IN(0)) {
        LAS float* scr = (LAS float*)(lds + wave * 8448);
        constexpr int I_IN = (DM / 64) * (INC / 32), I_LO = (LW / 64) * (DM / 32), I_CO = (CW / 64) * (DM / 32), I_O = (DM / 64) * (DM / 32), I_1 = (DM / 64) * (DFF / 32), I_2 = (DFF / 64) * (DM / 32);
        constexpr int I_G = 2 * 2 * NH * 8;
        constexpr int NITEMS = I_IN + I_LO + I_CO + I_O + I_1 + I_2 + I_G;
        for (int it = gw; it < NITEMS; it += NGW) {
            int r = it;
            if (r < I_IN) { p0_transpose_item(w_in, DM, INC, WINT, scr, r, lane); continue; } r -= I_IN;
            if (r < I_LO) { p0_transpose_item(w_lru_out, LW, DM, WLO, scr, r, lane); continue; } r -= I_LO;
            if (r < I_CO) { p0_transpose_item(w_conv_out, CW, DM, WCO, scr, r, lane); continue; } r -= I_CO;
            if (r < I_O) { p0_transpose_item(w_o, DM, DM, WO, scr, r, lane); continue; } r -= I_O;
            if (r < I_1) { p0_transpose_item(mlp_w1, DM, DFF, W1, scr, r, lane); continue; } r -= I_1;
            if (r < I_2) { p0_transpose_item(mlp_w2, DFF, DM, W2, scr, r, lane); continue; } r -= I_2;
            { const int mat = r >> 3, sub = r & 7, gate = mat / (2 * NH), dh = mat % (2 * NH);
              const float* src = (gate ? lru_w_x : lru_w_a) + (size_t)dh * HD * HD;
              p0_transpose_item(src, HD, HD, WG + (size_t)mat * HD * HD, scr, sub, lane); }
        }
        for (int m = gw; m < MT; m += NGW) {
            const f32x4* xr = (const f32x4*)(x + (size_t)m * DM) + lane; v2u* o8 = (v2u*)(XB + (size_t)m * DM) + lane;
#pragma unroll
            for (int j = 0; j < 8; ++j) { const f32x4 v = xr[64 * j]; v2u w; w.x = pk2(v[0], v[1]); w.y = pk2(v[2], v[3]); o8[64 * j] = w; }
        }
    }
    SEAM(0);
    if (IN(1)) {
        pg8::Gemm g{XB, WINT, MT, INC, DM}; pg8::StaticOrder S; S.init(MT, INC, G, bx);
        pg8::EpiProj E{LX, SEC, SEC_ELEMS};
        pg8::gemm_phase<pg8::EpiProj, pg8::StaticOrder, true, true>(lds, g, S, E);
    }
    SEAM(1);
    if (IN(2)) {
#if MK_NAIVE_LRU
        if (bx < NB * NH) lru_naive_item(bx / NH, bx % NH, LX, lru_conv_w, lru_conv_b, lru_w_a, lru_b_a, lru_w_x, lru_b_x, lru_lambda, HS, (LAS float*)(lds), tid);
#else
        if (bx < NB * NH) lru_fast_item(bx / NH, bx % NH, LX, lru_conv_w, lru_conv_b, WG, lru_b_a, lru_b_x, lru_lambda, HS, lds, tid, lane, wave);
#endif
        for (;;) {
            __syncthreads();
            if (tid == 0) MISC[0] = atomicAdd(ctl + CW_ZQ, 1u);
            __syncthreads();
            const int item = (int)MISC[0];
            if (item >= MT / 32) break;
            z_item(item, CXR, CBZ, CCC, sc_conv_w, sc_conv_b, tid);
        }
        __syncthreads();
    }
    SEAM(2);
    if (IN(3)) {
        { pg8::Gemm g{HS, WLO, MT, DM, LW}; pg8::StaticOrder S; S.init(MT, DM, G, bx);
          pg8::EpiGate1 E{GL, T1};
          pg8::gemm_phase<pg8::EpiGate1, pg8::StaticOrder, true, true>(lds, g, S, E); }
        __syncthreads();
        { pg8::Gemm g{CBZ, WCO, MT, DM, CW}; pg8::StaticOrder S; S.init(MT, DM, G, bx);
          pg8::EpiGate2 E{GC, T1};
          pg8::gemm_phase<pg8::EpiGate2, pg8::StaticOrder, true, true>(lds, g, S, E); }
    }
    SEAM(3);
    if (IN(4)) {
        pg8::Gemm g{GC, WO, MT, DM, DM}; pg8::StaticOrder S; S.init(MT, DM, G, bx);
        pg8::EpiResStats E{x, OUTF, nullptr, (pg8::f32x2*)ST1, ALPHA};
        pg8::gemm_phase<pg8::EpiResStats, pg8::StaticOrder, true, true>(lds, g, S, E);
    }
    SEAM(4);
    if (IN(5)) {
        for (int m = gw; m < MT; m += NGW) ln_apply_row(OUTF + (size_t)m * DM, ST1 + (size_t)m * 32, ln1_g, ln1_b, OUTF + (size_t)m * DM, H1B + (size_t)m * DM, lane);
    }
    SEAM(5);
    if (IN(6)) {
        pg8::Gemm g{H1B, W1, MT, DFF, DM}; pg8::StaticOrder S; S.init(MT, DFF, G, bx);
        pg8::EpiRelu2 E{FFB, DFF, mlp_b1};
        pg8::gemm_phase<pg8::EpiRelu2, pg8::StaticOrder, true, true>(lds, g, S, E);
    }
    SEAM(6);
    if (IN(7)) {
        pg8::Gemm g{FFB, W2, MT, DM, DFF}; pg8::StaticOrder S; S.init(MT, DM, G, bx);
        pg8::EpiResStats E{OUTF, OUTF, mlp_b2, (pg8::f32x2*)ST2, ALPHA};
        pg8::gemm_phase<pg8::EpiResStats, pg8::StaticOrder, true, true>(lds, g, S, E);
    }
    SEAM(7);
    if (IN(8)) {
        for (int m = gw; m < MT; m += NGW) ln_apply_row(OUTF + (size_t)m * DM, ST2 + (size_t)m * 32, ln2_g, ln2_b, OUTF + (size_t)m * DM, nullptr, lane);
    }
#undef IN
#undef SEAM
}

extern "C" void kernel_launch(void* const* d_in, const int* in_sizes, int n_in, void* d_out, int out_size, void* d_ws, size_t ws_size, hipStream_t stream) {
    static int grid = 0;
    if (grid == 0) {
        if (n_in != 22 || in_sizes[0] != MT * DM || out_size != MT * DM || ws_size < WS_END) {
            fprintf(stderr, "kernel_launch: unexpected shapes (n_in %d, in0 %d, out %d, ws %zu; need ws >= %zu)\n", n_in, n_in > 0 ? in_sizes[0] : -1, out_size, ws_size, (size_t)WS_END); grid = -1; return; }
        int dev = 0, cus = 0, per_cu = 0;
        if (hipGetDevice(&dev) != hipSuccess || hipDeviceGetAttribute(&cus, hipDeviceAttributeMultiprocessorCount, dev) != hipSuccess) { grid = -1; return; }
        if (hipFuncSetAttribute((const void*)mk_fwd, hipFuncAttributeMaxDynamicSharedMemorySize, LDS_BYTES) != hipSuccess) { fprintf(stderr, "kernel_launch: hipFuncSetAttribute failed\n"); grid = -1; return; }
        if (hipOccupancyMaxActiveBlocksPerMultiprocessor(&per_cu, (const void*)mk_fwd, NTHR, LDS_BYTES) != hipSuccess || per_cu < 1) { fprintf(stderr, "kernel_launch: occupancy query says %d blocks/CU\n", per_cu); (void)hipGetLastError(); grid = -1; return; }
        grid = cus * 1;
        fprintf(stderr, "kernel_launch: %d CUs, occupancy %d blocks/CU, grid %d\n", cus, per_cu, grid);
    }
    if (grid < 0) return;
    (void)hipMemsetAsync((char*)d_ws + WS_CTL, 0, CTL_BYTES, stream);
    Args a{};
    for (int i = 0; i < 22; ++i) a.in[i] = (const float*)d_in[i];
    a.out = (float*)d_out; a.ws = (unsigned char*)d_ws;
#if MK_ONE_LAUNCH
    a.ph_lo = 0; a.ph_hi = NPHASE;
    void* kargs[] = {&a};
    hipError_t e = hipLaunchCooperativeKernel((const void*)mk_fwd, dim3(grid), dim3(NTHR), kargs, LDS_BYTES, stream);
    if (e != hipSuccess) fprintf(stderr, "kernel_launch: cooperative launch failed: %s (grid %d)\n", hipGetErrorString(e), grid);
#else
    for (int p = 0; p < NPHASE; ++p) { a.ph_lo = p; a.ph_hi = p + 1; hipLaunchKernelGGL(mk_fwd, dim3(grid), dim3(NTHR), LDS_BYTES, stream, a); }
#endif
}
```

```cpp
#include <hip/hip_runtime.h>
#include <hip/hip_cooperative_groups.h>
#include <cstdio>
#include <cstdint>
namespace cg = cooperative_groups;
namespace pg8 {
#define PG8_LAS __attribute__((address_space(3)))
typedef unsigned short bf16_t;
typedef short bf16x8 __attribute__((ext_vector_type(8)));
typedef float f32x4 __attribute__((ext_vector_type(4)));
typedef unsigned u32x4 __attribute__((ext_vector_type(4)));
constexpr int BM = 256, BK = 64, HALF = 128, HTB = HALF * BK * 2  , STAGE_BYTES = 8 * HTB, NXCD = 8, WGM = 8;

__host__ __device__ __forceinline__ int lds_byte(int r, int c) { const int st = (r >> 4) * 2 + (c >> 5), rr = r & 15, cc = c & 31, ob = rr * 64 + cc * 2; return st * 1024 + (ob ^ (((ob >> 9) & 1) << 5)); }
__host__ __device__ __forceinline__ void stage_rc(int b, int& R, int& C) { const int st = b / 1024, sb = b % 1024, swz = sb ^ (((sb >> 9) & 1) << 5); R = (st >> 1) * 16 + swz / 64; C = (st & 1) * 32 + (swz % 64) / 2; }
__host__ __device__ __forceinline__ int perm32(int rho) { const int n = rho >> 4, i = rho & 15; return 8 * (i >> 2) + 4 * n + (i & 3); }

struct Unit { int pm, pn; };
struct Gemm { const bf16_t* A; const bf16_t* Bt; int M, N, K; };

struct StaticOrder {
    int nM, nN, nwg, G, c;
    __host__ __device__ void init(int M, int N, int G_, int c_) { nM = M / BM; nN = N / BM; nwg = nM * nN; G = G_; c = c_; }
    __host__ __device__ bool next(int i, Unit& u) const {
        const long L = (long)i * G + c; if (L >= nwg) return false;
        int wgid = (int)L; { const int q = nwg / NXCD, r = nwg % NXCD, xcd = wgid % NXCD, off = wgid / NXCD; wgid = (xcd < r ? xcd * (q + 1) : r * (q + 1) + (xcd - r) * q) + off; }
        const int nig = WGM * nN, gid = wgid / nig, fm = gid * WGM, gsz = (nM - fm) < WGM ? (nM - fm) : WGM;
        u.pm = fm + ((wgid % nig) % gsz); u.pn = (wgid % nig) / gsz; return true;
    }
    __device__ __forceinline__ void a_ready(const Unit&) const {}
    __device__ __forceinline__ void done(const Unit&) const {}
};

__device__ __forceinline__ unsigned cvt_pk_bf16(float lo, float hi) { unsigned r; asm volatile("v_cvt_pk_bf16_f32 %0, %1, %2" : "=v"(r) : "v"(lo), "v"(hi)); return r; }
typedef float f32x2 __attribute__((ext_vector_type(2)));
__device__ __forceinline__ float bf_lo(unsigned w) { return __uint_as_float(w << 16); }
__device__ __forceinline__ float bf_hi(unsigned w) { return __uint_as_float(w & 0xffff0000u); }
__device__ __forceinline__ float sigmoidf_fast(float v) { return __builtin_amdgcn_rcpf(1.0f + __builtin_amdgcn_exp2f(v * -1.44269504089f)); }

struct EpiProj {
    static constexpr bool PERM = true, AFTER_DRAIN = false;
    bf16_t* lx; bf16_t* sec; size_t sec_stride;
    __device__ __forceinline__ void operator()(const f32x4 (&acc)[2][2][4][2], const Unit& u, int wr, int wc, int fr, int fq) const {
        bf16_t* base; int ldc, colt;
        if (u.pn < 10) { base = lx; ldc = 2560; colt = u.pn * BM; }
        else { const int s = (u.pn - 10) >> 3; base = sec + (size_t)s * sec_stride; ldc = 2048; colt = ((u.pn - 10) & 7) * BM; }
        const int row0 = u.pm * BM + wr * 64 + fr, col0 = colt + wc * 32 + 8 * fq;
#pragma unroll
        for (int ai = 0; ai < 2; ++ai)
#pragma unroll
            for (int m = 0; m < 4; ++m) { bf16_t* rowp = base + (size_t)(row0 + ai * HALF + m * 16) * ldc + col0;
#pragma unroll
                for (int bj = 0; bj < 2; ++bj) { const f32x4 v0 = acc[ai][bj][m][0], v1 = acc[ai][bj][m][1];
                    u32x4 w; w.x = cvt_pk_bf16(v0[0], v0[1]); w.y = cvt_pk_bf16(v0[2], v0[3]); w.z = cvt_pk_bf16(v1[0], v1[1]); w.w = cvt_pk_bf16(v1[2], v1[3]);
                    *(u32x4*)(rowp + bj * HALF) = w; } }
    }
};
struct EpiGate1 {
    static constexpr bool PERM = true, AFTER_DRAIN = false;
    const bf16_t* g; float* t1;
    __device__ __forceinline__ void operator()(const f32x4 (&acc)[2][2][4][2], const Unit& u, int wr, int wc, int fr, int fq) const {
        const int row0 = u.pm * BM + wr * 64 + fr, col0 = u.pn * BM + wc * 32 + 8 * fq;
#pragma unroll
        for (int ai = 0; ai < 2; ++ai)
#pragma unroll
            for (int m = 0; m < 4; ++m) { const size_t off = (size_t)(row0 + ai * HALF + m * 16) * 2048 + col0;
#pragma unroll
                for (int bj = 0; bj < 2; ++bj) { const u32x4 gw = *(const u32x4*)(g + off + bj * HALF);
                    f32x4 s0, s1; s0[0] = sigmoidf_fast(bf_lo(gw.x)); s0[1] = sigmoidf_fast(bf_hi(gw.x)); s0[2] = sigmoidf_fast(bf_lo(gw.y)); s0[3] = sigmoidf_fast(bf_hi(gw.y));
                    s1[0] = sigmoidf_fast(bf_lo(gw.z)); s1[1] = sigmoidf_fast(bf_hi(gw.z)); s1[2] = sigmoidf_fast(bf_lo(gw.w)); s1[3] = sigmoidf_fast(bf_hi(gw.w));
                    *(f32x4*)(t1 + off + bj * HALF) = s0 * acc[ai][bj][m][0]; *(f32x4*)(t1 + off + bj * HALF + 4) = s1 * acc[ai][bj][m][1]; } }
    }
};
struct EpiGate2 {
    static constexpr bool PERM = true, AFTER_DRAIN = false;
    bf16_t* g; const float* t1;
    __device__ __forceinline__ void operator()(const f32x4 (&acc)[2][2][4][2], const Unit& u, int wr, int wc, int fr, int fq) const {
        const int row0 = u.pm * BM + wr * 64 + fr, col0 = u.pn * BM + wc * 32 + 8 * fq;
#pragma unroll
        for (int ai = 0; ai < 2; ++ai)
#pragma unroll
            for (int m = 0; m < 4; ++m) { const size_t off = (size_t)(row0 + ai * HALF + m * 16) * 2048 + col0;
#pragma unroll
                for (int bj = 0; bj < 2; ++bj) { const u32x4 gw = *(const u32x4*)(g + off + bj * HALF);
                    const f32x4 a0 = *(const f32x4*)(t1 + off + bj * HALF), a1 = *(const f32x4*)(t1 + off + bj * HALF + 4);
                    f32x4 s0, s1; s0[0] = sigmoidf_fast(bf_lo(gw.x)); s0[1] = sigmoidf_fast(bf_hi(gw.x)); s0[2] = sigmoidf_fast(bf_lo(gw.y)); s0[3] = sigmoidf_fast(bf_hi(gw.y));
                    s1[0] = sigmoidf_fast(bf_lo(gw.z)); s1[1] = sigmoidf_fast(bf_hi(gw.z)); s1[2] = sigmoidf_fast(bf_lo(gw.w)); s1[3] = sigmoidf_fast(bf_hi(gw.w));
                    const f32x4 v0 = a0 + s0 * acc[ai][bj][m][0], v1 = a1 + s1 * acc[ai][bj][m][1];
                    u32x4 w; w.x = cvt_pk_bf16(v0[0], v0[1]); w.y = cvt_pk_bf16(v0[2], v0[3]); w.z = cvt_pk_bf16(v1[0], v1[1]); w.w = cvt_pk_bf16(v1[2], v1[3]);
                    *(u32x4*)(g + off + bj * HALF) = w; } }
    }
};
struct EpiResStats {
    static constexpr bool PERM = false, AFTER_DRAIN = false;
    const float* base; float* out; const float* bias; f32x2* st; float alpha;
    __device__ __forceinline__ void operator()(const f32x4 (&acc)[2][2][4][2], const Unit& u, int wr, int wc, int fr, int fq) const {
        const int col0 = u.pn * BM + wc * 32 + 4 * fq;
        f32x4 bv[2][2];
#pragma unroll
        for (int bj = 0; bj < 2; ++bj)
#pragma unroll
            for (int n = 0; n < 2; ++n) bv[bj][n] = bias ? *(const f32x4*)(bias + col0 + bj * HALF + n * 16) : (f32x4){0.f, 0.f, 0.f, 0.f};
#pragma unroll
        for (int ai = 0; ai < 2; ++ai)
#pragma unroll
            for (int m = 0; m < 4; ++m) { const int r = u.pm * BM + ai * HALF + wr * 64 + m * 16 + fr; const size_t off = (size_t)r * 2048 + col0;
                f32x4 v[2][2]; float s = 0.f;
#pragma unroll
                for (int bj = 0; bj < 2; ++bj)
#pragma unroll
                    for (int n = 0; n < 2; ++n) { const f32x4 bs = *(const f32x4*)(base + off + bj * HALF + n * 16); v[bj][n] = bs * alpha + acc[ai][bj][m][n] + bv[bj][n]; }
#pragma unroll
                for (int bj = 0; bj < 2; ++bj)
#pragma unroll
                    for (int n = 0; n < 2; ++n) { *(f32x4*)(out + off + bj * HALF + n * 16) = v[bj][n]; s += (v[bj][n][0] + v[bj][n][1]) + (v[bj][n][2] + v[bj][n][3]); }
                s += __shfl_xor(s, 16); s += __shfl_xor(s, 32);
                const float mw = s * (1.0f / 64.0f); float q = 0.f;
#pragma unroll
                for (int bj = 0; bj < 2; ++bj)
#pragma unroll
                    for (int n = 0; n < 2; ++n) { const f32x4 d = v[bj][n] - mw; q += (d[0] * d[0] + d[1] * d[1]) + (d[2] * d[2] + d[3] * d[3]); }
                q += __shfl_xor(q, 16); q += __shfl_xor(q, 32);
                if (fq == 0) st[(size_t)r * 32 + u.pn * 4 + wc] = (f32x2){mw, q};
                asm volatile("" ::: "memory"); }
    }
};
struct EpiRelu2 {
    static constexpr bool PERM = true, AFTER_DRAIN = false;
    bf16_t* O; int ldc; const float* bias;
    __device__ __forceinline__ void operator()(const f32x4 (&acc)[2][2][4][2], const Unit& u, int wr, int wc, int fr, int fq) const {
        const int row0 = u.pm * BM + wr * 64 + fr, col0 = u.pn * BM + wc * 32 + 8 * fq;
        f32x4 bv[2][2];
#pragma unroll
        for (int bj = 0; bj < 2; ++bj)
#pragma unroll
            for (int n = 0; n < 2; ++n) bv[bj][n] = *(const f32x4*)(bias + col0 + bj * HALF + 4 * n);
#pragma unroll
        for (int ai = 0; ai < 2; ++ai)
#pragma unroll
            for (int m = 0; m < 4; ++m) { bf16_t* rowp = O + (size_t)(row0 + ai * HALF + m * 16) * ldc + col0;
#pragma unroll
                for (int bj = 0; bj < 2; ++bj) { f32x4 v0 = acc[ai][bj][m][0] + bv[bj][0], v1 = acc[ai][bj][m][1] + bv[bj][1];
#pragma unroll
                    for (int j = 0; j < 4; ++j) { const float a = fmaxf(v0[j], 0.f), b = fmaxf(v1[j], 0.f); v0[j] = a * a; v1[j] = b * b; }
                    u32x4 w; w.x = cvt_pk_bf16(v0[0], v0[1]); w.y = cvt_pk_bf16(v0[2], v0[3]); w.z = cvt_pk_bf16(v1[0], v1[1]); w.w = cvt_pk_bf16(v1[2], v1[3]);
                    *(u32x4*)(rowp + bj * HALF) = w; } }
    }
};

template <class Epi, class Sched, bool ALIGN_EPI = false, bool SP2 = false>
__device__ __forceinline__ void gemm_phase(PG8_LAS unsigned char* lds, const Gemm g, const Sched& S, const Epi& E) {
    const int tid = threadIdx.x, wid = __builtin_amdgcn_readfirstlane(tid >> 6), lane = tid & 63, wr = wid >> 2, wc = wid & 3, fr = lane & 15, fq = lane >> 4;
    const int K = g.K, nt = K / BK;
    unsigned voffA[2], voffB[2];
#pragma unroll
    for (int i = 0; i < 2; ++i) { int R, C; stage_rc(tid * 16 + i * 8192, R, C); const int Rb = Epi::PERM ? ((R & ~31) + perm32(R & 31)) : R;
        voffA[i] = (unsigned)(R * K + C) * 2u; voffB[i] = (unsigned)(Rb * K + C) * 2u; }
    const size_t kstep = (size_t)(BK * 2);
    const size_t hstep = (size_t)HALF * K * 2;
    const size_t tstep = 2 * hstep;
    const unsigned ldsw = (unsigned)wid * 1024u;
    const int aoff = lds_byte(wr * 64 + fr, fq * 8), boff = lds_byte(wc * 32 + fr, fq * 8);
#define PG8_SA(b, h) (((b) * 2 + (h)) * HTB)
#define PG8_SB(b, h) ((4 + (b) * 2 + (h)) * HTB)
#define PG8_STAGE(bufoff, gbase, voff) do { _Pragma("unroll") for (int _i = 0; _i < 2; ++_i) \
        __builtin_amdgcn_global_load_lds((const unsigned*)((const char*)(gbase) + (voff)[_i]), (PG8_LAS unsigned*)(lds + (bufoff) + ldsw + _i * 8192), 16, 0, 0); } while (0)
#define PG8_LDA(dst, b, h) do { _Pragma("unroll") for (int m = 0; m < 4; ++m) _Pragma("unroll") for (int k = 0; k < 2; ++k) dst[m][k] = *(const PG8_LAS bf16x8*)(lds + PG8_SA(b, h) + aoff + m * 2048 + k * 1024); } while (0)
#define PG8_LDB(dst, b, h) do { _Pragma("unroll") for (int n = 0; n < 2; ++n) _Pragma("unroll") for (int k = 0; k < 2; ++k) dst[n][k] = *(const PG8_LAS bf16x8*)(lds + PG8_SB(b, h) + boff + n * 2048 + k * 1024); } while (0)
#define PG8_MMA(ai, bj, At, Bt) do { __builtin_amdgcn_s_setprio(1); _Pragma("unroll") for (int m = 0; m < 4; ++m) _Pragma("unroll") for (int n = 0; n < 2; ++n) _Pragma("unroll") for (int k = 0; k < 2; ++k) \
        acc[ai][bj][m][n] = __builtin_amdgcn_mfma_f32_16x16x32_bf16(Bt[n][k], At[m][k], acc[ai][bj][m][n], 0, 0, 0); __builtin_amdgcn_s_setprio(0); } while (0)
#define PG8_WAIT_V(n) asm volatile("s_waitcnt vmcnt(" #n ")" ::: "memory")
#define PG8_WAIT_L(n) asm volatile("s_waitcnt lgkmcnt(" #n ")" ::: "memory")
#define PG8_BAR __builtin_amdgcn_s_barrier()
#define PG8_SCHED __builtin_amdgcn_sched_barrier(0)
    Unit cur, nxt; int ui = 0;
    if (!S.next(0, cur)) return;
    f32x4 acc[2][2][4][2];
#pragma unroll
    for (int a = 0; a < 2; ++a)
#pragma unroll
        for (int b = 0; b < 2; ++b)
#pragma unroll
            for (int m = 0; m < 4; ++m)
#pragma unroll
                for (int n = 0; n < 2; ++n) acc[a][b][m][n] = (f32x4){0.f, 0.f, 0.f, 0.f};
    bf16x8 At[4][2], B0[2][2], B1[2][2];
    const char* cA = (const char*)g.A + (size_t)cur.pm * tstep; const char* cB = (const char*)g.Bt + (size_t)cur.pn * tstep;
    S.a_ready(cur);
    if constexpr (SP2) {
        PG8_STAGE(PG8_SB(0, 0), cB, voffB); PG8_STAGE(PG8_SB(0, 1), cB + hstep, voffB); PG8_STAGE(PG8_SA(0, 0), cA, voffA); PG8_STAGE(PG8_SA(0, 1), cA + hstep, voffA);
        if (wr == 1) PG8_BAR;
        PG8_WAIT_V(2); PG8_BAR;
        PG8_STAGE(PG8_SB(1, 0), cB + kstep, voffB); PG8_STAGE(PG8_SA(1, 0), cA + kstep, voffA); PG8_STAGE(PG8_SB(1, 1), cB + hstep + kstep, voffB);
        PG8_WAIT_V(6); PG8_BAR;
    } else {
        PG8_STAGE(PG8_SB(0, 0), cB, voffB); PG8_STAGE(PG8_SA(0, 0), cA, voffA); PG8_STAGE(PG8_SB(0, 1), cB + hstep, voffB); PG8_STAGE(PG8_SA(0, 1), cA + hstep, voffA);
        if (wr == 1) PG8_BAR;
        PG8_WAIT_V(4); PG8_BAR;
        PG8_STAGE(PG8_SB(1, 0), cB + kstep, voffB); PG8_STAGE(PG8_SA(1, 0), cA + kstep, voffA); PG8_STAGE(PG8_SB(1, 1), cB + hstep + kstep, voffB);
        PG8_WAIT_V(6); PG8_BAR;
    }
    for (;;) {
        const bool has_next = S.next(ui + 1, nxt);
        const char* nA = has_next ? (const char*)g.A + (size_t)nxt.pm * tstep : cA; const char* nB = has_next ? (const char*)g.Bt + (size_t)nxt.pn * tstep : cB;
        for (int t = 0; t < nt; t += 2) {
            const bool last = (t == nt - 2);
            const char* a1 = cA + (size_t)(t + 1) * kstep;
            const char* a2 = last ? nA : cA + (size_t)(t + 2) * kstep; const char* b2 = last ? nB : cB + (size_t)(t + 2) * kstep;
            const char* a3 = a2 + kstep; const char* b3 = b2 + kstep;
            if (last && has_next) S.a_ready(nxt);
            if constexpr (SP2) {
            PG8_LDB(B0, 0, 0); PG8_LDB(B1, 0, 1); PG8_SCHED; PG8_LDA(At, 0, 0); PG8_STAGE(PG8_SA(1, 1), a1 + hstep, voffA);
            PG8_WAIT_V(8); PG8_WAIT_L(0); PG8_BAR; PG8_MMA(0, 0, At, B0); PG8_MMA(0, 1, At, B1); PG8_BAR; PG8_SCHED;
            PG8_LDA(At, 0, 1); PG8_STAGE(PG8_SB(0, 0), b2, voffB); PG8_STAGE(PG8_SB(0, 1), b2 + hstep, voffB); PG8_STAGE(PG8_SA(0, 0), a2, voffA);
            PG8_WAIT_V(8); PG8_WAIT_L(0); PG8_BAR; PG8_MMA(1, 0, At, B0); PG8_MMA(1, 1, At, B1); PG8_BAR; PG8_SCHED;
            PG8_LDB(B0, 1, 0); PG8_LDB(B1, 1, 1); PG8_SCHED; PG8_LDA(At, 1, 0); PG8_STAGE(PG8_SA(0, 1), a2 + hstep, voffA);
            PG8_WAIT_V(8); PG8_WAIT_L(0); PG8_BAR; PG8_MMA(0, 0, At, B0); PG8_MMA(0, 1, At, B1); PG8_BAR; PG8_SCHED;
            PG8_LDA(At, 1, 1); PG8_STAGE(PG8_SB(1, 0), b3, voffB); PG8_STAGE(PG8_SB(1, 1), b3 + hstep, voffB); PG8_STAGE(PG8_SA(1, 0), a3, voffA);
            PG8_WAIT_V(8); PG8_WAIT_L(0); PG8_BAR; PG8_MMA(1, 0, At, B0); PG8_MMA(1, 1, At, B1); PG8_BAR; PG8_SCHED;
            } else {
            PG8_LDB(B0, 0, 0); PG8_SCHED; PG8_LDA(At, 0, 0); PG8_STAGE(PG8_SA(1, 1), a1 + hstep, voffA);
            PG8_WAIT_L(8); PG8_BAR; PG8_WAIT_L(0); PG8_MMA(0, 0, At, B0); PG8_BAR; PG8_SCHED;
            PG8_LDB(B1, 0, 1); PG8_STAGE(PG8_SB(0, 0), b2, voffB);
            PG8_BAR; PG8_WAIT_L(0); PG8_MMA(0, 1, At, B1); PG8_BAR;
            PG8_LDA(At, 0, 1); PG8_STAGE(PG8_SA(0, 0), a2, voffA);
            PG8_BAR; PG8_WAIT_L(0); PG8_MMA(1, 0, At, B0); PG8_BAR; PG8_SCHED;
            PG8_STAGE(PG8_SB(0, 1), b2 + hstep, voffB);
            PG8_WAIT_V(6); PG8_BAR; PG8_MMA(1, 1, At, B1); PG8_BAR;
            PG8_LDB(B0, 1, 0); PG8_SCHED; PG8_LDA(At, 1, 0); PG8_STAGE(PG8_SA(0, 1), a2 + hstep, voffA);
            PG8_WAIT_L(8); PG8_BAR; PG8_WAIT_L(0); PG8_MMA(0, 0, At, B0); PG8_BAR; PG8_SCHED;
            PG8_LDB(B1, 1, 1); PG8_STAGE(PG8_SB(1, 0), b3, voffB);
            PG8_BAR; PG8_WAIT_L(0); PG8_MMA(0, 1, At, B1); PG8_BAR;
            PG8_LDA(At, 1, 1); PG8_STAGE(PG8_SA(1, 0), a3, voffA);
            PG8_BAR; PG8_WAIT_L(0); PG8_MMA(1, 0, At, B0); PG8_BAR; PG8_SCHED;
            PG8_STAGE(PG8_SB(1, 1), b3 + hstep, voffB);
            PG8_WAIT_V(6); PG8_BAR; PG8_MMA(1, 1, At, B1); PG8_BAR;
            }
        }
        if constexpr (ALIGN_EPI) { if (wr == 0) PG8_BAR; }
        if constexpr (!Epi::AFTER_DRAIN) { E(acc, cur, wr, wc, fr, fq); S.done(cur); }
        if (!has_next) break;
#pragma unroll
        for (int a = 0; a < 2; ++a)
#pragma unroll
            for (int b = 0; b < 2; ++b)
#pragma unroll
                for (int m = 0; m < 4; ++m)
#pragma unroll
                    for (int n = 0; n < 2; ++n) acc[a][b][m][n] = (f32x4){0.f, 0.f, 0.f, 0.f};
        cur = nxt; cA = nA; cB = nB; ++ui;
        if constexpr (ALIGN_EPI) { if (wr == 1) PG8_BAR; }
    }
    PG8_WAIT_V(0);
    if constexpr (!ALIGN_EPI) { if (wr == 0) PG8_BAR; }
    PG8_BAR;
    if constexpr (Epi::AFTER_DRAIN) { E.fused(acc, cur, wr, wc, fr, fq, lds, wid, lane); S.done(cur); }
#undef PG8_SA
#undef PG8_SB
#undef PG8_STAGE
#undef PG8_LDA
#undef PG8_LDB
#undef PG8_MMA
#undef PG8_WAIT_V
#undef PG8_WAIT_L
#undef PG8_BAR
#undef PG8_SCHED
}
}
#ifndef MK_ONE_LAUNCH
#define MK_ONE_LAUNCH 1
#endif
#ifndef MK_NAIVE_LRU
#define MK_NAIVE_LRU 0
#endif
constexpr int NWAVES = 8, NTHR = NWAVES * 64;
constexpr int NB = 8, SEQ = 2048, MT = NB * SEQ, DM = 2048, LW = 2560, NH = 20, HD = 128, CW = 2048, DFF = 8192, INC = 12800;
constexpr float ALPHA = 1.18920711500272f;
constexpr float LN_EPS = 1e-5f;
constexpr int NPHASE = 9;
constexpr size_t MiB = 1u << 20;
constexpr size_t WS_CTL = 0, CTL_BYTES = 1 * MiB;
constexpr size_t WS_ST1 = 1 * MiB, WS_ST2 = 5 * MiB;
constexpr size_t WS_WG = 9 * MiB;
constexpr size_t WS_WLO = 12 * MiB, WS_WCO = 22 * MiB, WS_WO = 30 * MiB, WS_W1 = 38 * MiB, WS_W2 = 70 * MiB;
constexpr size_t WS_LX = 102 * MiB;
constexpr size_t WS_SEC = 182 * MiB, SEC_BYTES = 64 * MiB;
constexpr size_t WS_T1 = 102 * MiB;
constexpr size_t WS_FF = 102 * MiB;
constexpr size_t WS_H1B = WS_SEC + 3 * SEC_BYTES;
constexpr size_t WS_END = WS_SEC + 5 * SEC_BYTES;
static_assert(WS_FF + (size_t)MT * DFF * 2 <= WS_H1B, "FF overlay must end before H1B");
constexpr size_t DO_XB = 0, DO_WINT = 64 * MiB, DO_HS = 0;
constexpr int CW_ZQ = 64;
constexpr int CW_BAR = 4096;
constexpr int LDS_BYTES = 147456, MISC_OFF = 131072;

#define GAS __attribute__((address_space(1)))
#define LAS __attribute__((address_space(3)))
typedef unsigned short bf16;
typedef unsigned v4u __attribute__((ext_vector_type(4)));
typedef unsigned v2u __attribute__((ext_vector_type(2)));
typedef float f32x4 __attribute__((ext_vector_type(4)));
typedef float f32x2 __attribute__((ext_vector_type(2)));
#define LDS_WAIT() asm volatile("s_waitcnt lgkmcnt(0)" ::: "memory")
__device__ __forceinline__ unsigned f2bf(float f) { unsigned u = __builtin_bit_cast(unsigned, f); return (u + 0x7fffu + ((u >> 16) & 1u)) >> 16; }
__device__ __forceinline__ unsigned pk2(float lo, float hi) { return f2bf(lo) | (f2bf(hi) << 16); }
__device__ __forceinline__ float bf2f(unsigned short b) { return __uint_as_float(((unsigned)b) << 16); }
__device__ __forceinline__ float bflo(unsigned w) { return __uint_as_float(w << 16); }
__device__ __forceinline__ float bfhi(unsigned w) { return __uint_as_float(w & 0xffff0000u); }

__device__ __forceinline__ void p0_transpose_item(const float* W, int K, int N, bf16* WT, LAS float* scr, int item, int lane) {
    const int nblk = N / 32, kb = item / nblk, nb = item % nblk, k0 = 64 * kb, n0 = 32 * nb;
#pragma unroll 8
    for (int i = 0; i < 32; ++i) { const int kk = 2 * i + (lane >> 5); scr[kk * 33 + (lane & 31)] = W[(size_t)(k0 + kk) * N + n0 + (lane & 31)]; }
    LDS_WAIT(); asm volatile("" ::: "memory");
    const int c = lane & 7;
#pragma unroll
    for (int j = 0; j < 4; ++j) { const int n = (lane >> 3) + 8 * j; const LAS float* s = scr + (8 * c) * 33 + n;
        v4u o; o.x = pk2(s[0 * 33], s[1 * 33]); o.y = pk2(s[2 * 33], s[3 * 33]); o.z = pk2(s[4 * 33], s[5 * 33]); o.w = pk2(s[6 * 33], s[7 * 33]);
        *(v4u*)(WT + (size_t)(n0 + n) * K + k0 + 8 * c) = o; }
    LDS_WAIT(); asm volatile("" ::: "memory");
}

__device__ __forceinline__ void ln_apply_row(const float* vrow, const f32x2* strow, const float* gam, const float* bet, float* outf, bf16* outb, int lane) {
    const f32x2 p = strow[lane & 31];
    float ms = p.x;
#pragma unroll
    for (int o = 1; o < 32; o <<= 1) ms += __shfl_xor(ms, o);
    const float mean = ms * (1.0f / 32.0f);
    const float dm = p.x - mean; float q = p.y + 64.0f * dm * dm;
#pragma unroll
    for (int o = 1; o < 32; o <<= 1) q += __shfl_xor(q, o);
    const float rstd = 1.0f / sqrtf(q * (1.0f / 2048.0f) + LN_EPS);
    const f32x4* v4 = (const f32x4*)vrow; const f32x4* g4 = (const f32x4*)gam; const f32x4* b4 = (const f32x4*)bet;
#pragma unroll
    for (int j = 0; j < 8; ++j) { const int i = 64 * j + lane; const f32x4 x = v4[i]; const f32x4 y = (x - mean) * rstd * g4[i] + b4[i];
        ((f32x4*)outf)[i] = y;
        if (outb) { v2u w; w.x = pk2(y[0], y[1]); w.y = pk2(y[2], y[3]); ((v2u*)outb)[i] = w; } }
}

__device__ __forceinline__ void z_item(int item, const bf16* CX, bf16* CBZ, const bf16* CC, const float* w, const float* bias, int tid) {
    const int cg = tid & 255, rh = tid >> 8, R0 = item * 32 + rh * 16, t0 = R0 & (SEQ - 1), c0 = cg * 8;
    float w0[8], w1[8], w2[8], bb[8];
#pragma unroll
    for (int j = 0; j < 8; ++j) { w0[j] = w[c0 + j]; w1[j] = w[CW + c0 + j]; w2[j] = w[2 * CW + c0 + j]; bb[j] = bias[c0 + j]; }
    float pv[8], cu[8], nx[8];
#define LOADCX(dst, row, ok) do { if (ok) { const v4u a_ = *(const v4u*)(CX + (size_t)(row) * CW + c0), b_ = *(const v4u*)(CC + (size_t)(row) * CW + c0); \
        dst[0] = bflo(a_.x) * bflo(b_.x); dst[1] = bfhi(a_.x) * bfhi(b_.x); dst[2] = bflo(a_.y) * bflo(b_.y); dst[3] = bfhi(a_.y) * bfhi(b_.y); \
        dst[4] = bflo(a_.z) * bflo(b_.z); dst[5] = bfhi(a_.z) * bfhi(b_.z); dst[6] = bflo(a_.w) * bflo(b_.w); dst[7] = bfhi(a_.w) * bfhi(b_.w); } \
        else { _Pragma("unroll") for (int j_ = 0; j_ < 8; ++j_) dst[j_] = 0.f; } } while (0)
    LOADCX(pv, R0 - 1, t0 > 0);
    LOADCX(cu, R0, true);
    for (int i = 0; i < 16; ++i) {
        LOADCX(nx, R0 + i + 1, (t0 + i + 1) < SEQ);
        const v4u cb = *(const v4u*)(CBZ + (size_t)(R0 + i) * CW + c0);
        float z[8];
#pragma unroll
        for (int j = 0; j < 8; ++j) z[j] = w0[j] * pv[j] + w1[j] * cu[j] + w2[j] * nx[j] + bb[j];
        v4u o; o.x = pk2(bflo(cb.x) * z[0], bfhi(cb.x) * z[1]); o.y = pk2(bflo(cb.y) * z[2], bfhi(cb.y) * z[3]); o.z = pk2(bflo(cb.z) * z[4], bfhi(cb.z) * z[5]); o.w = pk2(bflo(cb.w) * z[6], bfhi(cb.w) * z[7]);
        *(v4u*)(CBZ + (size_t)(R0 + i) * CW + c0) = o;
#pragma unroll
        for (int j = 0; j < 8; ++j) { pv[j] = cu[j]; cu[j] = nx[j]; }
    }
#undef LOADCX
}

#if MK_NAIVE_LRU
__device__ __forceinline__ void lru_naive_item(int b, int hd, const bf16* LX, const float* cw, const float* cb, const float* wa, const float* ba, const float* wx, const float* bx,
                                               const float* lam, bf16* HS, LAS float* us, int tid) {
    const int dir = (tid >> 7) & 1, e = tid & 127; const bool act = tid < 256; const int ch = hd * HD + e;
    const float c0 = cw[ch], c1 = cw[LW + ch], c2 = cw[2 * LW + ch], c3 = cw[3 * LW + ch], cbias = cb[ch];
    const float b_a = ba[(dir * NH + hd) * HD + e], b_x = bx[(dir * NH + hd) * HD + e];
    const float kl = -8.0f * log1pf(expf(-lam[dir * LW + ch]));
    const float* Wa = wa + (size_t)(dir * NH + hd) * HD * HD + e; const float* Wx = wx + (size_t)(dir * NH + hd) * HD * HD + e;
    float h = 0.f;
    for (int s = 0; s < SEQ; ++s) {
        const int t = dir ? (SEQ - 1 - s) : s;
        float u = cbias;
        if (act) { const bf16* p = LX + ((size_t)b * SEQ + t) * LW + ch;
            if (t >= 2) u += c0 * bf2f(p[-2 * LW]); if (t >= 1) u += c1 * bf2f(p[-LW]); u += c2 * bf2f(p[0]); if (t + 1 < SEQ) u += c3 * bf2f(p[LW]);
            us[dir * HD + e] = u; }
        __syncthreads();
        if (act) { float ra = b_a, ri = b_x;
            for (int d = 0; d < HD; ++d) { const float ud = us[dir * HD + d]; ra += ud * Wa[d * HD]; ri += ud * Wx[d * HD]; }
            const float r = 1.0f / (1.0f + expf(-ra)), ig = 1.0f / (1.0f + expf(-ri));
            const float la = kl * r, a = expf(la), g = sqrtf(fmaxf(-expm1f(2.0f * la), 0.f)) * (ig * u);
            h = a * h + g;
            bf16* o = HS + ((size_t)b * SEQ + t) * LW + ch;
            if (s < SEQ / 2) *o = (bf16)f2bf(h); else *o = (bf16)f2bf(bf2f(*o) + h); }
        __syncthreads();
    }
}
#endif


#if !MK_NAIVE_LRU
__device__ __forceinline__ void lru_fast_item(int b, int hd, const bf16* LX, const float* cw, const float* cb, const bf16* WGt, const float* ba, const float* bx, const float* lam, bf16* HS,
                                              LAS unsigned char* lds, int tid, int lane, int wave) {
    constexpr int T = 64, S = SEQ / T; constexpr float L2E = 1.44269504089f;
    typedef short bf16x8 __attribute__((ext_vector_type(8)));
    const int q = lane >> 4, c = lane & 15, chl = 16 * wave + c, ch = hd * HD + chl;
    float nba[2], nbx[2], kl2[2], hc[2];
    bf16x8 Bf[2][2][4];
#pragma unroll
    for (int d = 0; d < 2; ++d) { nba[d] = -L2E * ba[(d * NH + hd) * HD + chl]; nbx[d] = -L2E * bx[(d * NH + hd) * HD + chl]; kl2[d] = -8.0f * L2E * log1pf(expf(-lam[d * LW + ch])); hc[d] = 0.f;
#pragma unroll
        for (int g = 0; g < 2; ++g)
#pragma unroll
            for (int ks = 0; ks < 4; ++ks) Bf[d][g][ks] = *(const bf16x8*)(WGt + ((size_t)((g * 2 + d) * NH + hd) * HD + chl) * HD + 32 * ks + 8 * q); }
    LAS float* cwl = (LAS float*)(lds + 65536);
    for (int i = tid; i < 640; i += NTHR) { const int k = i >> 7, e = i & 127; cwl[i] = (k < 4) ? cw[k * LW + hd * HD + e] : cb[hd * HD + e]; }
    const int cg = tid & 15, rr = tid >> 4, cdir = rr >> 4, run = rr & 15;
    const bf16* lxb = LX + (size_t)b * SEQ * LW + hd * HD + 8 * cg;
    v4u xr[7];
#define LRU_LOAD7(step) do { const int ts_ = (cdir ? SEQ - ((step) + 1) * T : (step) * T) + 4 * run - 2; \
        _Pragma("unroll") for (int k_ = 0; k_ < 7; ++k_) { const int tok_ = ts_ + k_; xr[k_] = (tok_ >= 0 && tok_ < SEQ) ? *(const v4u*)(lxb + (size_t)tok_ * LW) : (v4u){0u, 0u, 0u, 0u}; } } while (0)
#define LRU_CONV_WRITE(buf) do { float wk_[5][8]; \
        _Pragma("unroll") for (int k_ = 0; k_ < 5; ++k_) { const f32x4 a_ = *(const LAS f32x4*)(cwl + k_ * 128 + 8 * cg), b_ = *(const LAS f32x4*)(cwl + k_ * 128 + 8 * cg + 4); \
            wk_[k_][0] = a_[0]; wk_[k_][1] = a_[1]; wk_[k_][2] = a_[2]; wk_[k_][3] = a_[3]; wk_[k_][4] = b_[0]; wk_[k_][5] = b_[1]; wk_[k_][6] = b_[2]; wk_[k_][7] = b_[3]; } \
        LAS unsigned char* ub_ = lds + (cdir * 2 + (buf)) * 16384; \
        _Pragma("unroll") for (int i_ = 0; i_ < 4; ++i_) { float o_[8]; \
            _Pragma("unroll") for (int j_ = 0; j_ < 8; ++j_) o_[j_] = wk_[4][j_]; \
            _Pragma("unroll") for (int k_ = 0; k_ < 4; ++k_) { const v4u x_ = xr[i_ + k_]; \
                o_[0] += wk_[k_][0] * bflo(x_.x); o_[1] += wk_[k_][1] * bfhi(x_.x); o_[2] += wk_[k_][2] * bflo(x_.y); o_[3] += wk_[k_][3] * bfhi(x_.y); \
                o_[4] += wk_[k_][4] * bflo(x_.z); o_[5] += wk_[k_][5] * bfhi(x_.z); o_[6] += wk_[k_][6] * bflo(x_.w); o_[7] += wk_[k_][7] * bfhi(x_.w); } \
            const int row_ = 4 * run + i_; v4u w_; w_.x = pk2(o_[0], o_[1]); w_.y = pk2(o_[2], o_[3]); w_.z = pk2(o_[4], o_[5]); w_.w = pk2(o_[6], o_[7]); \
            *(LAS v4u*)(ub_ + row_ * 256 + ((cg ^ (row_ & 15)) << 4)) = w_; } } while (0)
    __syncthreads();
    LRU_LOAD7(0);
    LRU_CONV_WRITE(0);
    __syncthreads();
    for (int s = 0; s < S; ++s) {
        if (s + 1 < S) LRU_LOAD7(s + 1);
        const bool first_half = s < S / 2;
#pragma unroll
        for (int d = 0; d < 2; ++d) {
            const LAS unsigned char* ub = lds + (d * 2 + (s & 1)) * 16384;
            const int tile0 = d ? SEQ - (s + 1) * T : s * T;
#pragma unroll 1
            for (int rbi = 0; rbi < 4; ++rbi) {
                const int rb = d ? 3 - rbi : rbi;
                pg8::f32x4 accA = {0.f, 0.f, 0.f, 0.f}, accX = {0.f, 0.f, 0.f, 0.f};
                const LAS unsigned char* arow = ub + (16 * rb + c) * 256;
#pragma unroll
                for (int ks = 0; ks < 4; ++ks) { const bf16x8 af = *(const LAS bf16x8*)(arow + (((q + 4 * ks) ^ c) << 4));
                    accA = __builtin_amdgcn_mfma_f32_16x16x32_bf16(af, Bf[d][0][ks], accA, 0, 0, 0);
                    accX = __builtin_amdgcn_mfma_f32_16x16x32_bf16(af, Bf[d][1][ks], accX, 0, 0, 0); }
                float av[4], gv[4];
#pragma unroll
                for (int i = 0; i < 4; ++i) { const int rowi = 16 * rb + 4 * q + i;
                    const float u = bf2f(*(const LAS unsigned short*)(ub + rowi * 256 + (((chl >> 3) ^ (rowi & 15)) << 4) + (chl & 7) * 2));
                    const float r = __builtin_amdgcn_rcpf(1.0f + __builtin_amdgcn_exp2f(accA[i] * -L2E + nba[d]));
                    const float ig = __builtin_amdgcn_rcpf(1.0f + __builtin_amdgcn_exp2f(accX[i] * -L2E + nbx[d]));
                    const float a = __builtin_amdgcn_exp2f(kl2[d] * r);
                    av[i] = a; gv[i] = __builtin_amdgcn_sqrtf(fmaxf(1.0f - a * a, 0.f)) * (ig * u); }
                float Ap[4], Hp[4], hv[4];
                if (d == 0) {
                    Ap[0] = av[0]; Hp[0] = gv[0];
#pragma unroll
                    for (int i = 1; i < 4; ++i) { Ap[i] = av[i] * Ap[i - 1]; Hp[i] = av[i] * Hp[i - 1] + gv[i]; }
                    float IA = Ap[3], IH = Hp[3];
                    { const float pa = __shfl_up(IA, 16), ph = __shfl_up(IH, 16); if (q >= 1) { IH = IA * ph + IH; IA = IA * pa; } }
                    { const float pa = __shfl_up(IA, 32), ph = __shfl_up(IH, 32); if (q >= 2) { IH = IA * ph + IH; IA = IA * pa; } }
                    float EA = __shfl_up(IA, 16), EH = __shfl_up(IH, 16); if (q == 0) { EA = 1.f; EH = 0.f; }
                    const float hin = EA * hc[d] + EH;
#pragma unroll
                    for (int i = 0; i < 4; ++i) hv[i] = Ap[i] * hin + Hp[i];
                    hc[d] = __shfl(hv[3], 48 + c);
                } else {
                    Ap[3] = av[3]; Hp[3] = gv[3];
#pragma unroll
                    for (int i = 2; i >= 0; --i) { Ap[i] = av[i] * Ap[i + 1]; Hp[i] = av[i] * Hp[i + 1] + gv[i]; }
                    float IA = Ap[0], IH = Hp[0];
                    { const float pa = __shfl_down(IA, 16), ph = __shfl_down(IH, 16); if (q <= 2) { IH = IA * ph + IH; IA = IA * pa; } }
                    { const float pa = __shfl_down(IA, 32), ph = __shfl_down(IH, 32); if (q <= 1) { IH = IA * ph + IH; IA = IA * pa; } }
                    float EA = __shfl_down(IA, 16), EH = __shfl_down(IH, 16); if (q == 3) { EA = 1.f; EH = 0.f; }
                    const float hin = EA * hc[d] + EH;
#pragma unroll
                    for (int i = 0; i < 4; ++i) hv[i] = Ap[i] * hin + Hp[i];
                    hc[d] = __shfl(hv[0], c);
                }
                bf16* op = HS + ((size_t)b * SEQ + tile0 + 16 * rb + 4 * q) * LW + ch;
                if (first_half) {
#pragma unroll
                    for (int i = 0; i < 4; ++i) op[(size_t)i * LW] = (bf16)f2bf(hv[i]);
                } else {
#pragma unroll
                    for (int i = 0; i < 4; ++i) op[(size_t)i * LW] = (bf16)f2bf(bf2f(op[(size_t)i * LW]) + hv[i]);
                }
            }
        }
        if (s + 1 < S) LRU_CONV_WRITE((s + 1) & 1);
        asm volatile("s_waitcnt vmcnt(0)" ::: "memory");
        __syncthreads();
    }
#undef LRU_LOAD7
#undef LRU_CONV_WRITE
}
#endif

#define XB_TMO      128
#define XB_XCNT(j)  (256  + 64 * (j))
#define XB_XSUB(j)  (1280 + 64 * (j))
#define XB_XGEN(j)  (2304 + 64 * (j))
#define XB_TOP      3328
#define XB_TOPGEN   3392
#define XCD_BAR_WORDS 3456
#define XB_SPIN_CAP (1u << 18)

__device__ __forceinline__ unsigned xb_ld(unsigned* p)              { return __hip_atomic_load(p, __ATOMIC_RELAXED, __HIP_MEMORY_SCOPE_AGENT); }
__device__ __forceinline__ unsigned xb_add(unsigned* p, unsigned v) { return __hip_atomic_fetch_add(p, v, __ATOMIC_RELAXED, __HIP_MEMORY_SCOPE_AGENT); }
__device__ __forceinline__ unsigned xb_xcc_id() { return (unsigned)__builtin_amdgcn_s_getreg((3 << 11) | 20) & 0xFu; }
#define XB_SPIN(cond, bar) do { unsigned _sp = 0; while (cond) { __builtin_amdgcn_s_sleep(1); \
    if ((++_sp & 255u) == 0u) { if (xb_ld(&(bar)[XB_TMO])) break; if (_sp > XB_SPIN_CAP) { atomicAdd(&(bar)[XB_TMO], 1u); break; } } } } while (0)

struct XcdBarrier {
    unsigned* bar; unsigned x;
    volatile LAS unsigned* st;
};

__device__ __forceinline__ XcdBarrier xcd_barrier_post(unsigned* bar, volatile LAS unsigned* st) {
    XcdBarrier b; b.bar = bar; b.x = xb_xcc_id(); b.st = st;
    if (threadIdx.x == 0) (void)xb_add(&bar[XB_XCNT(b.x)], 1u);
    return b;
}
__device__ __forceinline__ void xcd_barrier_complete(unsigned* bar, unsigned x, unsigned& nloc, unsigned& nx) {
    const unsigned G = gridDim.x * gridDim.y * gridDim.z;
    unsigned sum, cnt, mine, sp = 0u;
    for (;;) {
        sum = 0u; cnt = 0u; mine = 0u;
#pragma unroll
        for (unsigned j = 0; j < 16; ++j) { const unsigned c = xb_ld(&bar[XB_XCNT(j)]); sum += c; cnt += (c > 0u) ? 1u : 0u; mine = (j == x) ? c : mine; }
        if (sum == G) break;
        __builtin_amdgcn_s_sleep(1);
        if ((++sp & 255u) == 0u) { if (xb_ld(&bar[XB_TMO])) break; if (sp > XB_SPIN_CAP) { atomicAdd(&bar[XB_TMO], 1u); break; } }
    }
    nloc = mine > 0u ? mine : 1u; nx = cnt > 0u ? cnt : 1u;
}

__device__ __forceinline__ void xcd_barrier(const XcdBarrier& b) {
    asm volatile("s_waitcnt vmcnt(0)" ::: "memory");
    __syncthreads();
    if (threadIdx.x == 0) {
        unsigned* bar = b.bar;
        __builtin_amdgcn_s_waitcnt(0);
        unsigned nloc = b.st[0], nx = b.st[1];
        if (nloc == 0u) { xcd_barrier_complete(bar, b.x, nloc, nx); b.st[0] = nloc; b.st[1] = nx; }
        const unsigned old = xb_add(&bar[XB_XSUB(b.x)], 1u);
        const unsigned gen = old / nloc;
        if (old + 1u == (gen + 1u) * nloc) {
            __builtin_amdgcn_fence(__ATOMIC_RELEASE, "agent");
            asm volatile("s_waitcnt vmcnt(0)" ::: "memory");
            const unsigned og = xb_add(&bar[XB_TOP], 1u);
            const unsigned tg = og / nx;
            if (og + 1u == (tg + 1u) * nx) xb_add(&bar[XB_TOPGEN], 1u);
            else XB_SPIN(xb_ld(&bar[XB_TOPGEN]) == tg, bar);
            __builtin_amdgcn_fence(__ATOMIC_ACQUIRE, "agent");
            xb_add(&bar[XB_XGEN(b.x)], 1u);
            asm volatile("s_waitcnt vmcnt(0)" ::: "memory");
        } else {
            XB_SPIN(xb_ld(&bar[XB_XGEN(b.x)]) == gen, bar);
            __builtin_amdgcn_fence(__ATOMIC_ACQUIRE, "agent");
            asm volatile("s_waitcnt vmcnt(0)" ::: "memory");
        }
    }
    __syncthreads();
}

struct Args { const float* in[22]; float* out; unsigned char* ws; int ph_lo, ph_hi; };

__global__ void __launch_bounds__(NTHR, 2) mk_fwd(Args args) {
    extern __shared__ __attribute__((aligned(16))) unsigned char lds_raw[];
    LAS unsigned char* lds = (LAS unsigned char*)lds_raw;
    volatile LAS unsigned* MISC = (volatile LAS unsigned*)(lds + MISC_OFF);
    const int tid = threadIdx.x, lane = tid & 63, wave = __builtin_amdgcn_readfirstlane(tid >> 6);
    const int G = gridDim.x, bx = blockIdx.x;
    const int gw = bx * NWAVES + wave, NGW = G * NWAVES;
    unsigned char* ws = args.ws; unsigned char* dob = (unsigned char*)args.out;
    unsigned* ctl = (unsigned*)(ws + WS_CTL);
    const float* x = args.in[0]; const float* w_in = args.in[1]; const float* lru_conv_w = args.in[2]; const float* lru_conv_b = args.in[3];
    const float* lru_w_a = args.in[4]; const float* lru_b_a = args.in[5]; const float* lru_w_x = args.in[6]; const float* lru_b_x = args.in[7];
    const float* lru_lambda = args.in[8]; const float* w_lru_out = args.in[9]; const float* sc_conv_w = args.in[10]; const float* sc_conv_b = args.in[11];
    const float* w_conv_out = args.in[12]; const float* w_o = args.in[13]; const float* ln1_g = args.in[14]; const float* ln1_b = args.in[15];
    const float* mlp_w1 = args.in[16]; const float* mlp_b1 = args.in[17]; const float* mlp_w2 = args.in[18]; const float* mlp_b2 = args.in[19];
    const float* ln2_g = args.in[20]; const float* ln2_b = args.in[21];
    bf16* XB = (bf16*)(dob + DO_XB); bf16* WINT = (bf16*)(dob + DO_WINT); bf16* HS = (bf16*)(dob + DO_HS); float* OUTF = args.out;
    bf16* WG = (bf16*)(ws + WS_WG); bf16* WLO = (bf16*)(ws + WS_WLO); bf16* WCO = (bf16*)(ws + WS_WCO); bf16* WO = (bf16*)(ws + WS_WO); bf16* W1 = (bf16*)(ws + WS_W1); bf16* W2 = (bf16*)(ws + WS_W2);
    bf16* LX = (bf16*)(ws + WS_LX); bf16* SEC = (bf16*)(ws + WS_SEC); constexpr size_t SEC_ELEMS = SEC_BYTES / 2;
    bf16* CXR = SEC; bf16* CBZ = SEC + SEC_ELEMS; bf16* CCC = SEC + 2 * SEC_ELEMS; bf16* GL = SEC + 3 * SEC_ELEMS; bf16* GC = SEC + 4 * SEC_ELEMS;
    float* T1 = (float*)(ws + WS_T1); bf16* FFB = (bf16*)(ws + WS_FF); bf16* H1B = (bf16*)(ws + WS_H1B);
    f32x2* ST1 = (f32x2*)(ws + WS_ST1); f32x2* ST2 = (f32x2*)(ws + WS_ST2);

    const int lo = args.ph_lo, hi = args.ph_hi;
#if MK_ONE_LAUNCH
    cg::grid_group grid = cg::this_grid();
    if (tid < 32) MISC[tid] = 0u;
    __syncthreads();
    const XcdBarrier xbar = xcd_barrier_post(ctl + CW_BAR, MISC + 8);
#define SEAM(k) do { if (lo <= (k) && (k) + 1 < hi) { if ((k) == 0) grid.sync(); else xcd_barrier(xbar); } } while (0)
#else
#define SEAM(k) do { } while (0)
#endif
#define IN(k) (lo <= (k) && (k) < hi)

    if (IN(0)) {
        LAS float* scr = (LAS float*)(lds + wave * 8448);
        constexpr int I_IN = (DM / 64) * (INC / 32), I_LO = (LW / 64) * (DM / 32), I_CO = (CW / 64) * (DM / 32), I_O = (DM / 64) * (DM / 32), I_1 = (DM / 64) * (DFF / 32), I_2 = (DFF / 64) * (DM / 32);
        constexpr int I_G = 2 * 2 * NH * 8;
        constexpr int NITEMS = I_IN + I_LO + I_CO + I_O + I_1 + I_2 + I_G;
        for (int it = gw; it < NITEMS; it += NGW) {
            int r = it;
            if (r < I_IN) { p0_transpose_item(w_in, DM, INC, WINT, scr, r, lane); continue; } r -= I_IN;
            if (r < I_LO) { p0_transpose_item(w_lru_out, LW, DM, WLO, scr, r, lane); continue; } r -= I_LO;
            if (r < I_CO) { p0_transpose_item(w_conv_out, CW, DM, WCO, scr, r, lane); continue; } r -= I_CO;
            if (r < I_O) { p0_transpose_item(w_o, DM, DM, WO, scr, r, lane); continue; } r -= I_O;
            if (r < I_1) { p0_transpose_item(mlp_w1, DM, DFF, W1, scr, r, lane); continue; } r -= I_1;
            if (r < I_2) { p0_transpose_item(mlp_w2, DFF, DM, W2, scr, r, lane); continue; } r -= I_2;
            { const int mat = r >> 3, sub = r & 7, gate = mat / (2 * NH), dh = mat % (2 * NH);
              const float* src = (gate ? lru_w_x : lru_w_a) + (size_t)dh * HD * HD;
              p0_transpose_item(src, HD, HD, WG + (size_t)mat * HD * HD, scr, sub, lane); }
        }
        for (int m = gw; m < MT; m += NGW) {
            const f32x4* xr = (const f32x4*)(x + (size_t)m * DM) + lane; v2u* o8 = (v2u*)(XB + (size_t)m * DM) + lane;
#pragma unroll
            for (int j = 0; j < 8; ++j) { const f32x4 v = xr[64 * j]; v2u w; w.x = pk2(v[0], v[1]); w.y = pk2(v[2], v[3]); o8[64 * j] = w; }
        }
    }
    SEAM(0);
    if (IN(1)) {
        pg8::Gemm g{XB, WINT, MT, INC, DM}; pg8::StaticOrder S; S.init(MT, INC, G, bx);
        pg8::EpiProj E{LX, SEC, SEC_ELEMS};
        pg8::gemm_phase<pg8::EpiProj, pg8::StaticOrder, true, true>(lds, g, S, E);
    }
    SEAM(1);
    if (IN(2)) {
#if MK_NAIVE_LRU
        if (bx < NB * NH) lru_naive_item(bx / NH, bx % NH, LX, lru_conv_w, lru_conv_b, lru_w_a, lru_b_a, lru_w_x, lru_b_x, lru_lambda, HS, (LAS float*)(lds), tid);
#else
        if (bx < NB * NH) lru_fast_item(bx / NH, bx % NH, LX, lru_conv_w, lru_conv_b, WG, lru_b_a, lru_b_x, lru_lambda, HS, lds, tid, lane, wave);
#endif
        for (;;) {
            __syncthreads();
            if (tid == 0) MISC[0] = atomicAdd(ctl + CW_ZQ, 1u);
            __syncthreads();
            const int item = (int)MISC[0];
            if (item >= MT / 32) break;
            z_item(item, CXR, CBZ, CCC, sc_conv_w, sc_conv_b, tid);
        }
        __syncthreads();
    }
    SEAM(2);
    if (IN(3)) {
        { pg8::Gemm g{HS, WLO, MT, DM, LW}; pg8::StaticOrder S; S.init(MT, DM, G, bx);
          pg8::EpiGate1 E{GL, T1};
          pg8::gemm_phase<pg8::EpiGate1, pg8::StaticOrder, true, true>(lds, g, S, E); }
        __syncthreads();
        { pg8::Gemm g{CBZ, WCO, MT, DM, CW}; pg8::StaticOrder S; S.init(MT, DM, G, bx);
          pg8::EpiGate2 E{GC, T1};
          pg8::gemm_phase<pg8::EpiGate2, pg8::StaticOrder, true, true>(lds, g, S, E); }
    }
    SEAM(3);
    if (IN(4)) {
        pg8::Gemm g{GC, WO, MT, DM, DM}; pg8::StaticOrder S; S.init(MT, DM, G, bx);
        pg8::EpiResStats E{x, OUTF, nullptr, (pg8::f32x2*)ST1, ALPHA};
        pg8::gemm_phase<pg8::EpiResStats, pg8::StaticOrder, true, true>(lds, g, S, E);
    }
    SEAM(4);
    if (IN(5)) {
        for (int m = gw; m < MT; m += NGW) ln_apply_row(OUTF + (size_t)m * DM, ST1 + (size_t)m * 32, ln1_g, ln1_b, OUTF + (size_t)m * DM, H1B + (size_t)m * DM, lane);
    }
    SEAM(5);
    if (IN(6)) {
        pg8::Gemm g{H1B, W1, MT, DFF, DM}; pg8::StaticOrder S; S.init(MT, DFF, G, bx);
        pg8::EpiRelu2 E{FFB, DFF, mlp_b1};
        pg8::gemm_phase<pg8::EpiRelu2, pg8::StaticOrder, true, true>(lds, g, S, E);
    }
    SEAM(6);
    if (IN(7)) {
        pg8::Gemm g{FFB, W2, MT, DM, DFF}; pg8::StaticOrder S; S.init(MT, DM, G, bx);
        pg8::EpiResStats E{OUTF, OUTF, mlp_b2, (pg8::f32x2*)ST2, ALPHA};
        pg8::gemm_phase<pg8::EpiResStats, pg8::StaticOrder, true, true>(lds, g, S, E);
    }
    SEAM(7);
    if (IN(8)) {
        for (int m = gw; m < MT; m += NGW) ln_apply_row(OUTF + (size_t)m * DM, ST2 + (size_t)m * 32, ln2_g, ln2_b, OUTF + (size_t)m * DM, nullptr, lane);
    }
#undef IN
#undef SEAM
}

extern "C" void kernel_launch(void* const* d_in, const int* in_sizes, int n_in, void* d_out, int out_size, void* d_ws, size_t ws_size, hipStream_t stream) {
    static int grid = 0;
    if (grid == 0) {
        if (n_in != 22 || in_sizes[0] != MT * DM || out_size != MT * DM || ws_size < WS_END) {
            fprintf(stderr, "kernel_launch: unexpected shapes (n_in %d, in0 %d, out %d, ws %zu; need ws >= %zu)\n", n_in, n_in > 0 ? in_sizes[0] : -1, out_size, ws_size, (size_t)WS_END); grid = -1; return; }
        int dev = 0, cus = 0, per_cu = 0;
        if (hipGetDevice(&dev) != hipSuccess || hipDeviceGetAttribute(&cus, hipDeviceAttributeMultiprocessorCount, dev) != hipSuccess) { grid = -1; return; }
        if (hipFuncSetAttribute((const void*)mk_fwd, hipFuncAttributeMaxDynamicSharedMemorySize, LDS_BYTES) != hipSuccess) { fprintf(stderr, "kernel_launch: hipFuncSetAttribute failed\n"); grid = -1; return; }
        if (hipOccupancyMaxActiveBlocksPerMultiprocessor(&per_cu, (const void*)mk_fwd, NTHR, LDS_BYTES) != hipSuccess || per_cu < 1) { fprintf(stderr, "kernel_launch: occupancy query says %d blocks/CU\n", per_cu); (void)hipGetLastError(); grid = -1; return; }
        grid = cus * 1;
        fprintf(stderr, "kernel_launch: %d CUs, occupancy %d blocks/CU, grid %d\n", cus, per_cu, grid);
    }
    if (grid < 0) return;
    (void)hipMemsetAsync((char*)d_ws + WS_CTL, 0, CTL_BYTES, stream);
    Args a{};
    for (int i = 0; i < 22; ++i) a.in[i] = (const float*)d_in[i];
    a.out = (float*)d_out; a.ws = (unsigned char*)d_ws;
#if MK_ONE_LAUNCH
    a.ph_lo = 0; a.ph_hi = NPHASE;
    void* kargs[] = {&a};
    hipError_t e = hipLaunchCooperativeKernel((const void*)mk_fwd, dim3(grid), dim3(NTHR), kargs, LDS_BYTES, stream);
    if (e != hipSuccess) fprintf(stderr, "kernel_launch: cooperative launch failed: %s (grid %d)\n", hipGetErrorString(e), grid);
#else
    for (int p = 0; p < NPHASE; ++p) { a.ph_lo = p; a.ph_hi = p + 1; hipLaunchKernelGGL(mk_fwd, dim3(grid), dim3(NTHR), LDS_BYTES, stream, a); }
#endif
}
```

```cpp
#include <hip/hip_runtime.h>
#include <hip/hip_cooperative_groups.h>
#include <cstdio>
#include <cstdint>
namespace cg = cooperative_groups;
namespace pg8 {
#define PG8_LAS __attribute__((address_space(3)))
typedef unsigned short bf16_t;
typedef short bf16x8 __attribute__((ext_vector_type(8)));
typedef float f32x4 __attribute__((ext_vector_type(4)));
typedef unsigned u32x4 __attribute__((ext_vector_type(4)));
constexpr int BM = 256, BK = 64, HALF = 128, HTB = HALF * BK * 2  , STAGE_BYTES = 8 * HTB, NXCD = 8, WGM = 8;

__host__ __device__ __forceinline__ int lds_byte(int r, int c) { const int st = (r >> 4) * 2 + (c >> 5), rr = r & 15, cc = c & 31, ob = rr * 64 + cc * 2; return st * 1024 + (ob ^ (((ob >> 9) & 1) << 5)); }
__host__ __device__ __forceinline__ void stage_rc(int b, int& R, int& C) { const int st = b / 1024, sb = b % 1024, swz = sb ^ (((sb >> 9) & 1) << 5); R = (st >> 1) * 16 + swz / 64; C = (st & 1) * 32 + (swz % 64) / 2; }
__host__ __device__ __forceinline__ int perm32(int rho) { const int n = rho >> 4, i = rho & 15; return 8 * (i >> 2) + 4 * n + (i & 3); }

struct Unit { int pm, pn; };
struct Gemm { const bf16_t* A; const bf16_t* Bt; int M, N, K; };

struct StaticOrder {
    int nM, nN, nwg, G, c;
    __host__ __device__ void init(int M, int N, int G_, int c_) { nM = M / BM; nN = N / BM; nwg = nM * nN; G = G_; c = c_; }
    __host__ __device__ bool next(int i, Unit& u) const {
        const long L = (long)i * G + c; if (L >= nwg) return false;
        int wgid = (int)L; { const int q = nwg / NXCD, r = nwg % NXCD, xcd = wgid % NXCD, off = wgid / NXCD; wgid = (xcd < r ? xcd * (q + 1) : r * (q + 1) + (xcd - r) * q) + off; }
        const int nig = WGM * nN, gid = wgid / nig, fm = gid * WGM, gsz = (nM - fm) < WGM ? (nM - fm) : WGM;
        u.pm = fm + ((wgid % nig) % gsz); u.pn = (wgid % nig) / gsz; return true;
    }
    __device__ __forceinline__ void a_ready(const Unit&) const {}
    __device__ __forceinline__ void done(const Unit&) const {}
};

__device__ __forceinline__ unsigned cvt_pk_bf16(float lo, float hi) { unsigned r; asm volatile("v_cvt_pk_bf16_f32 %0, %1, %2" : "=v"(r) : "v"(lo), "v"(hi)); return r; }
typedef float f32x2 __attribute__((ext_vector_type(2)));
__device__ __forceinline__ float bf_lo(unsigned w) { return __uint_as_float(w << 16); }
__device__ __forceinline__ float bf_hi(unsigned w) { return __uint_as_float(w & 0xffff0000u); }
__device__ __forceinline__ float sigmoidf_fast(float v) { return __builtin_amdgcn_rcpf(1.0f + __builtin_amdgcn_exp2f(v * -1.44269504089f)); }

struct EpiProj {
    static constexpr bool PERM = true, AFTER_DRAIN = false;
    bf16_t* lx; bf16_t* sec; size_t sec_stride;
    __device__ __forceinline__ void operator()(const f32x4 (&acc)[2][2][4][2], const Unit& u, int wr, int wc, int fr, int fq) const {
        bf16_t* base; int ldc, colt;
        if (u.pn < 10) { base = lx; ldc = 2560; colt = u.pn * BM; }
        else { const int s = (u.pn - 10) >> 3; base = sec + (size_t)s * sec_stride; ldc = 2048; colt = ((u.pn - 10) & 7) * BM; }
        const int row0 = u.pm * BM + wr * 64 + fr, col0 = colt + wc * 32 + 8 * fq;
#pragma unroll
        for (int ai = 0; ai < 2; ++ai)
#pragma unroll
            for (int m = 0; m < 4; ++m) { bf16_t* rowp = base + (size_t)(row0 + ai * HALF + m * 16) * ldc + col0;
#pragma unroll
                for (int bj = 0; bj < 2; ++bj) { const f32x4 v0 = acc[ai][bj][m][0], v1 = acc[ai][bj][m][1];
                    u32x4 w; w.x = cvt_pk_bf16(v0[0], v0[1]); w.y = cvt_pk_bf16(v0[2], v0[3]); w.z = cvt_pk_bf16(v1[0], v1[1]); w.w = cvt_pk_bf16(v1[2], v1[3]);
                    *(u32x4*)(rowp + bj * HALF) = w; } }
    }
};
struct EpiGate1 {
    static constexpr bool PERM = true, AFTER_DRAIN = false;
    const bf16_t* g; float* t1;
    __device__ __forceinline__ void operator()(const f32x4 (&acc)[2][2][4][2], const Unit& u, int wr, int wc, int fr, int fq) const {
        const int row0 = u.pm * BM + wr * 64 + fr, col0 = u.pn * BM + wc * 32 + 8 * fq;
#pragma unroll
        for (int ai = 0; ai < 2; ++ai)
#pragma unroll
            for (int m = 0; m < 4; ++m) { const size_t off = (size_t)(row0 + ai * HALF + m * 16) * 2048 + col0;
#pragma unroll
                for (int bj = 0; bj < 2; ++bj) { const u32x4 gw = *(const u32x4*)(g + off + bj * HALF);
                    f32x4 s0, s1; s0[0] = sigmoidf_fast(bf_lo(gw.x)); s0[1] = sigmoidf_fast(bf_hi(gw.x)); s0[2] = sigmoidf_fast(bf_lo(gw.y)); s0[3] = sigmoidf_fast(bf_hi(gw.y));
                    s1[0] = sigmoidf_fast(bf_lo(gw.z)); s1[1] = sigmoidf_fast(bf_hi(gw.z)); s1[2] = sigmoidf_fast(bf_lo(gw.w)); s1[3] = sigmoidf_fast(bf_hi(gw.w));
                    *(f32x4*)(t1 + off + bj * HALF) = s0 * acc[ai][bj][m][0]; *(f32x4*)(t1 + off + bj * HALF + 4) = s1 * acc[ai][bj][m][1]; } }
    }
};
struct EpiGate2 {
    static constexpr bool PERM = true, AFTER_DRAIN = false;
    bf16_t* g; const float* t1;
    __device__ __forceinline__ void operator()(const f32x4 (&acc)[2][2][4][2], const Unit& u, int wr, int wc, int fr, int fq) const {
        const int row0 = u.pm * BM + wr * 64 + fr, col0 = u.pn * BM + wc * 32 + 8 * fq;
#pragma unroll
        for (int ai = 0; ai < 2; ++ai)
#pragma unroll
            for (int m = 0; m < 4; ++m) { const size_t off = (size_t)(row0 + ai * HALF + m * 16) * 2048 + col0;
#pragma unroll
                for (int bj = 0; bj < 2; ++bj) { const u32x4 gw = *(const u32x4*)(g + off + bj * HALF);
                    const f32x4 a0 = *(const f32x4*)(t1 + off + bj * HALF), a1 = *(const f32x4*)(t1 + off + bj * HALF + 4);
                    f32x4 s0, s1; s0[0] = sigmoidf_fast(bf_lo(gw.x)); s0[1] = sigmoidf_fast(bf_hi(gw.x)); s0[2] = sigmoidf_fast(bf_lo(gw.y)); s0[3] = sigmoidf_fast(bf_hi(gw.y));
                    s1[0] = sigmoidf_fast(bf_lo(gw.z)); s1[1] = sigmoidf_fast(bf_hi(gw.z)); s1[2] = sigmoidf_fast(bf_lo(gw.w)); s1[3] = sigmoidf_fast(bf_hi(gw.w));
                    const f32x4 v0 = a0 + s0 * acc[ai][bj][m][0], v1 = a1 + s1 * acc[ai][bj][m][1];
                    u32x4 w; w.x = cvt_pk_bf16(v0[0], v0[1]); w.y = cvt_pk_bf16(v0[2], v0[3]); w.z = cvt_pk_bf16(v1[0], v1[1]); w.w = cvt_pk_bf16(v1[2], v1[3]);
                    *(u32x4*)(g + off + bj * HALF) = w; } }
    }
};
struct EpiResStats {
    static constexpr bool PERM = false, AFTER_DRAIN = false;
    const float* base; float* out; const float* bias; f32x2* st; float alpha;
    __device__ __forceinline__ void operator()(const f32x4 (&acc)[2][2][4][2], const Unit& u, int wr, int wc, int fr, int fq) const {
        const int col0 = u.pn * BM + wc * 32 + 4 * fq;
        f32x4 bv[2][2];
#pragma unroll
        for (int bj = 0; bj < 2; ++bj)
#pragma unroll
            for (int n = 0; n < 2; ++n) bv[bj][n] = bias ? *(const f32x4*)(bias + col0 + bj * HALF + n * 16) : (f32x4){0.f, 0.f, 0.f, 0.f};
#pragma unroll
        for (int ai = 0; ai < 2; ++ai)
#pragma unroll
            for (int m = 0; m < 4; ++m) { const int r = u.pm * BM + ai * HALF + wr * 64 + m * 16 + fr; const size_t off = (size_t)r * 2048 + col0;
                f32x4 v[2][2]; float s = 0.f;
#pragma unroll
                for (int bj = 0; bj < 2; ++bj)
#pragma unroll
                    for (int n = 0; n < 2; ++n) { const f32x4 bs = *(const f32x4*)(base + off + bj * HALF + n * 16); v[bj][n] = bs * alpha + acc[ai][bj][m][n] + bv[bj][n]; }
#pragma unroll
                for (int bj = 0; bj < 2; ++bj)
#pragma unroll
                    for (int n = 0; n < 2; ++n) { *(f32x4*)(out + off + bj * HALF + n * 16) = v[bj][n]; s += (v[bj][n][0] + v[bj][n][1]) + (v[bj][n][2] + v[bj][n][3]); }
                s += __shfl_xor(s, 16); s += __shfl_xor(s, 32);
                const float mw = s * (1.0f / 64.0f); float q = 0.f;
#pragma unroll
                for (int bj = 0; bj < 2; ++bj)
#pragma unroll
                    for (int n = 0; n < 2; ++n) { const f32x4 d = v[bj][n] - mw; q += (d[0] * d[0] + d[1] * d[1]) + (d[2] * d[2] + d[3] * d[3]); }
                q += __shfl_xor(q, 16); q += __shfl_xor(q, 32);
                if (fq == 0) st[(size_t)r * 32 + u.pn * 4 + wc] = (f32x2){mw, q};
                asm volatile("" ::: "memory"); }
    }
};
struct EpiRelu2 {
    static constexpr bool PERM = true, AFTER_DRAIN = false;
    bf16_t* O; int ldc; const float* bias;
    __device__ __forceinline__ void operator()(const f32x4 (&acc)[2][2][4][2], const Unit& u, int wr, int wc, int fr, int fq) const {
        const int row0 = u.pm * BM + wr * 64 + fr, col0 = u.pn * BM + wc * 32 + 8 * fq;
        f32x4 bv[2][2];
#pragma unroll
        for (int bj = 0; bj < 2; ++bj)
#pragma unroll
            for (int n = 0; n < 2; ++n) bv[bj][n] = *(const f32x4*)(bias + col0 + bj * HALF + 4 * n);
#pragma unroll
        for (int ai = 0; ai < 2; ++ai)
#pragma unroll
            for (int m = 0; m < 4; ++m) { bf16_t* rowp = O + (size_t)(row0 + ai * HALF + m * 16) * ldc + col0;
#pragma unroll
                for (int bj = 0; bj < 2; ++bj) { f32x4 v0 = acc[ai][bj][m][0] + bv[bj][0], v1 = acc[ai][bj][m][1] + bv[bj][1];
#pragma unroll
                    for (int j = 0; j < 4; ++j) { const float a = fmaxf(v0[j], 0.f), b = fmaxf(v1[j], 0.f); v0[j] = a * a; v1[j] = b * b; }
                    u32x4 w; w.x = cvt_pk_bf16(v0[0], v0[1]); w.y = cvt_pk_bf16(v0[2], v0[3]); w.z = cvt_pk_bf16(v1[0], v1[1]); w.w = cvt_pk_bf16(v1[2], v1[3]);
                    *(u32x4*)(rowp + bj * HALF) = w; } }
    }
};

template <class Epi, class Sched, bool ALIGN_EPI = false, bool SP2 = false>
__device__ __forceinline__ void gemm_phase(PG8_LAS unsigned char* lds, const Gemm g, const Sched& S, const Epi& E) {
    const int tid = threadIdx.x, wid = __builtin_amdgcn_readfirstlane(tid >> 6), lane = tid & 63, wr = wid >> 2, wc = wid & 3, fr = lane & 15, fq = lane >> 4;
    const int K = g.K, nt = K / BK;
    unsigned voffA[2], voffB[2];
#pragma unroll
    for (int i = 0; i < 2; ++i) { int R, C; stage_rc(tid * 16 + i * 8192, R, C); const int Rb = Epi::PERM ? ((R & ~31) + perm32(R & 31)) : R;
        voffA[i] = (unsigned)(R * K + C) * 2u; voffB[i] = (unsigned)(Rb * K + C) * 2u; }
    const size_t kstep = (size_t)(BK * 2);
    const size_t hstep = (size_t)HALF * K * 2;
    const size_t tstep = 2 * hstep;
    const unsigned ldsw = (unsigned)wid * 1024u;
    const int aoff = lds_byte(wr * 64 + fr, fq * 8), boff = lds_byte(wc * 32 + fr, fq * 8);
#define PG8_SA(b, h) (((b) * 2 + (h)) * HTB)
#define PG8_SB(b, h) ((4 + (b) * 2 + (h)) * HTB)
#define PG8_STAGE(bufoff, gbase, voff) do { _Pragma("unroll") for (int _i = 0; _i < 2; ++_i) \
        __builtin_amdgcn_global_load_lds((const unsigned*)((const char*)(gbase) + (voff)[_i]), (PG8_LAS unsigned*)(lds + (bufoff) + ldsw + _i * 8192), 16, 0, 0); } while (0)
#define PG8_LDA(dst, b, h) do { _Pragma("unroll") for (int m = 0; m < 4; ++m) _Pragma("unroll") for (int k = 0; k < 2; ++k) dst[m][k] = *(const PG8_LAS bf16x8*)(lds + PG8_SA(b, h) + aoff + m * 2048 + k * 1024); } while (0)
#define PG8_LDB(dst, b, h) do { _Pragma("unroll") for (int n = 0; n < 2; ++n) _Pragma("unroll") for (int k = 0; k < 2; ++k) dst[n][k] = *(const PG8_LAS bf16x8*)(lds + PG8_SB(b, h) + boff + n * 2048 + k * 1024); } while (0)
#define PG8_MMA(ai, bj, At, Bt) do { __builtin_amdgcn_s_setprio(1); _Pragma("unroll") for (int m = 0; m < 4; ++m) _Pragma("unroll") for (int n = 0; n < 2; ++n) _Pragma("unroll") for (int k = 0; k < 2; ++k) \
        acc[ai][bj][m][n] = __builtin_amdgcn_mfma_f32_16x16x32_bf16(Bt[n][k], At[m][k], acc[ai][bj][m][n], 0, 0, 0); __builtin_amdgcn_s_setprio(0); } while (0)
#define PG8_WAIT_V(n) asm volatile("s_waitcnt vmcnt(" #n ")" ::: "memory")
#define PG8_WAIT_L(n) asm volatile("s_waitcnt lgkmcnt(" #n ")" ::: "memory")
#define PG8_BAR __builtin_amdgcn_s_barrier()
#define PG8_SCHED __builtin_amdgcn_sched_barrier(0)
    Unit cur, nxt; int ui = 0;
    if (!S.next(0, cur)) return;
    f32x4 acc[2][2][4][2];
#pragma unroll
    for (int a = 0; a < 2; ++a)
#pragma unroll
        for (int b = 0; b < 2; ++b)
#pragma unroll
            for (int m = 0; m < 4; ++m)
#pragma unroll
                for (int n = 0; n < 2; ++n) acc[a][b][m][n] = (f32x4){0.f, 0.f, 0.f, 0.f};
    bf16x8 At[4][2], B0[2][2], B1[2][2];
    const char* cA = (const char*)g.A + (size_t)cur.pm * tstep; const char* cB = (const char*)g.Bt + (size_t)cur.pn * tstep;
    S.a_ready(cur);
    if constexpr (SP2) {
        PG8_STAGE(PG8_SB(0, 0), cB, voffB); PG8_STAGE(PG8_SB(0, 1), cB + hstep, voffB); PG8_STAGE(PG8_SA(0, 0), cA, voffA); PG8_STAGE(PG8_SA(0, 1), cA + hstep, voffA);
        if (wr == 1) PG8_BAR;
        PG8_WAIT_V(2); PG8_BAR;
        PG8_STAGE(PG8_SB(1, 0), cB + kstep, voffB); PG8_STAGE(PG8_SA(1, 0), cA + kstep, voffA); PG8_STAGE(PG8_SB(1, 1), cB + hstep + kstep, voffB);
        PG8_WAIT_V(6); PG8_BAR;
    } else {
        PG8_STAGE(PG8_SB(0, 0), cB, voffB); PG8_STAGE(PG8_SA(0, 0), cA, voffA); PG8_STAGE(PG8_SB(0, 1), cB + hstep, voffB); PG8_STAGE(PG8_SA(0, 1), cA + hstep, voffA);
        if (wr == 1) PG8_BAR;
        PG8_WAIT_V(4); PG8_BAR;
        PG8_STAGE(PG8_SB(1, 0), cB + kstep, voffB); PG8_STAGE(PG8_SA(1, 0), cA + kstep, voffA); PG8_STAGE(PG8_SB(1, 1), cB + hstep + kstep, voffB);
        PG8_WAIT_V(6); PG8_BAR;
    }
    for (;;) {
        const bool has_next = S.next(ui + 1, nxt);
        const char* nA = has_next ? (const char*)g.A + (size_t)nxt.pm * tstep : cA; const char* nB = has_next ? (const char*)g.Bt + (size_t)nxt.pn * tstep : cB;
        for (int t = 0; t < nt; t += 2) {
            const bool last = (t == nt - 2);
            const char* a1 = cA + (size_t)(t + 1) * kstep;
            const char* a2 = last ? nA : cA + (size_t)(t + 2) * kstep; const char* b2 = last ? nB : cB + (size_t)(t + 2) * kstep;
            const char* a3 = a2 + kstep; const char* b3 = b2 + kstep;
            if (last && has_next) S.a_ready(nxt);
            if constexpr (SP2) {
            PG8_LDB(B0, 0, 0); PG8_LDB(B1, 0, 1); PG8_SCHED; PG8_LDA(At, 0, 0); PG8_STAGE(PG8_SA(1, 1), a1 + hstep, voffA);
            PG8_WAIT_V(8); PG8_WAIT_L(0); PG8_BAR; PG8_MMA(0, 0, At, B0); PG8_MMA(0, 1, At, B1); PG8_BAR; PG8_SCHED;
            PG8_LDA(At, 0, 1); PG8_STAGE(PG8_SB(0, 0), b2, voffB); PG8_STAGE(PG8_SB(0, 1), b2 + hstep, voffB); PG8_STAGE(PG8_SA(0, 0), a2, voffA);
            PG8_WAIT_V(8); PG8_WAIT_L(0); PG8_BAR; PG8_MMA(1, 0, At, B0); PG8_MMA(1, 1, At, B1); PG8_BAR; PG8_SCHED;
            PG8_LDB(B0, 1, 0); PG8_LDB(B1, 1, 1); PG8_SCHED; PG8_LDA(At, 1, 0); PG8_STAGE(PG8_SA(0, 1), a2 + hstep, voffA);
            PG8_WAIT_V(8); PG8_WAIT_L(0); PG8_BAR; PG8_MMA(0, 0, At, B0); PG8_MMA(0, 1, At, B1); PG8_BAR; PG8_SCHED;
            PG8_LDA(At, 1, 1); PG8_STAGE(PG8_SB(1, 0), b3, voffB); PG8_STAGE(PG8_SB(1, 1), b3 + hstep, voffB); PG8_STAGE(PG8_SA(1, 0), a3, voffA);
            PG8_WAIT_V(8); PG8_WAIT_L(0); PG8_BAR; PG8_MMA(1, 0, At, B0); PG8_MMA(1, 1, At, B1); PG8_BAR; PG8_SCHED;
            } else {
            PG8_LDB(B0, 0, 0); PG8_SCHED; PG8_LDA(At, 0, 0); PG8_STAGE(PG8_SA(1, 1), a1 + hstep, voffA);
            PG8_WAIT_L(8); PG8_BAR; PG8_WAIT_L(0); PG8_MMA(0, 0, At, B0); PG8_BAR; PG8_SCHED;
            PG8_LDB(B1, 0, 1); PG8_STAGE(PG8_SB(0, 0), b2, voffB);
            PG8_BAR; PG8_WAIT_L(0); PG8_MMA(0, 1, At, B1); PG8_BAR;
            PG8_LDA(At, 0, 1); PG8_STAGE(PG8_SA(0, 0), a2, voffA);
            PG8_BAR; PG8_WAIT_L(0); PG8_MMA(1, 0, At, B0); PG8_BAR; PG8_SCHED;
            PG8_STAGE(PG8_SB(0, 1), b2 + hstep, voffB);
            PG8_WAIT_V(6); PG8_BAR; PG8_MMA(1, 1, At, B1); PG8_BAR;
            PG8_LDB(B0, 1, 0); PG8_SCHED; PG8_LDA(At, 1, 0); PG8_STAGE(PG8_SA(0, 1), a2 + hstep, voffA);
            PG8_WAIT_L(8); PG8_BAR; PG8_WAIT_L(0); PG8_MMA(0, 0, At, B0); PG8_BAR; PG8_SCHED;
            PG8_LDB(B1, 1, 1); PG8_STAGE(PG8_SB(1, 0), b3, voffB);
            PG8_BAR; PG8_WAIT_L(0); PG8_MMA(0, 1, At, B1); PG8_BAR;
            PG8_LDA(At, 1, 1); PG8_STAGE(PG8_SA(1, 0), a3, voffA);
            PG8_BAR; PG8_WAIT_L(0); PG8_MMA(1, 0, At, B0); PG8_BAR; PG8_SCHED;
            PG8_STAGE(PG8_SB(1, 1), b3 + hstep, voffB);
            PG8_WAIT_V(6); PG8_BAR; PG8_MMA(1, 1, At, B1); PG8_BAR;
            }
        }
        if constexpr (ALIGN_EPI) { if (wr == 0) PG8_BAR; }
        if constexpr (!Epi::AFTER_DRAIN) { E(acc, cur, wr, wc, fr, fq); S.done(cur); }
        if (!has_next) break;
#pragma unroll
        for (int a = 0; a < 2; ++a)
#pragma unroll
            for (int b = 0; b < 2; ++b)
#pragma unroll
                for (int m = 0; m < 4; ++m)
#pragma unroll
                    for (int n = 0; n < 2; ++n) acc[a][b][m][n] = (f32x4){0.f, 0.f, 0.f, 0.f};
        cur = nxt; cA = nA; cB = nB; ++ui;
        if constexpr (ALIGN_EPI) { if (wr == 1) PG8_BAR; }
    }
    PG8_WAIT_V(0);
    if constexpr (!ALIGN_EPI) { if (wr == 0) PG8_BAR; }
    PG8_BAR;
    if constexpr (Epi::AFTER_DRAIN) { E.fused(acc, cur, wr, wc, fr, fq, lds, wid, lane); S.done(cur); }
#undef PG8_SA
#undef PG8_SB
#undef PG8_STAGE
#undef PG8_LDA
#undef PG8_LDB
#undef PG8_MMA
#undef PG8_WAIT_V
#undef PG8_WAIT_L
#undef PG8_BAR
#undef PG8_SCHED
}
}
#ifndef MK_ONE_LAUNCH
#define MK_ONE_LAUNCH 1
#endif
#ifndef MK_PROBE
#define MK_PROBE (-1)
#endif
#ifndef MK_NAIVE_LRU
#define MK_NAIVE_LRU 0
#endif
constexpr int NWAVES = 8, NTHR = NWAVES * 64;
constexpr int NB = 8, SEQ = 2048, MT = NB * SEQ, DM = 2048, LW = 2560, NH = 20, HD = 128, CW = 2048, DFF = 8192, INC = 12800;
constexpr float ALPHA = 1.18920711500272f;
constexpr float LN_EPS = 1e-5f;
constexpr int NPHASE = 9;
constexpr size_t MiB = 1u << 20;
constexpr size_t WS_CTL = 0, CTL_BYTES = 1 * MiB;
constexpr size_t WS_ST1 = 1 * MiB, WS_ST2 = 5 * MiB;
constexpr size_t WS_WG = 9 * MiB;
constexpr size_t WS_WLO = 12 * MiB, WS_WCO = 22 * MiB, WS_WO = 30 * MiB, WS_W1 = 38 * MiB, WS_W2 = 70 * MiB;
constexpr size_t WS_LX = 102 * MiB;
constexpr size_t WS_SEC = 182 * MiB, SEC_BYTES = 64 * MiB;
constexpr size_t WS_T1 = 102 * MiB;
constexpr size_t WS_FF = 102 * MiB;
constexpr size_t WS_H1B = WS_SEC + 3 * SEC_BYTES;
constexpr size_t WS_END = WS_SEC + 5 * SEC_BYTES;
static_assert(WS_FF + (size_t)MT * DFF * 2 <= WS_H1B, "FF overlay must end before H1B");
constexpr size_t DO_XB = 0, DO_WINT = 64 * MiB, DO_HS = 0;
constexpr int CW_ZQ = 64;
constexpr int CW_BAR = 4096;
constexpr int LDS_BYTES = 147456, MISC_OFF = 147456 - 256;

#define GAS __attribute__((address_space(1)))
#define LAS __attribute__((address_space(3)))
typedef unsigned short bf16;
typedef unsigned v4u __attribute__((ext_vector_type(4)));
typedef unsigned v2u __attribute__((ext_vector_type(2)));
typedef float f32x4 __attribute__((ext_vector_type(4)));
typedef float f32x2 __attribute__((ext_vector_type(2)));
#define LDS_WAIT() asm volatile("s_waitcnt lgkmcnt(0)" ::: "memory")
__device__ __forceinline__ unsigned f2bf(float f) { unsigned u = __builtin_bit_cast(unsigned, f); return (u + 0x7fffu + ((u >> 16) & 1u)) >> 16; }
__device__ __forceinline__ unsigned pk2(float lo, float hi) { return f2bf(lo) | (f2bf(hi) << 16); }
__device__ __forceinline__ unsigned cvtpk(float lo, float hi) { unsigned r; asm("v_cvt_pk_bf16_f32 %0, %1, %2" : "=v"(r) : "v"(lo), "v"(hi)); return r; }
__device__ __forceinline__ float bf2f(unsigned short b) { return __uint_as_float(((unsigned)b) << 16); }
__device__ __forceinline__ float bflo(unsigned w) { return __uint_as_float(w << 16); }
__device__ __forceinline__ float bfhi(unsigned w) { return __uint_as_float(w & 0xffff0000u); }

__device__ __forceinline__ void p0_transpose_item(const float* W, int K, int N, bf16* WT, LAS float* scr, int item, int lane) {
    const int nblk = N / 32, kb = item / nblk, nb = item % nblk, k0 = 64 * kb, n0 = 32 * nb;
#pragma unroll 8
    for (int i = 0; i < 32; ++i) { const int kk = 2 * i + (lane >> 5); scr[kk * 33 + (lane & 31)] = W[(size_t)(k0 + kk) * N + n0 + (lane & 31)]; }
    LDS_WAIT(); asm volatile("" ::: "memory");
    const int c = lane & 7;
#pragma unroll
    for (int j = 0; j < 4; ++j) { const int n = (lane >> 3) + 8 * j; const LAS float* s = scr + (8 * c) * 33 + n;
        v4u o; o.x = cvtpk(s[0 * 33], s[1 * 33]); o.y = cvtpk(s[2 * 33], s[3 * 33]); o.z = cvtpk(s[4 * 33], s[5 * 33]); o.w = cvtpk(s[6 * 33], s[7 * 33]);
        *(v4u*)(WT + (size_t)(n0 + n) * K + k0 + 8 * c) = o; }
    LDS_WAIT(); asm volatile("" ::: "memory");
}

__device__ __forceinline__ void ln_apply_row(const float* vrow, const f32x2* strow, const float* gam, const float* bet, float* outf, bf16* outb, int lane) {
    const f32x2 p = strow[lane & 31];
    float ms = p.x;
#pragma unroll
    for (int o = 1; o < 32; o <<= 1) ms += __shfl_xor(ms, o);
    const float mean = ms * (1.0f / 32.0f);
    const float dm = p.x - mean; float q = p.y + 64.0f * dm * dm;
#pragma unroll
    for (int o = 1; o < 32; o <<= 1) q += __shfl_xor(q, o);
    const float rstd = 1.0f / sqrtf(q * (1.0f / 2048.0f) + LN_EPS);
    const f32x4* v4 = (const f32x4*)vrow; const f32x4* g4 = (const f32x4*)gam; const f32x4* b4 = (const f32x4*)bet;
#pragma unroll
    for (int j = 0; j < 8; ++j) { const int i = 64 * j + lane; const f32x4 x = v4[i]; const f32x4 y = (x - mean) * rstd * g4[i] + b4[i];
        ((f32x4*)outf)[i] = y;
        if (outb) { v2u w; w.x = cvtpk(y[0], y[1]); w.y = cvtpk(y[2], y[3]); ((v2u*)outb)[i] = w; } }
}

__device__ __forceinline__ void z_item(int item, const bf16* CX, bf16* CBZ, const bf16* CC, const float* w, const float* bias, int tid) {
    const int cg = tid & 255, rh = tid >> 8, R0 = item * 32 + rh * 16, t0 = R0 & (SEQ - 1), c0 = cg * 8;
    float w0[8], w1[8], w2[8], bb[8];
#pragma unroll
    for (int j = 0; j < 8; ++j) { w0[j] = w[c0 + j]; w1[j] = w[CW + c0 + j]; w2[j] = w[2 * CW + c0 + j]; bb[j] = bias[c0 + j]; }
    const v4u zero4 = {0u, 0u, 0u, 0u};
#define MULCX(dst, a_, b_) do { dst[0] = bflo(a_.x) * bflo(b_.x); dst[1] = bfhi(a_.x) * bfhi(b_.x); dst[2] = bflo(a_.y) * bflo(b_.y); dst[3] = bfhi(a_.y) * bfhi(b_.y); \
        dst[4] = bflo(a_.z) * bflo(b_.z); dst[5] = bfhi(a_.z) * bfhi(b_.z); dst[6] = bflo(a_.w) * bflo(b_.w); dst[7] = bfhi(a_.w) * bfhi(b_.w); } while (0)
#pragma unroll 1
    for (int ck = 0; ck < 4; ++ck) {
        const int Rc = R0 + 4 * ck, tc = t0 + 4 * ck;
        v4u xa[6], xc[6], cbv[4];
#pragma unroll
        for (int k = 0; k < 6; ++k) { const bool ok = (tc + k - 1 >= 0) && (tc + k - 1 < SEQ);
            xa[k] = ok ? *(const v4u*)(CX + (size_t)(Rc + k - 1) * CW + c0) : zero4; xc[k] = ok ? *(const v4u*)(CC + (size_t)(Rc + k - 1) * CW + c0) : zero4; }
#pragma unroll
        for (int i = 0; i < 4; ++i) cbv[i] = *(const v4u*)(CBZ + (size_t)(Rc + i) * CW + c0);
        float pv[8], cu[8], nx[8];
        MULCX(pv, xa[0], xc[0]); MULCX(cu, xa[1], xc[1]);
#pragma unroll
        for (int i = 0; i < 4; ++i) {
            MULCX(nx, xa[i + 2], xc[i + 2]);
            float z[8];
#pragma unroll
            for (int j = 0; j < 8; ++j) z[j] = w0[j] * pv[j] + w1[j] * cu[j] + w2[j] * nx[j] + bb[j];
            const v4u cb = cbv[i];
            v4u o; o.x = cvtpk(bflo(cb.x) * z[0], bfhi(cb.x) * z[1]); o.y = cvtpk(bflo(cb.y) * z[2], bfhi(cb.y) * z[3]); o.z = cvtpk(bflo(cb.z) * z[4], bfhi(cb.z) * z[5]); o.w = cvtpk(bflo(cb.w) * z[6], bfhi(cb.w) * z[7]);
            *(v4u*)(CBZ + (size_t)(Rc + i) * CW + c0) = o;
#pragma unroll
            for (int j = 0; j < 8; ++j) { pv[j] = cu[j]; cu[j] = nx[j]; }
        }
    }
#undef MULCX
}

#if MK_NAIVE_LRU
__device__ __forceinline__ void lru_naive_item(int b, int hd, const bf16* LX, const float* cw, const float* cb, const float* wa, const float* ba, const float* wx, const float* bx,
                                               const float* lam, bf16* HS, LAS float* us, int tid) {
    const int dir = (tid >> 7) & 1, e = tid & 127; const bool act = tid < 256; const int ch = hd * HD + e;
    const float c0 = cw[ch], c1 = cw[LW + ch], c2 = cw[2 * LW + ch], c3 = cw[3 * LW + ch], cbias = cb[ch];
    const float b_a = ba[(dir * NH + hd) * HD + e], b_x = bx[(dir * NH + hd) * HD + e];
    const float kl = -8.0f * log1pf(expf(-lam[dir * LW + ch]));
    const float* Wa = wa + (size_t)(dir * NH + hd) * HD * HD + e; const float* Wx = wx + (size_t)(dir * NH + hd) * HD * HD + e;
    float h = 0.f;
    for (int s = 0; s < SEQ; ++s) {
        const int t = dir ? (SEQ - 1 - s) : s;
        float u = cbias;
        if (act) { const bf16* p = LX + ((size_t)b * SEQ + t) * LW + ch;
            if (t >= 2) u += c0 * bf2f(p[-2 * LW]); if (t >= 1) u += c1 * bf2f(p[-LW]); u += c2 * bf2f(p[0]); if (t + 1 < SEQ) u += c3 * bf2f(p[LW]);
            us[dir * HD + e] = u; }
        __syncthreads();
        if (act) { float ra = b_a, ri = b_x;
            for (int d = 0; d < HD; ++d) { const float ud = us[dir * HD + d]; ra += ud * Wa[d * HD]; ri += ud * Wx[d * HD]; }
            const float r = 1.0f / (1.0f + expf(-ra)), ig = 1.0f / (1.0f + expf(-ri));
            const float la = kl * r, a = expf(la), g = sqrtf(fmaxf(-expm1f(2.0f * la), 0.f)) * (ig * u);
            h = a * h + g;
            bf16* o = HS + ((size_t)b * SEQ + t) * LW + ch;
            if (s < SEQ / 2) *o = (bf16)f2bf(h); else *o = (bf16)f2bf(bf2f(*o) + h); }
        __syncthreads();
    }
}
#endif


#if !MK_NAIVE_LRU
__device__ __forceinline__ void lru_fast_item(int b, int hd, const bf16* LX, const float* cw, const float* cb, const bf16* WGt, const float* ba, const float* bx, const float* lam, bf16* HS,
                                              LAS unsigned char* lds, int tid, int lane, int wave) {
    constexpr int T = 64, S = SEQ / T; constexpr float L2E = 1.44269504089f;
    typedef short bf16x8 __attribute__((ext_vector_type(8)));
    const int q = lane >> 4, c = lane & 15, chl = 16 * wave + c, ch = hd * HD + chl;
    float nba[2], nbx[2], kl2[2], hc[2];
    bf16x8 Bf[2][2][4];
#pragma unroll
    for (int d = 0; d < 2; ++d) { nba[d] = -L2E * ba[(d * NH + hd) * HD + chl]; nbx[d] = -L2E * bx[(d * NH + hd) * HD + chl]; kl2[d] = -8.0f * L2E * log1pf(expf(-lam[d * LW + ch])); hc[d] = 0.f;
#pragma unroll
        for (int g = 0; g < 2; ++g)
#pragma unroll
            for (int ks = 0; ks < 4; ++ks) Bf[d][g][ks] = *(const bf16x8*)(WGt + ((size_t)((g * 2 + d) * NH + hd) * HD + chl) * HD + 32 * ks + 8 * q); }
    LAS float* cwl = (LAS float*)(lds + 65536 + 2 * 17408);
    for (int i = tid; i < 640; i += NTHR) { const int k = i >> 7, e = i & 127; cwl[i] = (k < 4) ? cw[k * LW + hd * HD + e] : cb[hd * HD + e]; }
    const int cg = tid & 15, rr = tid >> 4, cdir = rr >> 4, run = rr & 15;
    const bf16* lxb = LX + (size_t)b * SEQ * LW + hd * HD + 8 * cg;
    v4u xr[7];
#define LRU_LOAD7(step) do { const int ts_ = (cdir ? SEQ - ((step) + 1) * T : (step) * T) + 4 * run - 2; \
        _Pragma("unroll") for (int k_ = 0; k_ < 7; ++k_) { const int tok_ = ts_ + k_; xr[k_] = (tok_ >= 0 && tok_ < SEQ) ? *(const v4u*)(lxb + (size_t)tok_ * LW) : (v4u){0u, 0u, 0u, 0u}; } } while (0)
#define LRU_CONV_WRITE(buf) do { float wk_[5][8]; \
        _Pragma("unroll") for (int k_ = 0; k_ < 5; ++k_) { const f32x4 a_ = *(const LAS f32x4*)(cwl + k_ * 128 + 8 * cg), b_ = *(const LAS f32x4*)(cwl + k_ * 128 + 8 * cg + 4); \
            wk_[k_][0] = a_[0]; wk_[k_][1] = a_[1]; wk_[k_][2] = a_[2]; wk_[k_][3] = a_[3]; wk_[k_][4] = b_[0]; wk_[k_][5] = b_[1]; wk_[k_][6] = b_[2]; wk_[k_][7] = b_[3]; } \
        LAS unsigned char* ub_ = lds + (cdir * 2 + (buf)) * 16384; \
        _Pragma("unroll") for (int i_ = 0; i_ < 4; ++i_) { float o_[8]; \
            _Pragma("unroll") for (int j_ = 0; j_ < 8; ++j_) o_[j_] = wk_[4][j_]; \
            _Pragma("unroll") for (int k_ = 0; k_ < 4; ++k_) { const v4u x_ = xr[i_ + k_]; \
                o_[0] += wk_[k_][0] * bflo(x_.x); o_[1] += wk_[k_][1] * bfhi(x_.x); o_[2] += wk_[k_][2] * bflo(x_.y); o_[3] += wk_[k_][3] * bfhi(x_.y); \
                o_[4] += wk_[k_][4] * bflo(x_.z); o_[5] += wk_[k_][5] * bfhi(x_.z); o_[6] += wk_[k_][6] * bflo(x_.w); o_[7] += wk_[k_][7] * bfhi(x_.w); } \
            const int row_ = 4 * run + i_; v4u w_; w_.x = pk2(o_[0], o_[1]); w_.y = pk2(o_[2], o_[3]); w_.z = pk2(o_[4], o_[5]); w_.w = pk2(o_[6], o_[7]); \
            *(LAS v4u*)(ub_ + row_ * 256 + ((cg ^ (row_ & 15)) << 4)) = w_; } } while (0)
    __syncthreads();
    LRU_LOAD7(0);
    LRU_CONV_WRITE(0);
    __syncthreads();
    for (int s = 0; s < S; ++s) {
        if (s + 1 < S) LRU_LOAD7(s + 1);
        const bool first_half = s < S / 2;
        const int fd = tid >> 8, ftile0 = fd ? SEQ - (s + 1) * T : s * T;
        bf16* fbase = HS + ((size_t)b * SEQ + ftile0) * LW + hd * HD;
        v4u pr[4];
        if (!first_half) {
#pragma unroll
            for (int j = 0; j < 4; ++j) { const int id = (tid & 255) + 256 * j; pr[j] = *(const v4u*)(fbase + (size_t)(id >> 4) * LW + (id & 15) * 8); }
        }
#pragma unroll
        for (int d = 0; d < 2; ++d) {
            const LAS unsigned char* ub = lds + (d * 2 + (s & 1)) * 16384;
#pragma unroll 1
            for (int rbi = 0; rbi < 4; ++rbi) {
                const int rb = d ? 3 - rbi : rbi;
                pg8::f32x4 accA = {0.f, 0.f, 0.f, 0.f}, accX = {0.f, 0.f, 0.f, 0.f};
                const LAS unsigned char* arow = ub + (16 * rb + c) * 256;
#pragma unroll
                for (int ks = 0; ks < 4; ++ks) { const bf16x8 af = *(const LAS bf16x8*)(arow + (((q + 4 * ks) ^ c) << 4));
                    accA = __builtin_amdgcn_mfma_f32_16x16x32_bf16(af, Bf[d][0][ks], accA, 0, 0, 0);
                    accX = __builtin_amdgcn_mfma_f32_16x16x32_bf16(af, Bf[d][1][ks], accX, 0, 0, 0); }
                float av[4], gv[4];
#pragma unroll
                for (int i = 0; i < 4; ++i) { const int rowi = 16 * rb + 4 * q + i;
                    const float u = bf2f(*(const LAS unsigned short*)(ub + rowi * 256 + (((chl >> 3) ^ (rowi & 15)) << 4) + (chl & 7) * 2));
                    const float r = __builtin_amdgcn_rcpf(1.0f + __builtin_amdgcn_exp2f(accA[i] * -L2E + nba[d]));
                    const float ig = __builtin_amdgcn_rcpf(1.0f + __builtin_amdgcn_exp2f(accX[i] * -L2E + nbx[d]));
                    const float a = __builtin_amdgcn_exp2f(kl2[d] * r);
                    av[i] = a; gv[i] = __builtin_amdgcn_sqrtf(fmaxf(1.0f - a * a, 0.f)) * (ig * u); }
                float Ap[4], Hp[4], hv[4];
                if (d == 0) {
                    Ap[0] = av[0]; Hp[0] = gv[0];
#pragma unroll
                    for (int i = 1; i < 4; ++i) { Ap[i] = av[i] * Ap[i - 1]; Hp[i] = av[i] * Hp[i - 1] + gv[i]; }
                    float IA = Ap[3], IH = Hp[3];
                    { const float pa = __shfl_up(IA, 16), ph = __shfl_up(IH, 16); if (q >= 1) { IH = IA * ph + IH; IA = IA * pa; } }
                    { const float pa = __shfl_up(IA, 32), ph = __shfl_up(IH, 32); if (q >= 2) { IH = IA * ph + IH; IA = IA * pa; } }
                    float EA = __shfl_up(IA, 16), EH = __shfl_up(IH, 16); if (q == 0) { EA = 1.f; EH = 0.f; }
                    const float hin = EA * hc[d] + EH;
#pragma unroll
                    for (int i = 0; i < 4; ++i) hv[i] = Ap[i] * hin + Hp[i];
                    hc[d] = __shfl(hv[3], 48 + c);
                } else {
                    Ap[3] = av[3]; Hp[3] = gv[3];
#pragma unroll
                    for (int i = 2; i >= 0; --i) { Ap[i] = av[i] * Ap[i + 1]; Hp[i] = av[i] * Hp[i + 1] + gv[i]; }
                    float IA = Ap[0], IH = Hp[0];
                    { const float pa = __shfl_down(IA, 16), ph = __shfl_down(IH, 16); if (q <= 2) { IH = IA * ph + IH; IA = IA * pa; } }
                    { const float pa = __shfl_down(IA, 32), ph = __shfl_down(IH, 32); if (q <= 1) { IH = IA * ph + IH; IA = IA * pa; } }
                    float EA = __shfl_down(IA, 16), EH = __shfl_down(IH, 16); if (q == 3) { EA = 1.f; EH = 0.f; }
                    const float hin = EA * hc[d] + EH;
#pragma unroll
                    for (int i = 0; i < 4; ++i) hv[i] = Ap[i] * hin + Hp[i];
                    hc[d] = __shfl(hv[0], c);
                }
                LAS unsigned char* hp = lds + 65536 + d * 17408 + (16 * rb + 4 * q) * 272 + chl * 2;
#pragma unroll
                for (int i = 0; i < 4; ++i) *(LAS unsigned short*)(hp + i * 272) = (unsigned short)f2bf(hv[i]);
            }
        }
        __syncthreads();
        {
            const LAS unsigned char* hb = lds + 65536 + fd * 17408;
#pragma unroll
            for (int j = 0; j < 4; ++j) { const int id = (tid & 255) + 256 * j; v4u hw = *(const LAS v4u*)(hb + (id >> 4) * 272 + (id & 15) * 16);
                if (!first_half) { const v4u p = pr[j];
                    hw.x = pk2(bflo(hw.x) + bflo(p.x), bfhi(hw.x) + bfhi(p.x)); hw.y = pk2(bflo(hw.y) + bflo(p.y), bfhi(hw.y) + bfhi(p.y));
                    hw.z = pk2(bflo(hw.z) + bflo(p.z), bfhi(hw.z) + bfhi(p.z)); hw.w = pk2(bflo(hw.w) + bflo(p.w), bfhi(hw.w) + bfhi(p.w)); }
                *(v4u*)(fbase + (size_t)(id >> 4) * LW + (id & 15) * 8) = hw; }
        }
        if (s + 1 < S) LRU_CONV_WRITE((s + 1) & 1);
        asm volatile("s_waitcnt vmcnt(0)" ::: "memory");
        __syncthreads();
    }
#undef LRU_LOAD7
#undef LRU_CONV_WRITE
}
#endif


#if !MK_NAIVE_LRU
__device__ __forceinline__ void lru2_item(int b, int hd, const bf16* LX, const float* cw, const float* cb, const bf16* WGt, const float* ba, const float* bx, const float* lam, bf16* HS,
                                          const bf16* zrow, LAS unsigned char* lds, int tid, int lane, int wave, unsigned long long& pacc) {
    constexpr int T = 64, S = SEQ / T; constexpr float L2E = 1.44269504089f;
    unsigned long long ptm = 0ull;
#define LP(k) do { if (MK_PROBE == (k)) ptm = __builtin_amdgcn_s_memrealtime(); } while (0)
#define LQ(k) do { if (MK_PROBE == (k)) pacc += __builtin_amdgcn_s_memrealtime() - ptm; } while (0)
    constexpr int U_OFF = 0, UT_OFF = 32768, UT_STRIDE = 144, UT_BYTES = 128 * UT_STRIDE, H_OFF = UT_OFF + 2 * UT_BYTES, H_STRIDE = 272, H_BYTES = 64 * H_STRIDE, CWL_OFF = H_OFF + 2 * H_BYTES,
                  RAW_OFF = CWL_OFF + 2560, RAW_BYTES = 68 * 256;
    static_assert(RAW_OFF + 2 * RAW_BYTES <= MISC_OFF, "LRU LDS map");
    typedef short bf16x8 __attribute__((ext_vector_type(8)));
    typedef float f32x16 __attribute__((ext_vector_type(16)));
    const int wd = wave >> 2, chg = wave & 3, r = lane & 31, h = lane >> 5, chl = 32 * chg + r, ch = hd * HD + chl;
    const float nba = -L2E * ba[(wd * NH + hd) * HD + chl], nbx = -L2E * bx[(wd * NH + hd) * HD + chl], kl2 = -8.0f * L2E * log1pf(expf(-lam[wd * LW + ch]));
    bf16x8 Bf[2][8];
#pragma unroll
    for (int g = 0; g < 2; ++g)
#pragma unroll
        for (int ks = 0; ks < 8; ++ks) Bf[g][ks] = *(const bf16x8*)(WGt + ((size_t)((g * 2 + wd) * NH + hd) * HD + chl) * HD + 16 * ks + 8 * h);
    LAS float* cwl = (LAS float*)(lds + CWL_OFF);
    for (int i = tid; i < 640; i += NTHR) { const int k = i >> 7, e = i & 127; cwl[i] = (k < 4) ? cw[k * LW + hd * HD + e] : cb[hd * HD + e]; }
    const int cg = tid & 15, rr = tid >> 4, cdir = rr >> 4, run = rr & 15;
    const bf16* lxh = LX + (size_t)b * SEQ * LW + hd * HD;
    const int tau = 16 * ((r >> 2) & 1) + 4 * (r >> 3) + (r & 3);
#define LRU_LOAD7(step) do { for (int n_ = wave; n_ < 34; n_ += 8) { const int dd_ = n_ >= 17 ? 1 : 0, j_ = n_ - 17 * dd_, rr_ = 4 * j_ + (lane >> 4); \
            const int tok_ = (dd_ ? SEQ - ((step) + 1) * T : (step) * T) - 2 + rr_; \
            const bf16* src_ = (tok_ >= 0 && tok_ < SEQ && rr_ < 67) ? lxh + (size_t)tok_ * LW + 8 * (lane & 15) : zrow + 8 * (lane & 15); \
            __builtin_amdgcn_global_load_lds((const unsigned*)src_, (LAS unsigned*)(lds + RAW_OFF + dd_ * RAW_BYTES + j_ * 1024), 16, 0, 0); } } while (0)
#define LRU_CONV_WRITE(cg, run) do { _Pragma("unroll 1") for (int hf_ = 0; hf_ < 2; ++hf_) { f32x2 wk_[5][2]; v2u xr[7];     \
        _Pragma("unroll") for (int k_ = 0; k_ < 7; ++k_) xr[k_] = *(const LAS v2u*)(lds + RAW_OFF + cdir * RAW_BYTES + (4 * (run) + k_) * 256 + (cg) * 16 + 8 * hf_); \
        _Pragma("unroll") for (int k_ = 0; k_ < 5; ++k_) { const f32x4 a_ = *(const LAS f32x4*)(cwl + k_ * 128 + 8 * (cg) + 4 * hf_); \
            wk_[k_][0] = (f32x2){a_[0], a_[1]}; wk_[k_][1] = (f32x2){a_[2], a_[3]}; } \
        LAS unsigned char* ub_ = lds + U_OFF + cdir * 16384; LAS unsigned char* ut_ = lds + UT_OFF + cdir * UT_BYTES; unsigned pk_[4][2]; \
        _Pragma("unroll") for (int i_ = 0; i_ < 4; ++i_) { f32x2 o0_ = wk_[4][0], o1_ = wk_[4][1]; \
            _Pragma("unroll") for (int k_ = 0; k_ < 4; ++k_) { const v2u x_ = xr[i_ + k_]; \
                o0_ += wk_[k_][0] * (f32x2){bflo(x_.x), bfhi(x_.x)}; o1_ += wk_[k_][1] * (f32x2){bflo(x_.y), bfhi(x_.y)}; } \
            const int row_ = 4 * (run) + i_; pk_[i_][0] = cvtpk(o0_.x, o0_.y); pk_[i_][1] = cvtpk(o1_.x, o1_.y); \
            v2u w_; w_.x = pk_[i_][0]; w_.y = pk_[i_][1]; \
            *(LAS v2u*)(ub_ + row_ * 256 + (((cg) ^ (row_ & 15)) << 4) + 8 * hf_) = w_; } \
        _Pragma("unroll") for (int jj_ = 0; jj_ < 2; ++jj_) {     \
            v2u lo_, hi_; \
            lo_.x = __builtin_amdgcn_perm(pk_[1][jj_], pk_[0][jj_], 0x05040100u); lo_.y = __builtin_amdgcn_perm(pk_[3][jj_], pk_[2][jj_], 0x05040100u); \
            hi_.x = __builtin_amdgcn_perm(pk_[1][jj_], pk_[0][jj_], 0x07060302u); hi_.y = __builtin_amdgcn_perm(pk_[3][jj_], pk_[2][jj_], 0x07060302u); \
            *(LAS v2u*)(ut_ + (8 * (cg) + 4 * hf_ + 2 * jj_) * UT_STRIDE + 8 * (run)) = lo_; *(LAS v2u*)(ut_ + (8 * (cg) + 4 * hf_ + 2 * jj_ + 1) * UT_STRIDE + 8 * (run)) = hi_; } } } while (0)
    LRU_LOAD7(0);
    asm volatile("s_waitcnt vmcnt(0)" ::: "memory");
    __syncthreads();
    LRU_CONV_WRITE(cg, run);
    __syncthreads();
    float hc = 0.f;
    for (int s = 0; s < S; ++s) {
        LP(21);
        int tau_l = tau, cg_l = cg, run_l = run, chl_l = chl;
        asm volatile("" : "+v"(tau_l), "+v"(cg_l), "+v"(run_l), "+v"(chl_l));
        if (s + 1 < S) LRU_LOAD7(s + 1);
        const bool first_half = s < S / 2;
        const int fd = tid >> 8, ftile0 = fd ? SEQ - (s + 1) * T : s * T;
        bf16* fbase = HS + ((size_t)b * SEQ + ftile0) * LW + hd * HD;
        v4u pr[4];
        if (!first_half) {
#pragma unroll
            for (int j = 0; j < 4; ++j) { const int id = (tid & 255) + 256 * j; pr[j] = *(const v4u*)(fbase + (size_t)(id >> 4) * LW + (id & 15) * 8); }
        }
        {
            const LAS unsigned char* ub = lds + U_OFF + wd * 16384; const LAS unsigned char* ut = lds + UT_OFF + wd * UT_BYTES + chl_l * UT_STRIDE;
#pragma unroll 1
            for (int bi = 0; bi < 2; ++bi) {
                const int blk = wd ? 1 - bi : bi, rowp = 32 * blk + tau_l;
                const LAS unsigned char* arow = ub + rowp * 256;
                f32x16 accA, accX;
#pragma unroll
                for (int i = 0; i < 16; ++i) { accA[i] = 0.f; accX[i] = 0.f; }
#pragma unroll
                for (int ks = 0; ks < 8; ++ks) { const bf16x8 af = *(const LAS bf16x8*)(arow + (((2 * ks + h) ^ (rowp & 15)) << 4));
                    accA = __builtin_amdgcn_mfma_f32_32x32x16_bf16(af, Bf[0][ks], accA, 0, 0, 0); }
                float Ap[16], Hp[16];
#pragma unroll
                for (int i = 0; i < 16; i += 2) {
                    const f32x2 t = (f32x2){accA[i], accA[i + 1]} * (-L2E) + nba;
                    const f32x2 d = (f32x2){__builtin_amdgcn_exp2f(t.x), __builtin_amdgcn_exp2f(t.y)} + 1.0f;
                    const f32x2 la = (f32x2){__builtin_amdgcn_rcpf(d.x), __builtin_amdgcn_rcpf(d.y)} * kl2;
                    const f32x2 a = (f32x2){__builtin_amdgcn_exp2f(la.x), __builtin_amdgcn_exp2f(la.y)};
                    const f32x2 m2 = 1.0f - a * a;
                    Ap[i] = a.x; Ap[i + 1] = a.y; Hp[i] = __builtin_amdgcn_sqrtf(m2.x); Hp[i + 1] = __builtin_amdgcn_sqrtf(m2.y); }
                asm volatile("" ::: "memory");
#pragma unroll
                for (int ks = 0; ks < 8; ++ks) { const bf16x8 af = *(const LAS bf16x8*)(arow + (((2 * ks + h) ^ (rowp & 15)) << 4));
                    accX = __builtin_amdgcn_mfma_f32_32x32x16_bf16(af, Bf[1][ks], accX, 0, 0, 0); }
                const v4u u0 = *(const LAS v4u*)(ut + (32 * blk + 16 * h) * 2), u1 = *(const LAS v4u*)(ut + (32 * blk + 16 * h) * 2 + 16);
                float uv[16];
                uv[0] = bflo(u0.x); uv[1] = bfhi(u0.x); uv[2] = bflo(u0.y); uv[3] = bfhi(u0.y); uv[4] = bflo(u0.z); uv[5] = bfhi(u0.z); uv[6] = bflo(u0.w); uv[7] = bfhi(u0.w);
                uv[8] = bflo(u1.x); uv[9] = bfhi(u1.x); uv[10] = bflo(u1.y); uv[11] = bfhi(u1.y); uv[12] = bflo(u1.z); uv[13] = bfhi(u1.z); uv[14] = bflo(u1.w); uv[15] = bfhi(u1.w);
#pragma unroll
                for (int i = 0; i < 16; i += 2) {
                    const f32x2 t = (f32x2){accX[i], accX[i + 1]} * (-L2E) + nbx;
                    const f32x2 d = (f32x2){__builtin_amdgcn_exp2f(t.x), __builtin_amdgcn_exp2f(t.y)} + 1.0f;
                    const f32x2 g = (f32x2){Hp[i], Hp[i + 1]} * ((f32x2){__builtin_amdgcn_rcpf(d.x), __builtin_amdgcn_rcpf(d.y)} * (f32x2){uv[i], uv[i + 1]});
                    Hp[i] = g.x; Hp[i + 1] = g.y; }
                float hin;
                if (wd == 0) {
#pragma unroll
                    for (int i = 1; i < 16; ++i) { Hp[i] = Ap[i] * Hp[i - 1] + Hp[i]; Ap[i] = Ap[i] * Ap[i - 1]; }
                    const float oa = __shfl_xor(Ap[15], 32), oh = __shfl_xor(Hp[15], 32);
                    const float t0a = h ? oa : Ap[15], t0h = h ? oh : Hp[15], t1a = h ? Ap[15] : oa, t1h = h ? Hp[15] : oh;
                    const float hin1 = t0a * hc + t0h; hin = h ? hin1 : hc; hc = t1a * hin1 + t1h;
                } else {
#pragma unroll
                    for (int i = 14; i >= 0; --i) { Hp[i] = Ap[i] * Hp[i + 1] + Hp[i]; Ap[i] = Ap[i] * Ap[i + 1]; }
                    const float oa = __shfl_xor(Ap[0], 32), oh = __shfl_xor(Hp[0], 32);
                    const float t0a = h ? oa : Ap[0], t0h = h ? oh : Hp[0], t1a = h ? Ap[0] : oa, t1h = h ? Hp[0] : oh;
                    const float hin0 = t1a * hc + t1h; hin = h ? hc : hin0; hc = t0a * hin0 + t0h;
                }
                LAS unsigned char* hp = lds + H_OFF + wd * H_BYTES + (32 * blk + 16 * h) * H_STRIDE + chl_l * 2;
#pragma unroll
                for (int i = 0; i < 16; i += 2) { const f32x2 hv = (f32x2){Ap[i], Ap[i + 1]} * hin + (f32x2){Hp[i], Hp[i + 1]}; const unsigned w = cvtpk(hv.x, hv.y);
                    *(LAS unsigned short*)(hp + i * H_STRIDE) = (unsigned short)w; *(LAS unsigned short*)(hp + (i + 1) * H_STRIDE) = (unsigned short)(w >> 16); }
            }
        }
        LQ(21); LP(22);
        asm volatile("s_waitcnt vmcnt(0)" ::: "memory");
        LQ(22); LP(24);
        __syncthreads();
        LQ(24); LP(23);
        {
            const LAS unsigned char* hb = lds + H_OFF + fd * H_BYTES;
#pragma unroll
            for (int j = 0; j < 4; ++j) { const int id = (tid & 255) + 256 * j; v4u hw = *(const LAS v4u*)(hb + (id >> 4) * H_STRIDE + (id & 15) * 16);
                if (!first_half) { const v4u p = pr[j];
                    hw.x = cvtpk(bflo(hw.x) + bflo(p.x), bfhi(hw.x) + bfhi(p.x)); hw.y = cvtpk(bflo(hw.y) + bflo(p.y), bfhi(hw.y) + bfhi(p.y));
                    hw.z = cvtpk(bflo(hw.z) + bflo(p.z), bfhi(hw.z) + bfhi(p.z)); hw.w = cvtpk(bflo(hw.w) + bflo(p.w), bfhi(hw.w) + bfhi(p.w)); }
                *(v4u*)(fbase + (size_t)(id >> 4) * LW + (id & 15) * 8) = hw; }
        }
        __builtin_amdgcn_sched_barrier(0);
        if (s + 1 < S) LRU_CONV_WRITE(cg_l, run_l);
        if (s == S / 2 - 1) asm volatile("s_waitcnt vmcnt(0)" ::: "memory");
        LQ(23); LP(25);
        __syncthreads();
        LQ(25);
    }
    asm volatile("s_waitcnt vmcnt(0)" ::: "memory");
#undef LRU_LOAD7
#undef LRU_CONV_WRITE
#undef LP
#undef LQ
}
#endif

#define XB_TMO      128
#define XB_XCNT(j)  (256  + 64 * (j))
#define XB_XSUB(j)  (1280 + 64 * (j))
#define XB_XGEN(j)  (2304 + 64 * (j))
#define XB_TOP      3328
#define XB_TOPGEN   3392
#define XCD_BAR_WORDS 3456
#define XB_SPIN_CAP (1u << 18)

__device__ __forceinline__ unsigned xb_ld(unsigned* p)              { return __hip_atomic_load(p, __ATOMIC_RELAXED, __HIP_MEMORY_SCOPE_AGENT); }
__device__ __forceinline__ unsigned xb_add(unsigned* p, unsigned v) { return __hip_atomic_fetch_add(p, v, __ATOMIC_RELAXED, __HIP_MEMORY_SCOPE_AGENT); }
__device__ __forceinline__ unsigned xb_xcc_id() { return (unsigned)__builtin_amdgcn_s_getreg((3 << 11) | 20) & 0xFu; }
#define XB_SPIN(cond, bar) do { unsigned _sp = 0; while (cond) { __builtin_amdgcn_s_sleep(1); \
    if ((++_sp & 255u) == 0u) { if (xb_ld(&(bar)[XB_TMO])) break; if (_sp > XB_SPIN_CAP) { atomicAdd(&(bar)[XB_TMO], 1u); break; } } } } while (0)

struct XcdBarrier {
    unsigned* bar; unsigned x;
    volatile LAS unsigned* st;
};

__device__ __forceinline__ XcdBarrier xcd_barrier_post(unsigned* bar, volatile LAS unsigned* st) {
    XcdBarrier b; b.bar = bar; b.x = xb_xcc_id(); b.st = st;
    if (threadIdx.x == 0) (void)xb_add(&bar[XB_XCNT(b.x)], 1u);
    return b;
}
__device__ __forceinline__ void xcd_barrier_complete(unsigned* bar, unsigned x, unsigned& nloc, unsigned& nx) {
    const unsigned G = gridDim.x * gridDim.y * gridDim.z;
    unsigned sum, cnt, mine, sp = 0u;
    for (;;) {
        sum = 0u; cnt = 0u; mine = 0u;
#pragma unroll
        for (unsigned j = 0; j < 16; ++j) { const unsigned c = xb_ld(&bar[XB_XCNT(j)]); sum += c; cnt += (c > 0u) ? 1u : 0u; mine = (j == x) ? c : mine; }
        if (sum == G) break;
        __builtin_amdgcn_s_sleep(1);
        if ((++sp & 255u) == 0u) { if (xb_ld(&bar[XB_TMO])) break; if (sp > XB_SPIN_CAP) { atomicAdd(&bar[XB_TMO], 1u); break; } }
    }
    nloc = mine > 0u ? mine : 1u; nx = cnt > 0u ? cnt : 1u;
}

__device__ __forceinline__ void xcd_barrier(const XcdBarrier& b) {
    asm volatile("s_waitcnt vmcnt(0)" ::: "memory");
    __syncthreads();
    if (threadIdx.x == 0) {
        unsigned* bar = b.bar;
        __builtin_amdgcn_s_waitcnt(0);
        unsigned nloc = b.st[0], nx = b.st[1];
        if (nloc == 0u) { xcd_barrier_complete(bar, b.x, nloc, nx); b.st[0] = nloc; b.st[1] = nx; }
        const unsigned old = xb_add(&bar[XB_XSUB(b.x)], 1u);
        const unsigned gen = old / nloc;
        if (old + 1u == (gen + 1u) * nloc) {
            __builtin_amdgcn_fence(__ATOMIC_RELEASE, "agent");
            asm volatile("s_waitcnt vmcnt(0)" ::: "memory");
            const unsigned og = xb_add(&bar[XB_TOP], 1u);
            const unsigned tg = og / nx;
            if (og + 1u == (tg + 1u) * nx) xb_add(&bar[XB_TOPGEN], 1u);
            else XB_SPIN(xb_ld(&bar[XB_TOPGEN]) == tg, bar);
            __builtin_amdgcn_fence(__ATOMIC_ACQUIRE, "agent");
            xb_add(&bar[XB_XGEN(b.x)], 1u);
            asm volatile("s_waitcnt vmcnt(0)" ::: "memory");
        } else {
            XB_SPIN(xb_ld(&bar[XB_XGEN(b.x)]) == gen, bar);
            __builtin_amdgcn_fence(__ATOMIC_ACQUIRE, "agent");
            asm volatile("s_waitcnt vmcnt(0)" ::: "memory");
        }
    }
    __syncthreads();
}

struct Args { const float* in[22]; float* out; unsigned char* ws; int ph_lo, ph_hi; };

__global__ void __launch_bounds__(NTHR, 2) mk_fwd(Args args) {
    extern __shared__ __attribute__((aligned(16))) unsigned char lds_raw[];
    LAS unsigned char* lds = (LAS unsigned char*)lds_raw;
    volatile LAS unsigned* MISC = (volatile LAS unsigned*)(lds + MISC_OFF);
    const int tid = threadIdx.x, lane = tid & 63, wave = __builtin_amdgcn_readfirstlane(tid >> 6);
    const int G = gridDim.x, bx = blockIdx.x;
    const int gw = bx * NWAVES + wave, NGW = G * NWAVES;
    unsigned char* ws = args.ws; unsigned char* dob = (unsigned char*)args.out;
    unsigned* ctl = (unsigned*)(ws + WS_CTL);
    const float* x = args.in[0]; const float* w_in = args.in[1]; const float* lru_conv_w = args.in[2]; const float* lru_conv_b = args.in[3];
    const float* lru_w_a = args.in[4]; const float* lru_b_a = args.in[5]; const float* lru_w_x = args.in[6]; const float* lru_b_x = args.in[7];
    const float* lru_lambda = args.in[8]; const float* w_lru_out = args.in[9]; const float* sc_conv_w = args.in[10]; const float* sc_conv_b = args.in[11];
    const float* w_conv_out = args.in[12]; const float* w_o = args.in[13]; const float* ln1_g = args.in[14]; const float* ln1_b = args.in[15];
    const float* mlp_w1 = args.in[16]; const float* mlp_b1 = args.in[17]; const float* mlp_w2 = args.in[18]; const float* mlp_b2 = args.in[19];
    const float* ln2_g = args.in[20]; const float* ln2_b = args.in[21];
    bf16* XB = (bf16*)(dob + DO_XB); bf16* WINT = (bf16*)(dob + DO_WINT); bf16* HS = (bf16*)(dob + DO_HS); float* OUTF = args.out;
    bf16* WG = (bf16*)(ws + WS_WG); bf16* WLO = (bf16*)(ws + WS_WLO); bf16* WCO = (bf16*)(ws + WS_WCO); bf16* WO = (bf16*)(ws + WS_WO); bf16* W1 = (bf16*)(ws + WS_W1); bf16* W2 = (bf16*)(ws + WS_W2);
    bf16* LX = (bf16*)(ws + WS_LX); bf16* SEC = (bf16*)(ws + WS_SEC); constexpr size_t SEC_ELEMS = SEC_BYTES / 2;
    bf16* CXR = SEC; bf16* CBZ = SEC + SEC_ELEMS; bf16* CCC = SEC + 2 * SEC_ELEMS; bf16* GL = SEC + 3 * SEC_ELEMS; bf16* GC = SEC + 4 * SEC_ELEMS;
    float* T1 = (float*)(ws + WS_T1); bf16* FFB = (bf16*)(ws + WS_FF); bf16* H1B = (bf16*)(ws + WS_H1B);
    f32x2* ST1 = (f32x2*)(ws + WS_ST1); f32x2* ST2 = (f32x2*)(ws + WS_ST2);

    const int lo = args.ph_lo, hi = args.ph_hi;
#if MK_ONE_LAUNCH
    cg::grid_group grid = cg::this_grid();
    if (tid < 32) MISC[tid] = 0u;
    __syncthreads();
    const XcdBarrier xbar = xcd_barrier_post(ctl + CW_BAR, MISC + 8);
#define SEAM(k) do { if (lo <= (k) && (k) + 1 < hi) { if ((k) == 0) grid.sync(); else xcd_barrier(xbar); } } while (0)
#else
#define SEAM(k) do { } while (0)
#endif
#define IN(k) (lo <= (k) && (k) < hi)
    unsigned long long pr_t0 = 0ull, pr_dt = 0ull;
#define PB(k) do { if (MK_PROBE == (k)) pr_t0 = __builtin_amdgcn_s_memrealtime(); } while (0)
#define PE(k) do { if (MK_PROBE == (k)) pr_dt = __builtin_amdgcn_s_memrealtime() - pr_t0; } while (0)

    PB(0);
    if (IN(0)) {
        LAS float* scr = (LAS float*)(lds + wave * 8448);
        constexpr int I_IN = (DM / 64) * (INC / 32), I_LO = (LW / 64) * (DM / 32), I_CO = (CW / 64) * (DM / 32), I_O = (DM / 64) * (DM / 32), I_1 = (DM / 64) * (DFF / 32), I_2 = (DFF / 64) * (DM / 32);
        constexpr int I_G = 2 * 2 * NH * 8;
        constexpr int NITEMS = I_IN + I_LO + I_CO + I_O + I_1 + I_2 + I_G;
        for (int it = gw; it < NITEMS; it += NGW) {
            int r = it;
            if (r < I_IN) { p0_transpose_item(w_in, DM, INC, WINT, scr, r, lane); continue; } r -= I_IN;
            if (r < I_LO) { p0_transpose_item(w_lru_out, LW, DM, WLO, scr, r, lane); continue; } r -= I_LO;
            if (r < I_CO) { p0_transpose_item(w_conv_out, CW, DM, WCO, scr, r, lane); continue; } r -= I_CO;
            if (r < I_O) { p0_transpose_item(w_o, DM, DM, WO, scr, r, lane); continue; } r -= I_O;
            if (r < I_1) { p0_transpose_item(mlp_w1, DM, DFF, W1, scr, r, lane); continue; } r -= I_1;
            if (r < I_2) { p0_transpose_item(mlp_w2, DFF, DM, W2, scr, r, lane); continue; } r -= I_2;
            { const int mat = r >> 3, sub = r & 7, gate = mat / (2 * NH), dh = mat % (2 * NH);
              const float* src = (gate ? lru_w_x : lru_w_a) + (size_t)dh * HD * HD;
              p0_transpose_item(src, HD, HD, WG + (size_t)mat * HD * HD, scr, sub, lane); }
        }
        for (int m = gw; m < MT; m += NGW) {
            const f32x4* xr = (const f32x4*)(x + (size_t)m * DM) + lane; v2u* o8 = (v2u*)(XB + (size_t)m * DM) + lane;
#pragma unroll
            for (int j = 0; j < 8; ++j) { const f32x4 v = xr[64 * j]; v2u w; w.x = cvtpk(v[0], v[1]); w.y = cvtpk(v[2], v[3]); o8[64 * j] = w; }
        }
    }
    SEAM(0); PE(0);
    PB(1);
    if (IN(1)) {
        pg8::Gemm g{XB, WINT, MT, INC, DM}; pg8::StaticOrder S; S.init(MT, INC, G, bx);
        pg8::EpiProj E{LX, SEC, SEC_ELEMS};
        pg8::gemm_phase<pg8::EpiProj, pg8::StaticOrder, true, true>(lds, g, S, E);
    }
    SEAM(1); PE(1);
    PB(2);
    if (IN(2)) {
#if MK_NAIVE_LRU
        if (bx < NB * NH) lru_naive_item(bx / NH, bx % NH, LX, lru_conv_w, lru_conv_b, lru_w_a, lru_b_a, lru_w_x, lru_b_x, lru_lambda, HS, (LAS float*)(lds), tid);
#else
        PB(20);
        if (bx < NB * NH) lru2_item(bx / NH, bx % NH, LX, lru_conv_w, lru_conv_b, WG, lru_b_a, lru_b_x, lru_lambda, HS, (const bf16*)(ctl + 256), lds, tid, lane, wave, pr_dt);
        PE(20);
#endif
        for (;;) {
            __syncthreads();
            if (tid == 0) MISC[0] = atomicAdd(ctl + CW_ZQ, 1u);
            __syncthreads();
            const int item = (int)MISC[0];
            if (item >= MT / 32) break;
            z_item(item, CXR, CBZ, CCC, sc_conv_w, sc_conv_b, tid);
        }
        __syncthreads();
    }
    SEAM(2); PE(2);
    PB(3);
    if (IN(3)) {
        { pg8::Gemm g{HS, WLO, MT, DM, LW}; pg8::StaticOrder S; S.init(MT, DM, G, bx);
          pg8::EpiGate1 E{GL, T1};
          pg8::gemm_phase<pg8::EpiGate1, pg8::StaticOrder, true, true>(lds, g, S, E); }
        __syncthreads();
        { pg8::Gemm g{CBZ, WCO, MT, DM, CW}; pg8::StaticOrder S; S.init(MT, DM, G, bx);
          pg8::EpiGate2 E{GC, T1};
          pg8::gemm_phase<pg8::EpiGate2, pg8::StaticOrder, true, true>(lds, g, S, E); }
    }
    SEAM(3); PE(3);
    PB(4);
    if (IN(4)) {
        pg8::Gemm g{GC, WO, MT, DM, DM}; pg8::StaticOrder S; S.init(MT, DM, G, bx);
        pg8::EpiResStats E{x, OUTF, nullptr, (pg8::f32x2*)ST1, ALPHA};
        pg8::gemm_phase<pg8::EpiResStats, pg8::StaticOrder, true, true>(lds, g, S, E);
    }
    SEAM(4); PE(4);
    PB(5);
    if (IN(5)) {
        for (int m = gw; m < MT; m += NGW) ln_apply_row(OUTF + (size_t)m * DM, ST1 + (size_t)m * 32, ln1_g, ln1_b, OUTF + (size_t)m * DM, H1B + (size_t)m * DM, lane);
    }
    SEAM(5); PE(5);
    PB(6);
    if (IN(6)) {
        pg8::Gemm g{H1B, W1, MT, DFF, DM}; pg8::StaticOrder S; S.init(MT, DFF, G, bx);
        pg8::EpiRelu2 E{FFB, DFF, mlp_b1};
        pg8::gemm_phase<pg8::EpiRelu2, pg8::StaticOrder, true, true>(lds, g, S, E);
    }
    SEAM(6); PE(6);
    PB(7);
    if (IN(7)) {
        pg8::Gemm g{FFB, W2, MT, DM, DFF}; pg8::StaticOrder S; S.init(MT, DM, G, bx);
        pg8::EpiResStats E{OUTF, OUTF, mlp_b2, (pg8::f32x2*)ST2, ALPHA};
        pg8::gemm_phase<pg8::EpiResStats, pg8::StaticOrder, true, true>(lds, g, S, E);
    }
    SEAM(7); PE(7);
    PB(8);
    if (IN(8)) {
        for (int m = gw; m < MT; m += NGW) ln_apply_row(OUTF + (size_t)m * DM, ST2 + (size_t)m * 32, ln2_g, ln2_b, OUTF + (size_t)m * DM, nullptr, lane);
    }
    PE(8);
    if (MK_PROBE >= 0 && bx == 0) { const unsigned long long t1 = __builtin_amdgcn_s_memrealtime(); while (__builtin_amdgcn_s_memrealtime() - t1 < 4ull * pr_dt) __builtin_amdgcn_s_sleep(8); }
#undef IN
#undef SEAM
}

extern "C" void kernel_launch(void* const* d_in, const int* in_sizes, int n_in, void* d_out, int out_size, void* d_ws, size_t ws_size, hipStream_t stream) {
    static int grid = 0;
    if (grid == 0) {
        if (n_in != 22 || in_sizes[0] != MT * DM || out_size != MT * DM || ws_size < WS_END) {
            fprintf(stderr, "kernel_launch: unexpected shapes (n_in %d, in0 %d, out %d, ws %zu; need ws >= %zu)\n", n_in, n_in > 0 ? in_sizes[0] : -1, out_size, ws_size, (size_t)WS_END); grid = -1; return; }
        int dev = 0, cus = 0, per_cu = 0;
        if (hipGetDevice(&dev) != hipSuccess || hipDeviceGetAttribute(&cus, hipDeviceAttributeMultiprocessorCount, dev) != hipSuccess) { grid = -1; return; }
        if (hipFuncSetAttribute((const void*)mk_fwd, hipFuncAttributeMaxDynamicSharedMemorySize, LDS_BYTES) != hipSuccess) { fprintf(stderr, "kernel_launch: hipFuncSetAttribute failed\n"); grid = -1; return; }
        if (hipOccupancyMaxActiveBlocksPerMultiprocessor(&per_cu, (const void*)mk_fwd, NTHR, LDS_BYTES) != hipSuccess || per_cu < 1) { fprintf(stderr, "kernel_launch: occupancy query says %d blocks/CU\n", per_cu); (void)hipGetLastError(); grid = -1; return; }
        grid = cus * 1;
        fprintf(stderr, "kernel_launch: %d CUs, occupancy %d blocks/CU, grid %d\n", cus, per_cu, grid);
    }
    if (grid < 0) return;
    (void)hipMemsetAsync((char*)d_ws + WS_CTL, 0, CTL_BYTES, stream);
    Args a{};
    for (int i = 0; i < 22; ++i) a.in[i] = (const float*)d_in[i];
    a.out = (float*)d_out; a.ws = (unsigned char*)d_ws;
#if MK_ONE_LAUNCH
    a.ph_lo = 0; a.ph_hi = NPHASE;
    void* kargs[] = {&a};
    hipError_t e = hipLaunchCooperativeKernel((const void*)mk_fwd, dim3(grid), dim3(NTHR), kargs, LDS_BYTES, stream);
    if (e != hipSuccess) fprintf(stderr, "kernel_launch: cooperative launch failed: %s (grid %d)\n", hipGetErrorString(e), grid);
#else
    for (int p = 0; p < NPHASE; ++p) { a.ph_lo = p; a.ph_hi = p + 1; hipLaunchKernelGGL(mk_fwd, dim3(grid), dim3(NTHR), LDS_BYTES, stream, a); }
#endif
}
```

```cpp
#include <hip/hip_runtime.h>
#include <hip/hip_cooperative_groups.h>
#include <cstdio>
#include <cstdint>
namespace cg = cooperative_groups;
namespace pg8 {
#define PG8_LAS __attribute__((address_space(3)))
typedef unsigned short bf16_t;
typedef short bf16x8 __attribute__((ext_vector_type(8)));
typedef float f32x4 __attribute__((ext_vector_type(4)));
typedef unsigned u32x4 __attribute__((ext_vector_type(4)));
constexpr int BM = 256, BK = 64, HALF = 128, HTB = HALF * BK * 2  , STAGE_BYTES = 8 * HTB, NXCD = 8, WGM = 8;

__host__ __device__ __forceinline__ int lds_byte(int r, int c) { const int st = (r >> 4) * 2 + (c >> 5), rr = r & 15, cc = c & 31, ob = rr * 64 + cc * 2; return st * 1024 + (ob ^ (((ob >> 9) & 1) << 5)); }
__host__ __device__ __forceinline__ void stage_rc(int b, int& R, int& C) { const int st = b / 1024, sb = b % 1024, swz = sb ^ (((sb >> 9) & 1) << 5); R = (st >> 1) * 16 + swz / 64; C = (st & 1) * 32 + (swz % 64) / 2; }
__host__ __device__ __forceinline__ int perm32(int rho) { const int n = rho >> 4, i = rho & 15; return 8 * (i >> 2) + 4 * n + (i & 3); }

struct Unit { int pm, pn; };
struct Gemm { const bf16_t* A; const bf16_t* Bt; int M, N, K; };

struct StaticOrder {
    int nM, nN, nwg, G, c;
    __host__ __device__ void init(int M, int N, int G_, int c_) { nM = M / BM; nN = N / BM; nwg = nM * nN; G = G_; c = c_; }
    __host__ __device__ bool next(int i, Unit& u) const {
        const long L = (long)i * G + c; if (L >= nwg) return false;
        int wgid = (int)L; { const int q = nwg / NXCD, r = nwg % NXCD, xcd = wgid % NXCD, off = wgid / NXCD; wgid = (xcd < r ? xcd * (q + 1) : r * (q + 1) + (xcd - r) * q) + off; }
        const int nig = WGM * nN, gid = wgid / nig, fm = gid * WGM, gsz = (nM - fm) < WGM ? (nM - fm) : WGM;
        u.pm = fm + ((wgid % nig) % gsz); u.pn = (wgid % nig) / gsz; return true;
    }
    __device__ __forceinline__ void a_ready(const Unit&) const {}
    __device__ __forceinline__ void done(const Unit&) const {}
};

__device__ __forceinline__ unsigned cvt_pk_bf16(float lo, float hi) { unsigned r; asm volatile("v_cvt_pk_bf16_f32 %0, %1, %2" : "=v"(r) : "v"(lo), "v"(hi)); return r; }
typedef float f32x2 __attribute__((ext_vector_type(2)));
__device__ __forceinline__ float bf_lo(unsigned w) { return __uint_as_float(w << 16); }
__device__ __forceinline__ float bf_hi(unsigned w) { return __uint_as_float(w & 0xffff0000u); }
__device__ __forceinline__ float sigmoidf_fast(float v) { return __builtin_amdgcn_rcpf(1.0f + __builtin_amdgcn_exp2f(v * -1.44269504089f)); }

struct EpiProj {
    static constexpr bool PERM = true, AFTER_DRAIN = false;
    bf16_t* lx; bf16_t* sec; size_t sec_stride;
    __device__ __forceinline__ void operator()(const f32x4 (&acc)[2][2][4][2], const Unit& u, int wr, int wc, int fr, int fq) const {
        bf16_t* base; int ldc, colt;
        if (u.pn < 10) { base = lx; ldc = 2560; colt = u.pn * BM; }
        else { const int s = (u.pn - 10) >> 3; base = sec + (size_t)s * sec_stride; ldc = 2048; colt = ((u.pn - 10) & 7) * BM; }
        const int row0 = u.pm * BM + wr * 64 + fr, col0 = colt + wc * 32 + 8 * fq;
#pragma unroll
        for (int ai = 0; ai < 2; ++ai)
#pragma unroll
            for (int m = 0; m < 4; ++m) { bf16_t* rowp = base + (size_t)(row0 + ai * HALF + m * 16) * ldc + col0;
#pragma unroll
                for (int bj = 0; bj < 2; ++bj) { const f32x4 v0 = acc[ai][bj][m][0], v1 = acc[ai][bj][m][1];
                    u32x4 w; w.x = cvt_pk_bf16(v0[0], v0[1]); w.y = cvt_pk_bf16(v0[2], v0[3]); w.z = cvt_pk_bf16(v1[0], v1[1]); w.w = cvt_pk_bf16(v1[2], v1[3]);
                    *(u32x4*)(rowp + bj * HALF) = w; } }
    }
};
struct EpiGate1 {
    static constexpr bool PERM = true, AFTER_DRAIN = false;
    bf16_t* g;
    __device__ __forceinline__ void operator()(const f32x4 (&acc)[2][2][4][2], const Unit& u, int wr, int wc, int fr, int fq) const {
        const int row0 = u.pm * BM + wr * 64 + fr, col0 = u.pn * BM + wc * 32 + 8 * fq;
#pragma unroll
        for (int ai = 0; ai < 2; ++ai)
#pragma unroll
            for (int m = 0; m < 4; ++m) { const size_t off = (size_t)(row0 + ai * HALF + m * 16) * 2048 + col0;
#pragma unroll
                for (int bj = 0; bj < 2; ++bj) { const u32x4 gw = *(const u32x4*)(g + off + bj * HALF);
                    f32x4 s0, s1; s0[0] = sigmoidf_fast(bf_lo(gw.x)); s0[1] = sigmoidf_fast(bf_hi(gw.x)); s0[2] = sigmoidf_fast(bf_lo(gw.y)); s0[3] = sigmoidf_fast(bf_hi(gw.y));
                    s1[0] = sigmoidf_fast(bf_lo(gw.z)); s1[1] = sigmoidf_fast(bf_hi(gw.z)); s1[2] = sigmoidf_fast(bf_lo(gw.w)); s1[3] = sigmoidf_fast(bf_hi(gw.w));
                    const f32x4 v0 = s0 * acc[ai][bj][m][0], v1 = s1 * acc[ai][bj][m][1];
                    u32x4 w; w.x = cvt_pk_bf16(v0[0], v0[1]); w.y = cvt_pk_bf16(v0[2], v0[3]); w.z = cvt_pk_bf16(v1[0], v1[1]); w.w = cvt_pk_bf16(v1[2], v1[3]);
                    *(u32x4*)(g + off + bj * HALF) = w; } }
    }
};
struct EpiGate2 {
    static constexpr bool PERM = true, AFTER_DRAIN = false;
    bf16_t* g; const bf16_t* t1;
    __device__ __forceinline__ void operator()(const f32x4 (&acc)[2][2][4][2], const Unit& u, int wr, int wc, int fr, int fq) const {
        const int row0 = u.pm * BM + wr * 64 + fr, col0 = u.pn * BM + wc * 32 + 8 * fq;
#pragma unroll
        for (int ai = 0; ai < 2; ++ai)
#pragma unroll
            for (int m = 0; m < 4; ++m) { const size_t off = (size_t)(row0 + ai * HALF + m * 16) * 2048 + col0;
#pragma unroll
                for (int bj = 0; bj < 2; ++bj) { const u32x4 gw = *(const u32x4*)(g + off + bj * HALF); const u32x4 tw = *(const u32x4*)(t1 + off + bj * HALF);
                    const f32x4 a0 = {bf_lo(tw.x), bf_hi(tw.x), bf_lo(tw.y), bf_hi(tw.y)}, a1 = {bf_lo(tw.z), bf_hi(tw.z), bf_lo(tw.w), bf_hi(tw.w)};
                    f32x4 s0, s1; s0[0] = sigmoidf_fast(bf_lo(gw.x)); s0[1] = sigmoidf_fast(bf_hi(gw.x)); s0[2] = sigmoidf_fast(bf_lo(gw.y)); s0[3] = sigmoidf_fast(bf_hi(gw.y));
                    s1[0] = sigmoidf_fast(bf_lo(gw.z)); s1[1] = sigmoidf_fast(bf_hi(gw.z)); s1[2] = sigmoidf_fast(bf_lo(gw.w)); s1[3] = sigmoidf_fast(bf_hi(gw.w));
                    const f32x4 v0 = a0 + s0 * acc[ai][bj][m][0], v1 = a1 + s1 * acc[ai][bj][m][1];
                    u32x4 w; w.x = cvt_pk_bf16(v0[0], v0[1]); w.y = cvt_pk_bf16(v0[2], v0[3]); w.z = cvt_pk_bf16(v1[0], v1[1]); w.w = cvt_pk_bf16(v1[2], v1[3]);
                    *(u32x4*)(g + off + bj * HALF) = w; } }
    }
};
template <bool RES_BF16> struct EpiResStats {
    static constexpr bool PERM = true, AFTER_DRAIN = false;
    const void* base; void* out; const float* bias; f32x2* st; float alpha;
    __device__ __forceinline__ void operator()(const f32x4 (&acc)[2][2][4][2], const Unit& u, int wr, int wc, int fr, int fq) const {
        const int col0 = u.pn * BM + wc * 32 + 8 * fq;
        f32x4 bv[2][2];
#pragma unroll
        for (int bj = 0; bj < 2; ++bj)
#pragma unroll
            for (int n = 0; n < 2; ++n) bv[bj][n] = bias ? *(const f32x4*)(bias + col0 + bj * HALF + 4 * n) : (f32x4){0.f, 0.f, 0.f, 0.f};
#pragma unroll
        for (int ai = 0; ai < 2; ++ai)
#pragma unroll
            for (int m = 0; m < 4; ++m) { const int r = u.pm * BM + ai * HALF + wr * 64 + m * 16 + fr; const size_t off = (size_t)r * 2048 + col0;
                f32x4 v[2][2]; float s = 0.f;
#pragma unroll
                for (int bj = 0; bj < 2; ++bj) {
                    f32x4 b0, b1;
                    if (RES_BF16) { const u32x4 hw = *(const u32x4*)((const bf16_t*)base + off + bj * HALF); b0 = (f32x4){bf_lo(hw.x), bf_hi(hw.x), bf_lo(hw.y), bf_hi(hw.y)}; b1 = (f32x4){bf_lo(hw.z), bf_hi(hw.z), bf_lo(hw.w), bf_hi(hw.w)}; }
                    else { b0 = *(const f32x4*)((const float*)base + off + bj * HALF); b1 = *(const f32x4*)((const float*)base + off + bj * HALF + 4); }
                    v[bj][0] = b0 * alpha + acc[ai][bj][m][0] + bv[bj][0]; v[bj][1] = b1 * alpha + acc[ai][bj][m][1] + bv[bj][1]; }
#pragma unroll
                for (int bj = 0; bj < 2; ++bj) {
                    if (RES_BF16) { *(f32x4*)((float*)out + off + bj * HALF) = v[bj][0]; *(f32x4*)((float*)out + off + bj * HALF + 4) = v[bj][1]; }
                    else { u32x4 w; w.x = cvt_pk_bf16(v[bj][0][0], v[bj][0][1]); w.y = cvt_pk_bf16(v[bj][0][2], v[bj][0][3]); w.z = cvt_pk_bf16(v[bj][1][0], v[bj][1][1]); w.w = cvt_pk_bf16(v[bj][1][2], v[bj][1][3]);
                        *(u32x4*)((bf16_t*)out + off + bj * HALF) = w; }
#pragma unroll
                    for (int n = 0; n < 2; ++n) s += (v[bj][n][0] + v[bj][n][1]) + (v[bj][n][2] + v[bj][n][3]); }
                s += __shfl_xor(s, 16); s += __shfl_xor(s, 32);
                const float mw = s * (1.0f / 64.0f); float q = 0.f;
#pragma unroll
                for (int bj = 0; bj < 2; ++bj)
#pragma unroll
                    for (int n = 0; n < 2; ++n) { const f32x4 d = v[bj][n] - mw; q += (d[0] * d[0] + d[1] * d[1]) + (d[2] * d[2] + d[3] * d[3]); }
                q += __shfl_xor(q, 16); q += __shfl_xor(q, 32);
                if (fq == 0) st[(size_t)r * 32 + u.pn * 4 + wc] = (f32x2){mw, q};
                asm volatile("" ::: "memory"); }
    }
};
struct EpiRelu2 {
    static constexpr bool PERM = true, AFTER_DRAIN = false;
    bf16_t* O; int ldc; const float* bias;
    __device__ __forceinline__ void operator()(const f32x4 (&acc)[2][2][4][2], const Unit& u, int wr, int wc, int fr, int fq) const {
        const int row0 = u.pm * BM + wr * 64 + fr, col0 = u.pn * BM + wc * 32 + 8 * fq;
        f32x4 bv[2][2];
#pragma unroll
        for (int bj = 0; bj < 2; ++bj)
#pragma unroll
            for (int n = 0; n < 2; ++n) bv[bj][n] = *(const f32x4*)(bias + col0 + bj * HALF + 4 * n);
#pragma unroll
        for (int ai = 0; ai < 2; ++ai)
#pragma unroll
            for (int m = 0; m < 4; ++m) { bf16_t* rowp = O + (size_t)(row0 + ai * HALF + m * 16) * ldc + col0;
#pragma unroll
                for (int bj = 0; bj < 2; ++bj) { f32x4 v0 = acc[ai][bj][m][0] + bv[bj][0], v1 = acc[ai][bj][m][1] + bv[bj][1];
#pragma unroll
                    for (int j = 0; j < 4; ++j) { const float a = fmaxf(v0[j], 0.f), b = fmaxf(v1[j], 0.f); v0[j] = a * a; v1[j] = b * b; }
                    u32x4 w; w.x = cvt_pk_bf16(v0[0], v0[1]); w.y = cvt_pk_bf16(v0[2], v0[3]); w.z = cvt_pk_bf16(v1[0], v1[1]); w.w = cvt_pk_bf16(v1[2], v1[3]);
                    *(u32x4*)(rowp + bj * HALF) = w; } }
    }
};

template <class Epi, class Sched, bool ALIGN_EPI = false, bool SP2 = false>
__device__ __forceinline__ void gemm_phase(PG8_LAS unsigned char* lds, const Gemm g, const Sched& S, const Epi& E) {
    const int tid = threadIdx.x, wid = __builtin_amdgcn_readfirstlane(tid >> 6), lane = tid & 63, wr = wid >> 2, wc = wid & 3, fr = lane & 15, fq = lane >> 4;
    const int K = g.K, nt = K / BK;
    unsigned voffA[2], voffB[2];
#pragma unroll
    for (int i = 0; i < 2; ++i) { int R, C; stage_rc(tid * 16 + i * 8192, R, C); const int Rb = Epi::PERM ? ((R & ~31) + perm32(R & 31)) : R;
        voffA[i] = (unsigned)(R * K + C) * 2u; voffB[i] = (unsigned)(Rb * K + C) * 2u; }
    const size_t kstep = (size_t)(BK * 2);
    const size_t hstep = (size_t)HALF * K * 2;
    const size_t tstep = 2 * hstep;
    const unsigned ldsw = (unsigned)wid * 1024u;
    const int aoff = lds_byte(wr * 64 + fr, fq * 8), boff = lds_byte(wc * 32 + fr, fq * 8);
#define PG8_SA(b, h) (((b) * 2 + (h)) * HTB)
#define PG8_SB(b, h) ((4 + (b) * 2 + (h)) * HTB)
#define PG8_STAGE(bufoff, gbase, voff) do { _Pragma("unroll") for (int _i = 0; _i < 2; ++_i) \
        __builtin_amdgcn_global_load_lds((const unsigned*)((const char*)(gbase) + (voff)[_i]), (PG8_LAS unsigned*)(lds + (bufoff) + ldsw + _i * 8192), 16, 0, 0); } while (0)
#define PG8_LDA(dst, b, h) do { _Pragma("unroll") for (int m = 0; m < 4; ++m) _Pragma("unroll") for (int k = 0; k < 2; ++k) dst[m][k] = *(const PG8_LAS bf16x8*)(lds + PG8_SA(b, h) + aoff + m * 2048 + k * 1024); } while (0)
#define PG8_LDB(dst, b, h) do { _Pragma("unroll") for (int n = 0; n < 2; ++n) _Pragma("unroll") for (int k = 0; k < 2; ++k) dst[n][k] = *(const PG8_LAS bf16x8*)(lds + PG8_SB(b, h) + boff + n * 2048 + k * 1024); } while (0)
#define PG8_MMA(ai, bj, At, Bt) do { __builtin_amdgcn_s_setprio(1); _Pragma("unroll") for (int m = 0; m < 4; ++m) _Pragma("unroll") for (int n = 0; n < 2; ++n) _Pragma("unroll") for (int k = 0; k < 2; ++k) \
        acc[ai][bj][m][n] = __builtin_amdgcn_mfma_f32_16x16x32_bf16(Bt[n][k], At[m][k], acc[ai][bj][m][n], 0, 0, 0); __builtin_amdgcn_s_setprio(0); } while (0)
#define PG8_WAIT_V(n) asm volatile("s_waitcnt vmcnt(" #n ")" ::: "memory")
#define PG8_WAIT_L(n) asm volatile("s_waitcnt lgkmcnt(" #n ")" ::: "memory")
#define PG8_BAR __builtin_amdgcn_s_barrier()
#define PG8_SCHED __builtin_amdgcn_sched_barrier(0)
    Unit cur, nxt; int ui = 0;
    if (!S.next(0, cur)) return;
    f32x4 acc[2][2][4][2];
#pragma unroll
    for (int a = 0; a < 2; ++a)
#pragma unroll
        for (int b = 0; b < 2; ++b)
#pragma unroll
            for (int m = 0; m < 4; ++m)
#pragma unroll
                for (int n = 0; n < 2; ++n) acc[a][b][m][n] = (f32x4){0.f, 0.f, 0.f, 0.f};
    bf16x8 At[4][2], B0[2][2], B1[2][2];
    const char* cA = (const char*)g.A + (size_t)cur.pm * tstep; const char* cB = (const char*)g.Bt + (size_t)cur.pn * tstep;
    S.a_ready(cur);
    if constexpr (SP2) {
        PG8_STAGE(PG8_SB(0, 0), cB, voffB); PG8_STAGE(PG8_SB(0, 1), cB + hstep, voffB); PG8_STAGE(PG8_SA(0, 0), cA, voffA); PG8_STAGE(PG8_SA(0, 1), cA + hstep, voffA);
        if (wr == 1) PG8_BAR;
        PG8_WAIT_V(2); PG8_BAR;
        PG8_STAGE(PG8_SB(1, 0), cB + kstep, voffB); PG8_STAGE(PG8_SA(1, 0), cA + kstep, voffA); PG8_STAGE(PG8_SB(1, 1), cB + hstep + kstep, voffB);
        PG8_WAIT_V(6); PG8_BAR;
    } else {
        PG8_STAGE(PG8_SB(0, 0), cB, voffB); PG8_STAGE(PG8_SA(0, 0), cA, voffA); PG8_STAGE(PG8_SB(0, 1), cB + hstep, voffB); PG8_STAGE(PG8_SA(0, 1), cA + hstep, voffA);
        if (wr == 1) PG8_BAR;
        PG8_WAIT_V(4); PG8_BAR;
        PG8_STAGE(PG8_SB(1, 0), cB + kstep, voffB); PG8_STAGE(PG8_SA(1, 0), cA + kstep, voffA); PG8_STAGE(PG8_SB(1, 1), cB + hstep + kstep, voffB);
        PG8_WAIT_V(6); PG8_BAR;
    }
    for (;;) {
        const bool has_next = S.next(ui + 1, nxt);
        const char* nA = has_next ? (const char*)g.A + (size_t)nxt.pm * tstep : cA; const char* nB = has_next ? (const char*)g.Bt + (size_t)nxt.pn * tstep : cB;
        for (int t = 0; t < nt; t += 2) {
            const bool last = (t == nt - 2);
            const char* a1 = cA + (size_t)(t + 1) * kstep;
            const char* a2 = last ? nA : cA + (size_t)(t + 2) * kstep; const char* b2 = last ? nB : cB + (size_t)(t + 2) * kstep;
            const char* a3 = a2 + kstep; const char* b3 = b2 + kstep;
            if (last && has_next) S.a_ready(nxt);
            if constexpr (SP2) {
            PG8_LDB(B0, 0, 0); PG8_LDB(B1, 0, 1); PG8_SCHED; PG8_LDA(At, 0, 0); PG8_STAGE(PG8_SA(1, 1), a1 + hstep, voffA);
            PG8_WAIT_V(8); PG8_WAIT_L(0); PG8_BAR; PG8_MMA(0, 0, At, B0); PG8_MMA(0, 1, At, B1); PG8_BAR; PG8_SCHED;
            PG8_LDA(At, 0, 1); PG8_STAGE(PG8_SB(0, 0), b2, voffB); PG8_STAGE(PG8_SB(0, 1), b2 + hstep, voffB); PG8_STAGE(PG8_SA(0, 0), a2, voffA);
            PG8_WAIT_V(8); PG8_WAIT_L(0); PG8_BAR; PG8_MMA(1, 0, At, B0); PG8_MMA(1, 1, At, B1); PG8_BAR; PG8_SCHED;
            PG8_LDB(B0, 1, 0); PG8_LDB(B1, 1, 1); PG8_SCHED; PG8_LDA(At, 1, 0); PG8_STAGE(PG8_SA(0, 1), a2 + hstep, voffA);
            PG8_WAIT_V(8); PG8_WAIT_L(0); PG8_BAR; PG8_MMA(0, 0, At, B0); PG8_MMA(0, 1, At, B1); PG8_BAR; PG8_SCHED;
            PG8_LDA(At, 1, 1); PG8_STAGE(PG8_SB(1, 0), b3, voffB); PG8_STAGE(PG8_SB(1, 1), b3 + hstep, voffB); PG8_STAGE(PG8_SA(1, 0), a3, voffA);
            PG8_WAIT_V(8); PG8_WAIT_L(0); PG8_BAR; PG8_MMA(1, 0, At, B0); PG8_MMA(1, 1, At, B1); PG8_BAR; PG8_SCHED;
            } else {
            PG8_LDB(B0, 0, 0); PG8_SCHED; PG8_LDA(At, 0, 0); PG8_STAGE(PG8_SA(1, 1), a1 + hstep, voffA);
            PG8_WAIT_L(8); PG8_BAR; PG8_WAIT_L(0); PG8_MMA(0, 0, At, B0); PG8_BAR; PG8_SCHED;
            PG8_LDB(B1, 0, 1); PG8_STAGE(PG8_SB(0, 0), b2, voffB);
            PG8_BAR; PG8_WAIT_L(0); PG8_MMA(0, 1, At, B1); PG8_BAR;
            PG8_LDA(At, 0, 1); PG8_STAGE(PG8_SA(0, 0), a2, voffA);
            PG8_BAR; PG8_WAIT_L(0); PG8_MMA(1, 0, At, B0); PG8_BAR; PG8_SCHED;
            PG8_STAGE(PG8_SB(0, 1), b2 + hstep, voffB);
            PG8_WAIT_V(6); PG8_BAR; PG8_MMA(1, 1, At, B1); PG8_BAR;
            PG8_LDB(B0, 1, 0); PG8_SCHED; PG8_LDA(At, 1, 0); PG8_STAGE(PG8_SA(0, 1), a2 + hstep, voffA);
            PG8_WAIT_L(8); PG8_BAR; PG8_WAIT_L(0); PG8_MMA(0, 0, At, B0); PG8_BAR; PG8_SCHED;
            PG8_LDB(B1, 1, 1); PG8_STAGE(PG8_SB(1, 0), b3, voffB);
            PG8_BAR; PG8_WAIT_L(0); PG8_MMA(0, 1, At, B1); PG8_BAR;
            PG8_LDA(At, 1, 1); PG8_STAGE(PG8_SA(1, 0), a3, voffA);
            PG8_BAR; PG8_WAIT_L(0); PG8_MMA(1, 0, At, B0); PG8_BAR; PG8_SCHED;
            PG8_STAGE(PG8_SB(1, 1), b3 + hstep, voffB);
            PG8_WAIT_V(6); PG8_BAR; PG8_MMA(1, 1, At, B1); PG8_BAR;
            }
        }
        if constexpr (ALIGN_EPI) { if (wr == 0) PG8_BAR; }
        if constexpr (!Epi::AFTER_DRAIN) { E(acc, cur, wr, wc, fr, fq); S.done(cur); }
        if (!has_next) break;
#pragma unroll
        for (int a = 0; a < 2; ++a)
#pragma unroll
            for (int b = 0; b < 2; ++b)
#pragma unroll
                for (int m = 0; m < 4; ++m)
#pragma unroll
                    for (int n = 0; n < 2; ++n) acc[a][b][m][n] = (f32x4){0.f, 0.f, 0.f, 0.f};
        cur = nxt; cA = nA; cB = nB; ++ui;
        if constexpr (ALIGN_EPI) { if (wr == 1) PG8_BAR; }
    }
    PG8_WAIT_V(0);
    if constexpr (!ALIGN_EPI) { if (wr == 0) PG8_BAR; }
    PG8_BAR;
    if constexpr (Epi::AFTER_DRAIN) { E.fused(acc, cur, wr, wc, fr, fq, lds, wid, lane); S.done(cur); }
#undef PG8_SA
#undef PG8_SB
#undef PG8_STAGE
#undef PG8_LDA
#undef PG8_LDB
#undef PG8_MMA
#undef PG8_WAIT_V
#undef PG8_WAIT_L
#undef PG8_BAR
#undef PG8_SCHED
}
}
#ifndef MK_ONE_LAUNCH
#define MK_ONE_LAUNCH 1
#endif
#ifndef MK_PROBE
#define MK_PROBE (-1)
#endif
#ifndef MK_NAIVE_LRU
#define MK_NAIVE_LRU 0
#endif
constexpr int NWAVES = 8, NTHR = NWAVES * 64;
constexpr int NB = 8, SEQ = 2048, MT = NB * SEQ, DM = 2048, LW = 2560, NH = 20, HD = 128, CW = 2048, DFF = 8192, INC = 12800;
constexpr float ALPHA = 1.18920711500272f;
constexpr float LN_EPS = 1e-5f;
constexpr int NPHASE = 9;
constexpr size_t MiB = 1u << 20;
constexpr size_t WS_CTL = 0, CTL_BYTES = 1 * MiB;
constexpr size_t WS_ST1 = 1 * MiB, WS_ST2 = 5 * MiB;
constexpr size_t WS_WG = 9 * MiB;
constexpr size_t WS_WLO = 12 * MiB, WS_WCO = 22 * MiB, WS_WO = 30 * MiB, WS_W1 = 38 * MiB, WS_W2 = 70 * MiB;
constexpr size_t WS_LX = 102 * MiB;
constexpr size_t WS_SEC = 182 * MiB, SEC_BYTES = 64 * MiB;
constexpr size_t WS_T1 = 102 * MiB;
constexpr size_t WS_FF = 102 * MiB;
constexpr size_t WS_H1B = WS_SEC + 3 * SEC_BYTES;
constexpr size_t WS_END = WS_SEC + 5 * SEC_BYTES;
static_assert(WS_FF + (size_t)MT * DFF * 2 <= WS_H1B, "FF overlay must end before H1B");
constexpr size_t DO_XB = 0, DO_WINT = 64 * MiB, DO_HS = 0;
constexpr int CW_ZQ = 64;
constexpr int CW_BAR = 4096;
constexpr int LDS_BYTES = 147456, MISC_OFF = 147456 - 256;

#define GAS __attribute__((address_space(1)))
#define LAS __attribute__((address_space(3)))
typedef unsigned short bf16;
typedef unsigned v4u __attribute__((ext_vector_type(4)));
typedef unsigned v2u __attribute__((ext_vector_type(2)));
typedef float f32x4 __attribute__((ext_vector_type(4)));
typedef float f32x2 __attribute__((ext_vector_type(2)));
#define LDS_WAIT() asm volatile("s_waitcnt lgkmcnt(0)" ::: "memory")
__device__ __forceinline__ unsigned f2bf(float f) { unsigned u = __builtin_bit_cast(unsigned, f); return (u + 0x7fffu + ((u >> 16) & 1u)) >> 16; }
__device__ __forceinline__ unsigned pk2(float lo, float hi) { return f2bf(lo) | (f2bf(hi) << 16); }
__device__ __forceinline__ unsigned cvtpk(float lo, float hi) { unsigned r; asm("v_cvt_pk_bf16_f32 %0, %1, %2" : "=v"(r) : "v"(lo), "v"(hi)); return r; }
__device__ __forceinline__ float bf2f(unsigned short b) { return __uint_as_float(((unsigned)b) << 16); }
__device__ __forceinline__ float bflo(unsigned w) { return __uint_as_float(w << 16); }
__device__ __forceinline__ float bfhi(unsigned w) { return __uint_as_float(w & 0xffff0000u); }

__device__ __forceinline__ void p0_transpose_item(const float* W, int K, int N, bf16* WT, LAS float* scr, int item, int lane) {
    const int nblk = N / 32, kb = item / nblk, nb = item % nblk, k0 = 64 * kb, n0 = 32 * nb;
#pragma unroll 8
    for (int i = 0; i < 32; ++i) { const int kk = 2 * i + (lane >> 5); scr[kk * 33 + (lane & 31)] = W[(size_t)(k0 + kk) * N + n0 + (lane & 31)]; }
    LDS_WAIT(); asm volatile("" ::: "memory");
    const int c = lane & 7;
#pragma unroll
    for (int j = 0; j < 4; ++j) { const int n = (lane >> 3) + 8 * j; const LAS float* s = scr + (8 * c) * 33 + n;
        v4u o; o.x = cvtpk(s[0 * 33], s[1 * 33]); o.y = cvtpk(s[2 * 33], s[3 * 33]); o.z = cvtpk(s[4 * 33], s[5 * 33]); o.w = cvtpk(s[6 * 33], s[7 * 33]);
        *(v4u*)(WT + (size_t)(n0 + n) * K + k0 + 8 * c) = o; }
    LDS_WAIT(); asm volatile("" ::: "memory");
}

__device__ __forceinline__ f32x2 ln_row_stats(const f32x2* strow, int lane) {
    const f32x2 p = strow[lane & 31];
    float ms = p.x;
#pragma unroll
    for (int o = 1; o < 32; o <<= 1) ms += __shfl_xor(ms, o);
    const float mean = ms * (1.0f / 32.0f);
    const float dm = p.x - mean; float q = p.y + 64.0f * dm * dm;
#pragma unroll
    for (int o = 1; o < 32; o <<= 1) q += __shfl_xor(q, o);
    return (f32x2){mean, 1.0f / sqrtf(q * (1.0f / 2048.0f) + LN_EPS)};
}
__device__ __forceinline__ void ln_apply_row(const float* vrow, const f32x2* strow, const float* gam, const float* bet, float* outf, int lane) {
    const f32x2 mr = ln_row_stats(strow, lane);
    const f32x4* v4 = (const f32x4*)vrow; const f32x4* g4 = (const f32x4*)gam; const f32x4* b4 = (const f32x4*)bet;
#pragma unroll
    for (int j = 0; j < 8; ++j) { const int i = 64 * j + lane; const f32x4 x = v4[i]; ((f32x4*)outf)[i] = (x - mr.x) * mr.y * g4[i] + b4[i]; }
}
__device__ __forceinline__ void ln_apply_row_bf(const bf16* vrow, const f32x2* strow, const float* gam, const float* bet, bf16* outb, int lane) {
    const f32x2 mr = ln_row_stats(strow, lane);
    const f32x4* g4 = (const f32x4*)gam; const f32x4* b4 = (const f32x4*)bet;
#pragma unroll
    for (int j = 0; j < 4; ++j) { const int i = 64 * j + lane; const v4u w = ((const v4u*)vrow)[i];
        const f32x4 x0 = {bflo(w.x), bfhi(w.x), bflo(w.y), bfhi(w.y)}, x1 = {bflo(w.z), bfhi(w.z), bflo(w.w), bfhi(w.w)};
        const f32x4 y0 = (x0 - mr.x) * mr.y * g4[2 * i] + b4[2 * i], y1 = (x1 - mr.x) * mr.y * g4[2 * i + 1] + b4[2 * i + 1];
        v4u o; o.x = cvtpk(y0[0], y0[1]); o.y = cvtpk(y0[2], y0[3]); o.z = cvtpk(y1[0], y1[1]); o.w = cvtpk(y1[2], y1[3]);
        ((v4u*)outb)[i] = o; }
}

__device__ __forceinline__ void z_item(int item, const bf16* CX, bf16* CBZ, const bf16* CC, const float* w, const float* bias, int tid) {
    const int cg = tid & 255, rh = tid >> 8, R0 = item * 32 + rh * 16, t0 = R0 & (SEQ - 1), c0 = cg * 8;
    float w0[8], w1[8], w2[8], bb[8];
#pragma unroll
    for (int j = 0; j < 8; ++j) { w0[j] = w[c0 + j]; w1[j] = w[CW + c0 + j]; w2[j] = w[2 * CW + c0 + j]; bb[j] = bias[c0 + j]; }
    const v4u zero4 = {0u, 0u, 0u, 0u};
#define MULCX(dst, a_, b_) do { dst[0] = bflo(a_.x) * bflo(b_.x); dst[1] = bfhi(a_.x) * bfhi(b_.x); dst[2] = bflo(a_.y) * bflo(b_.y); dst[3] = bfhi(a_.y) * bfhi(b_.y); \
        dst[4] = bflo(a_.z) * bflo(b_.z); dst[5] = bfhi(a_.z) * bfhi(b_.z); dst[6] = bflo(a_.w) * bflo(b_.w); dst[7] = bfhi(a_.w) * bfhi(b_.w); } while (0)
#pragma unroll 1
    for (int ck = 0; ck < 4; ++ck) {
        const int Rc = R0 + 4 * ck, tc = t0 + 4 * ck;
        v4u xa[6], xc[6], cbv[4];
#pragma unroll
        for (int k = 0; k < 6; ++k) { const bool ok = (tc + k - 1 >= 0) && (tc + k - 1 < SEQ);
            xa[k] = ok ? *(const v4u*)(CX + (size_t)(Rc + k - 1) * CW + c0) : zero4; xc[k] = ok ? *(const v4u*)(CC + (size_t)(Rc + k - 1) * CW + c0) : zero4; }
#pragma unroll
        for (int i = 0; i < 4; ++i) cbv[i] = *(const v4u*)(CBZ + (size_t)(Rc + i) * CW + c0);
        float pv[8], cu[8], nx[8];
        MULCX(pv, xa[0], xc[0]); MULCX(cu, xa[1], xc[1]);
#pragma unroll
        for (int i = 0; i < 4; ++i) {
            MULCX(nx, xa[i + 2], xc[i + 2]);
            float z[8];
#pragma unroll
            for (int j = 0; j < 8; ++j) z[j] = w0[j] * pv[j] + w1[j] * cu[j] + w2[j] * nx[j] + bb[j];
            const v4u cb = cbv[i];
            v4u o; o.x = cvtpk(bflo(cb.x) * z[0], bfhi(cb.x) * z[1]); o.y = cvtpk(bflo(cb.y) * z[2], bfhi(cb.y) * z[3]); o.z = cvtpk(bflo(cb.z) * z[4], bfhi(cb.z) * z[5]); o.w = cvtpk(bflo(cb.w) * z[6], bfhi(cb.w) * z[7]);
            *(v4u*)(CBZ + (size_t)(Rc + i) * CW + c0) = o;
#pragma unroll
            for (int j = 0; j < 8; ++j) { pv[j] = cu[j]; cu[j] = nx[j]; }
        }
    }
#undef MULCX
}

#if MK_NAIVE_LRU
__device__ __forceinline__ void lru_naive_item(int b, int hd, const bf16* LX, const float* cw, const float* cb, const float* wa, const float* ba, const float* wx, const float* bx,
                                               const float* lam, bf16* HS, LAS float* us, int tid) {
    const int dir = (tid >> 7) & 1, e = tid & 127; const bool act = tid < 256; const int ch = hd * HD + e;
    const float c0 = cw[ch], c1 = cw[LW + ch], c2 = cw[2 * LW + ch], c3 = cw[3 * LW + ch], cbias = cb[ch];
    const float b_a = ba[(dir * NH + hd) * HD + e], b_x = bx[(dir * NH + hd) * HD + e];
    const float kl = -8.0f * log1pf(expf(-lam[dir * LW + ch]));
    const float* Wa = wa + (size_t)(dir * NH + hd) * HD * HD + e; const float* Wx = wx + (size_t)(dir * NH + hd) * HD * HD + e;
    float h = 0.f;
    for (int s = 0; s < SEQ; ++s) {
        const int t = dir ? (SEQ - 1 - s) : s;
        float u = cbias;
        if (act) { const bf16* p = LX + ((size_t)b * SEQ + t) * LW + ch;
            if (t >= 2) u += c0 * bf2f(p[-2 * LW]); if (t >= 1) u += c1 * bf2f(p[-LW]); u += c2 * bf2f(p[0]); if (t + 1 < SEQ) u += c3 * bf2f(p[LW]);
            us[dir * HD + e] = u; }
        __syncthreads();
        if (act) { float ra = b_a, ri = b_x;
            for (int d = 0; d < HD; ++d) { const float ud = us[dir * HD + d]; ra += ud * Wa[d * HD]; ri += ud * Wx[d * HD]; }
            const float r = 1.0f / (1.0f + expf(-ra)), ig = 1.0f / (1.0f + expf(-ri));
            const float la = kl * r, a = expf(la), g = sqrtf(fmaxf(-expm1f(2.0f * la), 0.f)) * (ig * u);
            h = a * h + g;
            bf16* o = HS + ((size_t)b * SEQ + t) * LW + ch;
            if (s < SEQ / 2) *o = (bf16)f2bf(h); else *o = (bf16)f2bf(bf2f(*o) + h); }
        __syncthreads();
    }
}
#endif


#if !MK_NAIVE_LRU
__device__ __forceinline__ void lru_fast_item(int b, int hd, const bf16* LX, const float* cw, const float* cb, const bf16* WGt, const float* ba, const float* bx, const float* lam, bf16* HS,
                                              LAS unsigned char* lds, int tid, int lane, int wave) {
    constexpr int T = 64, S = SEQ / T; constexpr float L2E = 1.44269504089f;
    typedef short bf16x8 __attribute__((ext_vector_type(8)));
    const int q = lane >> 4, c = lane & 15, chl = 16 * wave + c, ch = hd * HD + chl;
    float nba[2], nbx[2], kl2[2], hc[2];
    bf16x8 Bf[2][2][4];
#pragma unroll
    for (int d = 0; d < 2; ++d) { nba[d] = -L2E * ba[(d * NH + hd) * HD + chl]; nbx[d] = -L2E * bx[(d * NH + hd) * HD + chl]; kl2[d] = -8.0f * L2E * log1pf(expf(-lam[d * LW + ch])); hc[d] = 0.f;
#pragma unroll
        for (int g = 0; g < 2; ++g)
#pragma unroll
            for (int ks = 0; ks < 4; ++ks) Bf[d][g][ks] = *(const bf16x8*)(WGt + ((size_t)((g * 2 + d) * NH + hd) * HD + chl) * HD + 32 * ks + 8 * q); }
    LAS float* cwl = (LAS float*)(lds + 65536 + 2 * 17408);
    for (int i = tid; i < 640; i += NTHR) { const int k = i >> 7, e = i & 127; cwl[i] = (k < 4) ? cw[k * LW + hd * HD + e] : cb[hd * HD + e]; }
    const int cg = tid & 15, rr = tid >> 4, cdir = rr >> 4, run = rr & 15;
    const bf16* lxb = LX + (size_t)b * SEQ * LW + hd * HD + 8 * cg;
    v4u xr[7];
#define LRU_LOAD7(step) do { const int ts_ = (cdir ? SEQ - ((step) + 1) * T : (step) * T) + 4 * run - 2; \
        _Pragma("unroll") for (int k_ = 0; k_ < 7; ++k_) { const int tok_ = ts_ + k_; xr[k_] = (tok_ >= 0 && tok_ < SEQ) ? *(const v4u*)(lxb + (size_t)tok_ * LW) : (v4u){0u, 0u, 0u, 0u}; } } while (0)
#define LRU_CONV_WRITE(buf) do { float wk_[5][8]; \
        _Pragma("unroll") for (int k_ = 0; k_ < 5; ++k_) { const f32x4 a_ = *(const LAS f32x4*)(cwl + k_ * 128 + 8 * cg), b_ = *(const LAS f32x4*)(cwl + k_ * 128 + 8 * cg + 4); \
            wk_[k_][0] = a_[0]; wk_[k_][1] = a_[1]; wk_[k_][2] = a_[2]; wk_[k_][3] = a_[3]; wk_[k_][4] = b_[0]; wk_[k_][5] = b_[1]; wk_[k_][6] = b_[2]; wk_[k_][7] = b_[3]; } \
        LAS unsigned char* ub_ = lds + (cdir * 2 + (buf)) * 16384; \
        _Pragma("unroll") for (int i_ = 0; i_ < 4; ++i_) { float o_[8]; \
            _Pragma("unroll") for (int j_ = 0; j_ < 8; ++j_) o_[j_] = wk_[4][j_]; \
            _Pragma("unroll") for (int k_ = 0; k_ < 4; ++k_) { const v4u x_ = xr[i_ + k_]; \
                o_[0] += wk_[k_][0] * bflo(x_.x); o_[1] += wk_[k_][1] * bfhi(x_.x); o_[2] += wk_[k_][2] * bflo(x_.y); o_[3] += wk_[k_][3] * bfhi(x_.y); \
                o_[4] += wk_[k_][4] * bflo(x_.z); o_[5] += wk_[k_][5] * bfhi(x_.z); o_[6] += wk_[k_][6] * bflo(x_.w); o_[7] += wk_[k_][7] * bfhi(x_.w); } \
            const int row_ = 4 * run + i_; v4u w_; w_.x = pk2(o_[0], o_[1]); w_.y = pk2(o_[2], o_[3]); w_.z = pk2(o_[4], o_[5]); w_.w = pk2(o_[6], o_[7]); \
            *(LAS v4u*)(ub_ + row_ * 256 + ((cg ^ (row_ & 15)) << 4)) = w_; } } while (0)
    __syncthreads();
    LRU_LOAD7(0);
    LRU_CONV_WRITE(0);
    __syncthreads();
    for (int s = 0; s < S; ++s) {
        if (s + 1 < S) LRU_LOAD7(s + 1);
        const bool first_half = s < S / 2;
        const int fd = tid >> 8, ftile0 = fd ? SEQ - (s + 1) * T : s * T;
        bf16* fbase = HS + ((size_t)b * SEQ + ftile0) * LW + hd * HD;
        v4u pr[4];
        if (!first_half) {
#pragma unroll
            for (int j = 0; j < 4; ++j) { const int id = (tid & 255) + 256 * j; pr[j] = *(const v4u*)(fbase + (size_t)(id >> 4) * LW + (id & 15) * 8); }
        }
#pragma unroll
        for (int d = 0; d < 2; ++d) {
            const LAS unsigned char* ub = lds + (d * 2 + (s & 1)) * 16384;
#pragma unroll 1
            for (int rbi = 0; rbi < 4; ++rbi) {
                const int rb = d ? 3 - rbi : rbi;
                pg8::f32x4 accA = {0.f, 0.f, 0.f, 0.f}, accX = {0.f, 0.f, 0.f, 0.f};
                const LAS unsigned char* arow = ub + (16 * rb + c) * 256;
#pragma unroll
                for (int ks = 0; ks < 4; ++ks) { const bf16x8 af = *(const LAS bf16x8*)(arow + (((q + 4 * ks) ^ c) << 4));
                    accA = __builtin_amdgcn_mfma_f32_16x16x32_bf16(af, Bf[d][0][ks], accA, 0, 0, 0);
                    accX = __builtin_amdgcn_mfma_f32_16x16x32_bf16(af, Bf[d][1][ks], accX, 0, 0, 0); }
                float av[4], gv[4];
#pragma unroll
                for (int i = 0; i < 4; ++i) { const int rowi = 16 * rb + 4 * q + i;
                    const float u = bf2f(*(const LAS unsigned short*)(ub + rowi * 256 + (((chl >> 3) ^ (rowi & 15)) << 4) + (chl & 7) * 2));
                    const float r = __builtin_amdgcn_rcpf(1.0f + __builtin_amdgcn_exp2f(accA[i] * -L2E + nba[d]));
                    const float ig = __builtin_amdgcn_rcpf(1.0f + __builtin_amdgcn_exp2f(accX[i] * -L2E + nbx[d]));
                    const float a = __builtin_amdgcn_exp2f(kl2[d] * r);
                    av[i] = a; gv[i] = __builtin_amdgcn_sqrtf(fmaxf(1.0f - a * a, 0.f)) * (ig * u); }
                float Ap[4], Hp[4], hv[4];
                if (d == 0) {
                    Ap[0] = av[0]; Hp[0] = gv[0];
#pragma unroll
                    for (int i = 1; i < 4; ++i) { Ap[i] = av[i] * Ap[i - 1]; Hp[i] = av[i] * Hp[i - 1] + gv[i]; }
                    float IA = Ap[3], IH = Hp[3];
                    { const float pa = __shfl_up(IA, 16), ph = __shfl_up(IH, 16); if (q >= 1) { IH = IA * ph + IH; IA = IA * pa; } }
                    { const float pa = __shfl_up(IA, 32), ph = __shfl_up(IH, 32); if (q >= 2) { IH = IA * ph + IH; IA = IA * pa; } }
                    float EA = __shfl_up(IA, 16), EH = __shfl_up(IH, 16); if (q == 0) { EA = 1.f; EH = 0.f; }
                    const float hin = EA * hc[d] + EH;
#pragma unroll
                    for (int i = 0; i < 4; ++i) hv[i] = Ap[i] * hin + Hp[i];
                    hc[d] = __shfl(hv[3], 48 + c);
                } else {
                    Ap[3] = av[3]; Hp[3] = gv[3];
#pragma unroll
                    for (int i = 2; i >= 0; --i) { Ap[i] = av[i] * Ap[i + 1]; Hp[i] = av[i] * Hp[i + 1] + gv[i]; }
                    float IA = Ap[0], IH = Hp[0];
                    { const float pa = __shfl_down(IA, 16), ph = __shfl_down(IH, 16); if (q <= 2) { IH = IA * ph + IH; IA = IA * pa; } }
                    { const float pa = __shfl_down(IA, 32), ph = __shfl_down(IH, 32); if (q <= 1) { IH = IA * ph + IH; IA = IA * pa; } }
                    float EA = __shfl_down(IA, 16), EH = __shfl_down(IH, 16); if (q == 3) { EA = 1.f; EH = 0.f; }
                    const float hin = EA * hc[d] + EH;
#pragma unroll
                    for (int i = 0; i < 4; ++i) hv[i] = Ap[i] * hin + Hp[i];
                    hc[d] = __shfl(hv[0], c);
                }
                LAS unsigned char* hp = lds + 65536 + d * 17408 + (16 * rb + 4 * q) * 272 + chl * 2;
#pragma unroll
                for (int i = 0; i < 4; ++i) *(LAS unsigned short*)(hp + i * 272) = (unsigned short)f2bf(hv[i]);
            }
        }
        __syncthreads();
        {
            const LAS unsigned char* hb = lds + 65536 + fd * 17408;
#pragma unroll
            for (int j = 0; j < 4; ++j) { const int id = (tid & 255) + 256 * j; v4u hw = *(const LAS v4u*)(hb + (id >> 4) * 272 + (id & 15) * 16);
                if (!first_half) { const v4u p = pr[j];
                    hw.x = pk2(bflo(hw.x) + bflo(p.x), bfhi(hw.x) + bfhi(p.x)); hw.y = pk2(bflo(hw.y) + bflo(p.y), bfhi(hw.y) + bfhi(p.y));
                    hw.z = pk2(bflo(hw.z) + bflo(p.z), bfhi(hw.z) + bfhi(p.z)); hw.w = pk2(bflo(hw.w) + bflo(p.w), bfhi(hw.w) + bfhi(p.w)); }
                *(v4u*)(fbase + (size_t)(id >> 4) * LW + (id & 15) * 8) = hw; }
        }
        if (s + 1 < S) LRU_CONV_WRITE((s + 1) & 1);
        asm volatile("s_waitcnt vmcnt(0)" ::: "memory");
        __syncthreads();
    }
#undef LRU_LOAD7
#undef LRU_CONV_WRITE
}
#endif


#if !MK_NAIVE_LRU
__device__ __forceinline__ void lru2_item(int b, int hd, const bf16* LX, const float* cw, const float* cb, const bf16* WGt, const float* ba, const float* bx, const float* lam, bf16* HS,
                                          const bf16* zrow, LAS unsigned char* lds, int tid, int lane, int wave, unsigned long long& pacc) {
    constexpr int T = 64, S = SEQ / T; constexpr float L2E = 1.44269504089f;
    unsigned long long ptm = 0ull;
#define LP(k) do { if (MK_PROBE == (k)) ptm = __builtin_amdgcn_s_memrealtime(); } while (0)
#define LQ(k) do { if (MK_PROBE == (k)) pacc += __builtin_amdgcn_s_memrealtime() - ptm; } while (0)
    constexpr int U_OFF = 0, UT_OFF = 32768, UT_STRIDE = 144, UT_BYTES = 128 * UT_STRIDE, H_OFF = UT_OFF + 2 * UT_BYTES, H_STRIDE = 272, H_BYTES = 64 * H_STRIDE, CWL_OFF = H_OFF + 2 * H_BYTES,
                  RAW_OFF = CWL_OFF + 2560, RAW_BYTES = 68 * 256;
    static_assert(RAW_OFF + 2 * RAW_BYTES <= MISC_OFF, "LRU LDS map");
    typedef short bf16x8 __attribute__((ext_vector_type(8)));
    typedef float f32x16 __attribute__((ext_vector_type(16)));
    const int wd = wave >> 2, chg = wave & 3, r = lane & 31, h = lane >> 5, chl = 32 * chg + r, ch = hd * HD + chl;
    const float nba = -L2E * ba[(wd * NH + hd) * HD + chl], nbx = -L2E * bx[(wd * NH + hd) * HD + chl], kl2 = -8.0f * L2E * log1pf(expf(-lam[wd * LW + ch]));
    bf16x8 Bf[2][8];
#pragma unroll
    for (int g = 0; g < 2; ++g)
#pragma unroll
        for (int ks = 0; ks < 8; ++ks) Bf[g][ks] = *(const bf16x8*)(WGt + ((size_t)((g * 2 + wd) * NH + hd) * HD + chl) * HD + 16 * ks + 8 * h);
    LAS float* cwl = (LAS float*)(lds + CWL_OFF);
    for (int i = tid; i < 640; i += NTHR) { const int k = i >> 7, e = i & 127; cwl[i] = (k < 4) ? cw[k * LW + hd * HD + e] : cb[hd * HD + e]; }
    const int cg = tid & 15, rr = tid >> 4, cdir = rr >> 4, run = rr & 15;
    const bf16* lxh = LX + (size_t)b * SEQ * LW + hd * HD;
    const int tau = 16 * ((r >> 2) & 1) + 4 * (r >> 3) + (r & 3);
#define LRU_LOAD7(step) do { for (int n_ = wave; n_ < 34; n_ += 8) { const int dd_ = n_ >= 17 ? 1 : 0, j_ = n_ - 17 * dd_, rr_ = 4 * j_ + (lane >> 4); \
            const int tok_ = (dd_ ? SEQ - ((step) + 1) * T : (step) * T) - 2 + rr_; \
            const bf16* src_ = (tok_ >= 0 && tok_ < SEQ && rr_ < 67) ? lxh + (size_t)tok_ * LW + 8 * (lane & 15) : zrow + 8 * (lane & 15); \
            __builtin_amdgcn_global_load_lds((const unsigned*)src_, (LAS unsigned*)(lds + RAW_OFF + dd_ * RAW_BYTES + j_ * 1024), 16, 0, 0); } } while (0)
#define LRU_CONV_WRITE(cg, run) do { _Pragma("unroll 1") for (int hf_ = 0; hf_ < 2; ++hf_) { f32x2 wk_[5][2]; v2u xr[7];     \
        _Pragma("unroll") for (int k_ = 0; k_ < 7; ++k_) xr[k_] = *(const LAS v2u*)(lds + RAW_OFF + cdir * RAW_BYTES + (4 * (run) + k_) * 256 + (cg) * 16 + 8 * hf_); \
        _Pragma("unroll") for (int k_ = 0; k_ < 5; ++k_) { const f32x4 a_ = *(const LAS f32x4*)(cwl + k_ * 128 + 8 * (cg) + 4 * hf_); \
            wk_[k_][0] = (f32x2){a_[0], a_[1]}; wk_[k_][1] = (f32x2){a_[2], a_[3]}; } \
        LAS unsigned char* ub_ = lds + U_OFF + cdir * 16384; LAS unsigned char* ut_ = lds + UT_OFF + cdir * UT_BYTES; unsigned pk_[4][2]; \
        _Pragma("unroll") for (int i_ = 0; i_ < 4; ++i_) { f32x2 o0_ = wk_[4][0], o1_ = wk_[4][1]; \
            _Pragma("unroll") for (int k_ = 0; k_ < 4; ++k_) { const v2u x_ = xr[i_ + k_]; \
                o0_ += wk_[k_][0] * (f32x2){bflo(x_.x), bfhi(x_.x)}; o1_ += wk_[k_][1] * (f32x2){bflo(x_.y), bfhi(x_.y)}; } \
            const int row_ = 4 * (run) + i_; pk_[i_][0] = cvtpk(o0_.x, o0_.y); pk_[i_][1] = cvtpk(o1_.x, o1_.y); \
            v2u w_; w_.x = pk_[i_][0]; w_.y = pk_[i_][1]; \
            *(LAS v2u*)(ub_ + row_ * 256 + (((cg) ^ (row_ & 15)) << 4) + 8 * hf_) = w_; } \
        _Pragma("unroll") for (int jj_ = 0; jj_ < 2; ++jj_) {     \
            v2u lo_, hi_; \
            lo_.x = __builtin_amdgcn_perm(pk_[1][jj_], pk_[0][jj_], 0x05040100u); lo_.y = __builtin_amdgcn_perm(pk_[3][jj_], pk_[2][jj_], 0x05040100u); \
            hi_.x = __builtin_amdgcn_perm(pk_[1][jj_], pk_[0][jj_], 0x07060302u); hi_.y = __builtin_amdgcn_perm(pk_[3][jj_], pk_[2][jj_], 0x07060302u); \
            *(LAS v2u*)(ut_ + (8 * (cg) + 4 * hf_ + 2 * jj_) * UT_STRIDE + 8 * (run)) = lo_; *(LAS v2u*)(ut_ + (8 * (cg) + 4 * hf_ + 2 * jj_ + 1) * UT_STRIDE + 8 * (run)) = hi_; } } } while (0)
    LRU_LOAD7(0);
    asm volatile("s_waitcnt vmcnt(0)" ::: "memory");
    __syncthreads();
    LRU_CONV_WRITE(cg, run);
    __syncthreads();
    float hc = 0.f;
    for (int s = 0; s < S; ++s) {
        LP(21);
        int tau_l = tau, cg_l = cg, run_l = run, chl_l = chl;
        asm volatile("" : "+v"(tau_l), "+v"(cg_l), "+v"(run_l), "+v"(chl_l));
        if (s + 1 < S) LRU_LOAD7(s + 1);
        const bool first_half = s < S / 2;
        const int fd = tid >> 8, ftile0 = fd ? SEQ - (s + 1) * T : s * T;
        bf16* fbase = HS + ((size_t)b * SEQ + ftile0) * LW + hd * HD;
        v4u pr[4];
        if (!first_half) {
#pragma unroll
            for (int j = 0; j < 4; ++j) { const int id = (tid & 255) + 256 * j; pr[j] = *(const v4u*)(fbase + (size_t)(id >> 4) * LW + (id & 15) * 8); }
        }
        {
            const LAS unsigned char* ub = lds + U_OFF + wd * 16384; const LAS unsigned char* ut = lds + UT_OFF + wd * UT_BYTES + chl_l * UT_STRIDE;
#pragma unroll 1
            for (int bi = 0; bi < 2; ++bi) {
                const int blk = wd ? 1 - bi : bi, rowp = 32 * blk + tau_l;
                const LAS unsigned char* arow = ub + rowp * 256;
                f32x16 accA, accX;
#pragma unroll
                for (int i = 0; i < 16; ++i) { accA[i] = 0.f; accX[i] = 0.f; }
#pragma unroll
                for (int ks = 0; ks < 8; ++ks) { const bf16x8 af = *(const LAS bf16x8*)(arow + (((2 * ks + h) ^ (rowp & 15)) << 4));
                    accA = __builtin_amdgcn_mfma_f32_32x32x16_bf16(af, Bf[0][ks], accA, 0, 0, 0); }
                float Ap[16], Hp[16];
#pragma unroll
                for (int i = 0; i < 16; i += 2) {
                    const f32x2 t = (f32x2){accA[i], accA[i + 1]} * (-L2E) + nba;
                    const f32x2 d = (f32x2){__builtin_amdgcn_exp2f(t.x), __builtin_amdgcn_exp2f(t.y)} + 1.0f;
                    const f32x2 la = (f32x2){__builtin_amdgcn_rcpf(d.x), __builtin_amdgcn_rcpf(d.y)} * kl2;
                    const f32x2 a = (f32x2){__builtin_amdgcn_exp2f(la.x), __builtin_amdgcn_exp2f(la.y)};
                    const f32x2 m2 = 1.0f - a * a;
                    Ap[i] = a.x; Ap[i + 1] = a.y; Hp[i] = __builtin_amdgcn_sqrtf(m2.x); Hp[i + 1] = __builtin_amdgcn_sqrtf(m2.y); }
                asm volatile("" ::: "memory");
#pragma unroll
                for (int ks = 0; ks < 8; ++ks) { const bf16x8 af = *(const LAS bf16x8*)(arow + (((2 * ks + h) ^ (rowp & 15)) << 4));
                    accX = __builtin_amdgcn_mfma_f32_32x32x16_bf16(af, Bf[1][ks], accX, 0, 0, 0); }
                const v4u u0 = *(const LAS v4u*)(ut + (32 * blk + 16 * h) * 2), u1 = *(const LAS v4u*)(ut + (32 * blk + 16 * h) * 2 + 16);
                float uv[16];
                uv[0] = bflo(u0.x); uv[1] = bfhi(u0.x); uv[2] = bflo(u0.y); uv[3] = bfhi(u0.y); uv[4] = bflo(u0.z); uv[5] = bfhi(u0.z); uv[6] = bflo(u0.w); uv[7] = bfhi(u0.w);
                uv[8] = bflo(u1.x); uv[9] = bfhi(u1.x); uv[10] = bflo(u1.y); uv[11] = bfhi(u1.y); uv[12] = bflo(u1.z); uv[13] = bfhi(u1.z); uv[14] = bflo(u1.w); uv[15] = bfhi(u1.w);
#pragma unroll
                for (int i = 0; i < 16; i += 2) {
                    const f32x2 t = (f32x2){accX[i], accX[i + 1]} * (-L2E) + nbx;
                    const f32x2 d = (f32x2){__builtin_amdgcn_exp2f(t.x), __builtin_amdgcn_exp2f(t.y)} + 1.0f;
                    const f32x2 g = (f32x2){Hp[i], Hp[i + 1]} * ((f32x2){__builtin_amdgcn_rcpf(d.x), __builtin_amdgcn_rcpf(d.y)} * (f32x2){uv[i], uv[i + 1]});
                    Hp[i] = g.x; Hp[i + 1] = g.y; }
                float hin;
                if (wd == 0) {
#pragma unroll
                    for (int i = 1; i < 16; ++i) { Hp[i] = Ap[i] * Hp[i - 1] + Hp[i]; Ap[i] = Ap[i] * Ap[i - 1]; }
                    const float oa = __shfl_xor(Ap[15], 32), oh = __shfl_xor(Hp[15], 32);
                    const float t0a = h ? oa : Ap[15], t0h = h ? oh : Hp[15], t1a = h ? Ap[15] : oa, t1h = h ? Hp[15] : oh;
                    const float hin1 = t0a * hc + t0h; hin = h ? hin1 : hc; hc = t1a * hin1 + t1h;
                } else {
#pragma unroll
                    for (int i = 14; i >= 0; --i) { Hp[i] = Ap[i] * Hp[i + 1] + Hp[i]; Ap[i] = Ap[i] * Ap[i + 1]; }
                    const float oa = __shfl_xor(Ap[0], 32), oh = __shfl_xor(Hp[0], 32);
                    const float t0a = h ? oa : Ap[0], t0h = h ? oh : Hp[0], t1a = h ? Ap[0] : oa, t1h = h ? Hp[0] : oh;
                    const float hin0 = t1a * hc + t1h; hin = h ? hc : hin0; hc = t0a * hin0 + t0h;
                }
                LAS unsigned char* hp = lds + H_OFF + wd * H_BYTES + (32 * blk + 16 * h) * H_STRIDE + chl_l * 2;
#pragma unroll
                for (int i = 0; i < 16; i += 2) { const f32x2 hv = (f32x2){Ap[i], Ap[i + 1]} * hin + (f32x2){Hp[i], Hp[i + 1]}; const unsigned w = cvtpk(hv.x, hv.y);
                    *(LAS unsigned short*)(hp + i * H_STRIDE) = (unsigned short)w; *(LAS unsigned short*)(hp + (i + 1) * H_STRIDE) = (unsigned short)(w >> 16); }
            }
        }
        LQ(21); LP(22);
        asm volatile("s_waitcnt vmcnt(0)" ::: "memory");
        LQ(22); LP(24);
        __syncthreads();
        LQ(24); LP(23);
        {
            const LAS unsigned char* hb = lds + H_OFF + fd * H_BYTES;
#pragma unroll
            for (int j = 0; j < 4; ++j) { const int id = (tid & 255) + 256 * j; v4u hw = *(const LAS v4u*)(hb + (id >> 4) * H_STRIDE + (id & 15) * 16);
                if (!first_half) { const v4u p = pr[j];
                    hw.x = cvtpk(bflo(hw.x) + bflo(p.x), bfhi(hw.x) + bfhi(p.x)); hw.y = cvtpk(bflo(hw.y) + bflo(p.y), bfhi(hw.y) + bfhi(p.y));
                    hw.z = cvtpk(bflo(hw.z) + bflo(p.z), bfhi(hw.z) + bfhi(p.z)); hw.w = cvtpk(bflo(hw.w) + bflo(p.w), bfhi(hw.w) + bfhi(p.w)); }
                *(v4u*)(fbase + (size_t)(id >> 4) * LW + (id & 15) * 8) = hw; }
        }
        __builtin_amdgcn_sched_barrier(0);
        if (s + 1 < S) LRU_CONV_WRITE(cg_l, run_l);
        if (s == S / 2 - 1) asm volatile("s_waitcnt vmcnt(0)" ::: "memory");
        LQ(23); LP(25);
        __syncthreads();
        LQ(25);
    }
    asm volatile("s_waitcnt vmcnt(0)" ::: "memory");
#undef LRU_LOAD7
#undef LRU_CONV_WRITE
#undef LP
#undef LQ
}
#endif

#define XB_TMO      128
#define XB_XCNT(j)  (256  + 64 * (j))
#define XB_XSUB(j)  (1280 + 64 * (j))
#define XB_XGEN(j)  (2304 + 64 * (j))
#define XB_TOP      3328
#define XB_TOPGEN   3392
#define XCD_BAR_WORDS 3456
#define XB_SPIN_CAP (1u << 18)

__device__ __forceinline__ unsigned xb_ld(unsigned* p)              { return __hip_atomic_load(p, __ATOMIC_RELAXED, __HIP_MEMORY_SCOPE_AGENT); }
__device__ __forceinline__ unsigned xb_add(unsigned* p, unsigned v) { return __hip_atomic_fetch_add(p, v, __ATOMIC_RELAXED, __HIP_MEMORY_SCOPE_AGENT); }
__device__ __forceinline__ unsigned xb_xcc_id() { return (unsigned)__builtin_amdgcn_s_getreg((3 << 11) | 20) & 0xFu; }
#define XB_SPIN(cond, bar) do { unsigned _sp = 0; while (cond) { __builtin_amdgcn_s_sleep(1); \
    if ((++_sp & 255u) == 0u) { if (xb_ld(&(bar)[XB_TMO])) break; if (_sp > XB_SPIN_CAP) { atomicAdd(&(bar)[XB_TMO], 1u); break; } } } } while (0)

struct XcdBarrier {
    unsigned* bar; unsigned x;
    volatile LAS unsigned* st;
};

__device__ __forceinline__ XcdBarrier xcd_barrier_post(unsigned* bar, volatile LAS unsigned* st) {
    XcdBarrier b; b.bar = bar; b.x = xb_xcc_id(); b.st = st;
    if (threadIdx.x == 0) (void)xb_add(&bar[XB_XCNT(b.x)], 1u);
    return b;
}
__device__ __forceinline__ void xcd_barrier_complete(unsigned* bar, unsigned x, unsigned& nloc, unsigned& nx) {
    const unsigned G = gridDim.x * gridDim.y * gridDim.z;
    unsigned sum, cnt, mine, sp = 0u;
    for (;;) {
        sum = 0u; cnt = 0u; mine = 0u;
#pragma unroll
        for (unsigned j = 0; j < 16; ++j) { const unsigned c = xb_ld(&bar[XB_XCNT(j)]); sum += c; cnt += (c > 0u) ? 1u : 0u; mine = (j == x) ? c : mine; }
        if (sum == G) break;
        __builtin_amdgcn_s_sleep(1);
        if ((++sp & 255u) == 0u) { if (xb_ld(&bar[XB_TMO])) break; if (sp > XB_SPIN_CAP) { atomicAdd(&bar[XB_TMO], 1u); break; } }
    }
    nloc = mine > 0u ? mine : 1u; nx = cnt > 0u ? cnt : 1u;
}

__device__ __forceinline__ void xcd_barrier(const XcdBarrier& b) {
    asm volatile("s_waitcnt vmcnt(0)" ::: "memory");
    __syncthreads();
    if (threadIdx.x == 0) {
        unsigned* bar = b.bar;
        __builtin_amdgcn_s_waitcnt(0);
        unsigned nloc = b.st[0], nx = b.st[1];
        if (nloc == 0u) { xcd_barrier_complete(bar, b.x, nloc, nx); b.st[0] = nloc; b.st[1] = nx; }
        const unsigned old = xb_add(&bar[XB_XSUB(b.x)], 1u);
        const unsigned gen = old / nloc;
        if (old + 1u == (gen + 1u) * nloc) {
            __builtin_amdgcn_fence(__ATOMIC_RELEASE, "agent");
            asm volatile("s_waitcnt vmcnt(0)" ::: "memory");
            const unsigned og = xb_add(&bar[XB_TOP], 1u);
            const unsigned tg = og / nx;
            if (og + 1u == (tg + 1u) * nx) xb_add(&bar[XB_TOPGEN], 1u);
            else XB_SPIN(xb_ld(&bar[XB_TOPGEN]) == tg, bar);
            __builtin_amdgcn_fence(__ATOMIC_ACQUIRE, "agent");
            xb_add(&bar[XB_XGEN(b.x)], 1u);
            asm volatile("s_waitcnt vmcnt(0)" ::: "memory");
        } else {
            XB_SPIN(xb_ld(&bar[XB_XGEN(b.x)]) == gen, bar);
            __builtin_amdgcn_fence(__ATOMIC_ACQUIRE, "agent");
            asm volatile("s_waitcnt vmcnt(0)" ::: "memory");
        }
    }
    __syncthreads();
}

struct Args { const float* in[22]; float* out; unsigned char* ws; int ph_lo, ph_hi; };

__global__ void __launch_bounds__(NTHR, 2) mk_fwd(Args args) {
    extern __shared__ __attribute__((aligned(16))) unsigned char lds_raw[];
    LAS unsigned char* lds = (LAS unsigned char*)lds_raw;
    volatile LAS unsigned* MISC = (volatile LAS unsigned*)(lds + MISC_OFF);
    const int tid = threadIdx.x, lane = tid & 63, wave = __builtin_amdgcn_readfirstlane(tid >> 6);
    const int G = gridDim.x, bx = blockIdx.x;
    const int gw = bx * NWAVES + wave, NGW = G * NWAVES;
    unsigned char* ws = args.ws; unsigned char* dob = (unsigned char*)args.out;
    unsigned* ctl = (unsigned*)(ws + WS_CTL);
    const float* x = args.in[0]; const float* w_in = args.in[1]; const float* lru_conv_w = args.in[2]; const float* lru_conv_b = args.in[3];
    const float* lru_w_a = args.in[4]; const float* lru_b_a = args.in[5]; const float* lru_w_x = args.in[6]; const float* lru_b_x = args.in[7];
    const float* lru_lambda = args.in[8]; const float* w_lru_out = args.in[9]; const float* sc_conv_w = args.in[10]; const float* sc_conv_b = args.in[11];
    const float* w_conv_out = args.in[12]; const float* w_o = args.in[13]; const float* ln1_g = args.in[14]; const float* ln1_b = args.in[15];
    const float* mlp_w1 = args.in[16]; const float* mlp_b1 = args.in[17]; const float* mlp_w2 = args.in[18]; const float* mlp_b2 = args.in[19];
    const float* ln2_g = args.in[20]; const float* ln2_b = args.in[21];
    bf16* XB = (bf16*)(dob + DO_XB); bf16* WINT = (bf16*)(dob + DO_WINT); bf16* HS = (bf16*)(dob + DO_HS); float* OUTF = args.out;
    bf16* WG = (bf16*)(ws + WS_WG); bf16* WLO = (bf16*)(ws + WS_WLO); bf16* WCO = (bf16*)(ws + WS_WCO); bf16* WO = (bf16*)(ws + WS_WO); bf16* W1 = (bf16*)(ws + WS_W1); bf16* W2 = (bf16*)(ws + WS_W2);
    bf16* LX = (bf16*)(ws + WS_LX); bf16* SEC = (bf16*)(ws + WS_SEC); constexpr size_t SEC_ELEMS = SEC_BYTES / 2;
    bf16* CXR = SEC; bf16* CBZ = SEC + SEC_ELEMS; bf16* CCC = SEC + 2 * SEC_ELEMS; bf16* GL = SEC + 3 * SEC_ELEMS; bf16* GC = SEC + 4 * SEC_ELEMS;
    bf16* V1B = (bf16*)(dob + 0); bf16* FFB = (bf16*)(ws + WS_FF); bf16* H1B = (bf16*)(ws + WS_H1B);
    f32x2* ST1 = (f32x2*)(ws + WS_ST1); f32x2* ST2 = (f32x2*)(ws + WS_ST2);

    const int lo = args.ph_lo, hi = args.ph_hi;
#if MK_ONE_LAUNCH
    cg::grid_group grid = cg::this_grid();
    if (tid < 32) MISC[tid] = 0u;
    __syncthreads();
    const XcdBarrier xbar = xcd_barrier_post(ctl + CW_BAR, MISC + 8);
#define SEAM(k) do { if (lo <= (k) && (k) + 1 < hi) { if ((k) == 0) grid.sync(); else xcd_barrier(xbar); } } while (0)
#else
#define SEAM(k) do { } while (0)
#endif
#define IN(k) (lo <= (k) && (k) < hi)
    unsigned long long pr_t0 = 0ull, pr_dt = 0ull;
#define PB(k) do { if (MK_PROBE == (k)) pr_t0 = __builtin_amdgcn_s_memrealtime(); } while (0)
#define PE(k) do { if (MK_PROBE == (k)) pr_dt = __builtin_amdgcn_s_memrealtime() - pr_t0; } while (0)

    PB(0);
    if (IN(0)) {
        LAS float* scr = (LAS float*)(lds + wave * 8448);
        constexpr int I_IN = (DM / 64) * (INC / 32), I_LO = (LW / 64) * (DM / 32), I_CO = (CW / 64) * (DM / 32), I_O = (DM / 64) * (DM / 32), I_1 = (DM / 64) * (DFF / 32), I_2 = (DFF / 64) * (DM / 32);
        constexpr int I_G = 2 * 2 * NH * 8;
        constexpr int NITEMS = I_IN + I_LO + I_CO + I_O + I_1 + I_2 + I_G;
        for (int it = gw; it < NITEMS; it += NGW) {
            int r = it;
            if (r < I_IN) { p0_transpose_item(w_in, DM, INC, WINT, scr, r, lane); continue; } r -= I_IN;
            if (r < I_LO) { p0_transpose_item(w_lru_out, LW, DM, WLO, scr, r, lane); continue; } r -= I_LO;
            if (r < I_CO) { p0_transpose_item(w_conv_out, CW, DM, WCO, scr, r, lane); continue; } r -= I_CO;
            if (r < I_O) { p0_transpose_item(w_o, DM, DM, WO, scr, r, lane); continue; } r -= I_O;
            if (r < I_1) { p0_transpose_item(mlp_w1, DM, DFF, W1, scr, r, lane); continue; } r -= I_1;
            if (r < I_2) { p0_transpose_item(mlp_w2, DFF, DM, W2, scr, r, lane); continue; } r -= I_2;
            { const int mat = r >> 3, sub = r & 7, gate = mat / (2 * NH), dh = mat % (2 * NH);
              const float* src = (gate ? lru_w_x : lru_w_a) + (size_t)dh * HD * HD;
              p0_transpose_item(src, HD, HD, WG + (size_t)mat * HD * HD, scr, sub, lane); }
        }
        for (int m = gw; m < MT; m += NGW) {
            const f32x4* xr = (const f32x4*)(x + (size_t)m * DM) + lane; v2u* o8 = (v2u*)(XB + (size_t)m * DM) + lane;
#pragma unroll
            for (int j = 0; j < 8; ++j) { const f32x4 v = xr[64 * j]; v2u w; w.x = cvtpk(v[0], v[1]); w.y = cvtpk(v[2], v[3]); o8[64 * j] = w; }
        }
    }
    SEAM(0); PE(0);
    PB(1);
    if (IN(1)) {
        pg8::Gemm g{XB, WINT, MT, INC, DM}; pg8::StaticOrder S; S.init(MT, INC, G, bx);
        pg8::EpiProj E{LX, SEC, SEC_ELEMS};
        pg8::gemm_phase<pg8::EpiProj, pg8::StaticOrder, true, true>(lds, g, S, E);
    }
    SEAM(1); PE(1);
    PB(2);
    if (IN(2)) {
#if MK_NAIVE_LRU
        if (bx < NB * NH) lru_naive_item(bx / NH, bx % NH, LX, lru_conv_w, lru_conv_b, lru_w_a, lru_b_a, lru_w_x, lru_b_x, lru_lambda, HS, (LAS float*)(lds), tid);
#else
        PB(20);
        if (bx < NB * NH) lru2_item(bx / NH, bx % NH, LX, lru_conv_w, lru_conv_b, WG, lru_b_a, lru_b_x, lru_lambda, HS, (const bf16*)(ctl + 256), lds, tid, lane, wave, pr_dt);
        PE(20);
#endif
        for (;;) {
            __syncthreads();
            if (tid == 0) MISC[0] = atomicAdd(ctl + CW_ZQ, 1u);
            __syncthreads();
            const int item = (int)MISC[0];
            if (item >= MT / 32) break;
            z_item(item, CXR, CBZ, CCC, sc_conv_w, sc_conv_b, tid);
        }
        __syncthreads();
    }
    SEAM(2); PE(2);
    PB(3);
    if (IN(3)) {
        { pg8::Gemm g{HS, WLO, MT, DM, LW}; pg8::StaticOrder S; S.init(MT, DM, G, bx);
          pg8::EpiGate1 E{GL};
          pg8::gemm_phase<pg8::EpiGate1, pg8::StaticOrder, true, true>(lds, g, S, E); }
        __syncthreads();
        { pg8::Gemm g{CBZ, WCO, MT, DM, CW}; pg8::StaticOrder S; S.init(MT, DM, G, bx);
          pg8::EpiGate2 E{GC, GL};
          pg8::gemm_phase<pg8::EpiGate2, pg8::StaticOrder, true, true>(lds, g, S, E); }
    }
    SEAM(3); PE(3);
    PB(4);
    if (IN(4)) {
        pg8::Gemm g{GC, WO, MT, DM, DM}; pg8::StaticOrder S; S.init(MT, DM, G, bx);
        pg8::EpiResStats<false> E{x, V1B, nullptr, (pg8::f32x2*)ST1, ALPHA};
        pg8::gemm_phase<pg8::EpiResStats<false>, pg8::StaticOrder, true, true>(lds, g, S, E);
    }
    SEAM(4); PE(4);
    PB(5);
    if (IN(5)) {
        for (int m = gw; m < MT; m += NGW) ln_apply_row_bf(V1B + (size_t)m * DM, ST1 + (size_t)m * 32, ln1_g, ln1_b, H1B + (size_t)m * DM, lane);
    }
    SEAM(5); PE(5);
    PB(6);
    if (IN(6)) {
        pg8::Gemm g{H1B, W1, MT, DFF, DM}; pg8::StaticOrder S; S.init(MT, DFF, G, bx);
        pg8::EpiRelu2 E{FFB, DFF, mlp_b1};
        pg8::gemm_phase<pg8::EpiRelu2, pg8::StaticOrder, true, true>(lds, g, S, E);
    }
    SEAM(6); PE(6);
    PB(7);
    if (IN(7)) {
        pg8::Gemm g{FFB, W2, MT, DM, DFF}; pg8::StaticOrder S; S.init(MT, DM, G, bx);
        pg8::EpiResStats<true> E{H1B, OUTF, mlp_b2, (pg8::f32x2*)ST2, ALPHA};
        pg8::gemm_phase<pg8::EpiResStats<true>, pg8::StaticOrder, true, true>(lds, g, S, E);
    }
    SEAM(7); PE(7);
    PB(8);
    if (IN(8)) {
        for (int m = gw; m < MT; m += NGW) ln_apply_row(OUTF + (size_t)m * DM, ST2 + (size_t)m * 32, ln2_g, ln2_b, OUTF + (size_t)m * DM, lane);
    }
    PE(8);
    if (MK_PROBE >= 0 && bx == 0) { const unsigned long long t1 = __builtin_amdgcn_s_memrealtime(); while (__builtin_amdgcn_s_memrealtime() - t1 < 4ull * pr_dt) __builtin_amdgcn_s_sleep(8); }
#undef IN
#undef SEAM
}

extern "C" void kernel_launch(void* const* d_in, const int* in_sizes, int n_in, void* d_out, int out_size, void* d_ws, size_t ws_size, hipStream_t stream) {
    static int grid = 0;
    if (grid == 0) {
        if (n_in != 22 || in_sizes[0] != MT * DM || out_size != MT * DM || ws_size < WS_END) {
            fprintf(stderr, "kernel_launch: unexpected shapes (n_in %d, in0 %d, out %d, ws %zu; need ws >= %zu)\n", n_in, n_in > 0 ? in_sizes[0] : -1, out_size, ws_size, (size_t)WS_END); grid = -1; return; }
        int dev = 0, cus = 0, per_cu = 0;
        if (hipGetDevice(&dev) != hipSuccess || hipDeviceGetAttribute(&cus, hipDeviceAttributeMultiprocessorCount, dev) != hipSuccess) { grid = -1; return; }
        if (hipFuncSetAttribute((const void*)mk_fwd, hipFuncAttributeMaxDynamicSharedMemorySize, LDS_BYTES) != hipSuccess) { fprintf(stderr, "kernel_launch: hipFuncSetAttribute failed\n"); grid = -1; return; }
        if (hipOccupancyMaxActiveBlocksPerMultiprocessor(&per_cu, (const void*)mk_fwd, NTHR, LDS_BYTES) != hipSuccess || per_cu < 1) { fprintf(stderr, "kernel_launch: occupancy query says %d blocks/CU\n", per_cu); (void)hipGetLastError(); grid = -1; return; }
        grid = cus * 1;
        fprintf(stderr, "kernel_launch: %d CUs, occupancy %d blocks/CU, grid %d\n", cus, per_cu, grid);
    }
    if (grid < 0) return;
    (void)hipMemsetAsync((char*)d_ws + WS_CTL, 0, CTL_BYTES, stream);
    Args a{};
    for (int i = 0; i < 22; ++i) a.in[i] = (const float*)d_in[i];
    a.out = (float*)d_out; a.ws = (unsigned char*)d_ws;
#if MK_ONE_LAUNCH
    a.ph_lo = 0; a.ph_hi = NPHASE;
    void* kargs[] = {&a};
    hipError_t e = hipLaunchCooperativeKernel((const void*)mk_fwd, dim3(grid), dim3(NTHR), kargs, LDS_BYTES, stream);
    if (e != hipSuccess) fprintf(stderr, "kernel_launch: cooperative launch failed: %s (grid %d)\n", hipGetErrorString(e), grid);
#else
    for (int p = 0; p < NPHASE; ++p) { a.ph_lo = p; a.ph_hi = p + 1; hipLaunchKernelGGL(mk_fwd, dim3(grid), dim3(NTHR), LDS_BYTES, stream, a); }
#endif
}
```

```cpp
#include <hip/hip_runtime.h>
#include <hip/hip_cooperative_groups.h>
#include <cstdio>
#include <cstdint>
namespace cg = cooperative_groups;
namespace pg8 {
#define PG8_LAS __attribute__((address_space(3)))
typedef unsigned short bf16_t;
typedef short bf16x8 __attribute__((ext_vector_type(8)));
typedef float f32x4 __attribute__((ext_vector_type(4)));
typedef unsigned u32x4 __attribute__((ext_vector_type(4)));
constexpr int BM = 256, BK = 64, HALF = 128, HTB = HALF * BK * 2  , STAGE_BYTES = 8 * HTB, NXCD = 8, WGM = 8;

__host__ __device__ __forceinline__ int lds_byte(int r, int c) { const int st = (r >> 4) * 2 + (c >> 5), rr = r & 15, cc = c & 31, ob = rr * 64 + cc * 2; return st * 1024 + (ob ^ (((ob >> 9) & 1) << 5)); }
__host__ __device__ __forceinline__ void stage_rc(int b, int& R, int& C) { const int st = b / 1024, sb = b % 1024, swz = sb ^ (((sb >> 9) & 1) << 5); R = (st >> 1) * 16 + swz / 64; C = (st & 1) * 32 + (swz % 64) / 2; }
__host__ __device__ __forceinline__ int perm32(int rho) { const int n = rho >> 4, i = rho & 15; return 8 * (i >> 2) + 4 * n + (i & 3); }

struct Unit { int pm, pn; };
struct Gemm { const bf16_t* A; const bf16_t* Bt; int M, N, K; };

struct StaticOrder {
    int nM, nN, nwg, G, c;
    __host__ __device__ void init(int M, int N, int G_, int c_) { nM = M / BM; nN = N / BM; nwg = nM * nN; G = G_; c = c_; }
    __host__ __device__ bool next(int i, Unit& u) const {
        const long L = (long)i * G + c; if (L >= nwg) return false;
        int wgid = (int)L; { const int q = nwg / NXCD, r = nwg % NXCD, xcd = wgid % NXCD, off = wgid / NXCD; wgid = (xcd < r ? xcd * (q + 1) : r * (q + 1) + (xcd - r) * q) + off; }
        const int nig = WGM * nN, gid = wgid / nig, fm = gid * WGM, gsz = (nM - fm) < WGM ? (nM - fm) : WGM;
        u.pm = fm + ((wgid % nig) % gsz); u.pn = (wgid % nig) / gsz; return true;
    }
    __device__ __forceinline__ void a_ready(const Unit&) const {}
    __device__ __forceinline__ void done(const Unit&) const {}
};

__device__ __forceinline__ unsigned cvt_pk_bf16(float lo, float hi) { unsigned r; asm volatile("v_cvt_pk_bf16_f32 %0, %1, %2" : "=v"(r) : "v"(lo), "v"(hi)); return r; }
typedef float f32x2 __attribute__((ext_vector_type(2)));
__device__ __forceinline__ float bf_lo(unsigned w) { return __uint_as_float(w << 16); }
__device__ __forceinline__ float bf_hi(unsigned w) { return __uint_as_float(w & 0xffff0000u); }
__device__ __forceinline__ float sigmoidf_fast(float v) { return __builtin_amdgcn_rcpf(1.0f + __builtin_amdgcn_exp2f(v * -1.44269504089f)); }

struct EpiProj {
    static constexpr bool PERM = true, AFTER_DRAIN = false;
    bf16_t* lx; bf16_t* sec; size_t sec_stride;
    __device__ __forceinline__ void operator()(const f32x4 (&acc)[2][2][4][2], const Unit& u, int wr, int wc, int fr, int fq) const {
        bf16_t* base; int ldc, colt;
        if (u.pn < 10) { base = lx; ldc = 2560; colt = u.pn * BM; }
        else { const int s = (u.pn - 10) >> 3; base = sec + (size_t)s * sec_stride; ldc = 2048; colt = ((u.pn - 10) & 7) * BM; }
        const int row0 = u.pm * BM + wr * 64 + fr, col0 = colt + wc * 32 + 8 * fq;
#pragma unroll
        for (int ai = 0; ai < 2; ++ai)
#pragma unroll
            for (int m = 0; m < 4; ++m) { bf16_t* rowp = base + (size_t)(row0 + ai * HALF + m * 16) * ldc + col0;
#pragma unroll
                for (int bj = 0; bj < 2; ++bj) { const f32x4 v0 = acc[ai][bj][m][0], v1 = acc[ai][bj][m][1];
                    u32x4 w; w.x = cvt_pk_bf16(v0[0], v0[1]); w.y = cvt_pk_bf16(v0[2], v0[3]); w.z = cvt_pk_bf16(v1[0], v1[1]); w.w = cvt_pk_bf16(v1[2], v1[3]);
                    *(u32x4*)(rowp + bj * HALF) = w; } }
    }
};
struct EpiGate1 {
    static constexpr bool PERM = true, AFTER_DRAIN = false;
    bf16_t* g;
    __device__ __forceinline__ void operator()(const f32x4 (&acc)[2][2][4][2], const Unit& u, int wr, int wc, int fr, int fq) const {
        const int row0 = u.pm * BM + wr * 64 + fr, col0 = u.pn * BM + wc * 32 + 8 * fq;
#pragma unroll
        for (int ai = 0; ai < 2; ++ai)
#pragma unroll
            for (int m = 0; m < 4; ++m) { const size_t off = (size_t)(row0 + ai * HALF + m * 16) * 2048 + col0;
#pragma unroll
                for (int bj = 0; bj < 2; ++bj) { const u32x4 gw = *(const u32x4*)(g + off + bj * HALF);
                    f32x4 s0, s1; s0[0] = sigmoidf_fast(bf_lo(gw.x)); s0[1] = sigmoidf_fast(bf_hi(gw.x)); s0[2] = sigmoidf_fast(bf_lo(gw.y)); s0[3] = sigmoidf_fast(bf_hi(gw.y));
                    s1[0] = sigmoidf_fast(bf_lo(gw.z)); s1[1] = sigmoidf_fast(bf_hi(gw.z)); s1[2] = sigmoidf_fast(bf_lo(gw.w)); s1[3] = sigmoidf_fast(bf_hi(gw.w));
                    const f32x4 v0 = s0 * acc[ai][bj][m][0], v1 = s1 * acc[ai][bj][m][1];
                    u32x4 w; w.x = cvt_pk_bf16(v0[0], v0[1]); w.y = cvt_pk_bf16(v0[2], v0[3]); w.z = cvt_pk_bf16(v1[0], v1[1]); w.w = cvt_pk_bf16(v1[2], v1[3]);
                    *(u32x4*)(g + off + bj * HALF) = w; } }
    }
};
struct EpiGate2 {
    static constexpr bool PERM = true, AFTER_DRAIN = false;
    bf16_t* g; const bf16_t* t1;
    __device__ __forceinline__ void operator()(const f32x4 (&acc)[2][2][4][2], const Unit& u, int wr, int wc, int fr, int fq) const {
        const int row0 = u.pm * BM + wr * 64 + fr, col0 = u.pn * BM + wc * 32 + 8 * fq;
#pragma unroll
        for (int ai = 0; ai < 2; ++ai)
#pragma unroll
            for (int m = 0; m < 4; ++m) { const size_t off = (size_t)(row0 + ai * HALF + m * 16) * 2048 + col0;
#pragma unroll
                for (int bj = 0; bj < 2; ++bj) { const u32x4 gw = *(const u32x4*)(g + off + bj * HALF); const u32x4 tw = *(const u32x4*)(t1 + off + bj * HALF);
                    const f32x4 a0 = {bf_lo(tw.x), bf_hi(tw.x), bf_lo(tw.y), bf_hi(tw.y)}, a1 = {bf_lo(tw.z), bf_hi(tw.z), bf_lo(tw.w), bf_hi(tw.w)};
                    f32x4 s0, s1; s0[0] = sigmoidf_fast(bf_lo(gw.x)); s0[1] = sigmoidf_fast(bf_hi(gw.x)); s0[2] = sigmoidf_fast(bf_lo(gw.y)); s0[3] = sigmoidf_fast(bf_hi(gw.y));
                    s1[0] = sigmoidf_fast(bf_lo(gw.z)); s1[1] = sigmoidf_fast(bf_hi(gw.z)); s1[2] = sigmoidf_fast(bf_lo(gw.w)); s1[3] = sigmoidf_fast(bf_hi(gw.w));
                    const f32x4 v0 = a0 + s0 * acc[ai][bj][m][0], v1 = a1 + s1 * acc[ai][bj][m][1];
                    u32x4 w; w.x = cvt_pk_bf16(v0[0], v0[1]); w.y = cvt_pk_bf16(v0[2], v0[3]); w.z = cvt_pk_bf16(v1[0], v1[1]); w.w = cvt_pk_bf16(v1[2], v1[3]);
                    *(u32x4*)(g + off + bj * HALF) = w; } }
    }
};
template <bool RES_BF16> struct EpiResStats {
    static constexpr bool PERM = true, AFTER_DRAIN = false;
    const void* base; void* out; const float* bias; f32x2* st; float alpha;
    __device__ __forceinline__ void operator()(const f32x4 (&acc)[2][2][4][2], const Unit& u, int wr, int wc, int fr, int fq) const {
        const int col0 = u.pn * BM + wc * 32 + 8 * fq;
        f32x4 bv[2][2];
#pragma unroll
        for (int bj = 0; bj < 2; ++bj)
#pragma unroll
            for (int n = 0; n < 2; ++n) bv[bj][n] = bias ? *(const f32x4*)(bias + col0 + bj * HALF + 4 * n) : (f32x4){0.f, 0.f, 0.f, 0.f};
#pragma unroll
        for (int ai = 0; ai < 2; ++ai)
#pragma unroll
            for (int m = 0; m < 4; ++m) { const int r = u.pm * BM + ai * HALF + wr * 64 + m * 16 + fr; const size_t off = (size_t)r * 2048 + col0;
                f32x4 v[2][2]; float s = 0.f;
#pragma unroll
                for (int bj = 0; bj < 2; ++bj) {
                    f32x4 b0, b1;
                    if (RES_BF16) { const u32x4 hw = *(const u32x4*)((const bf16_t*)base + off + bj * HALF); b0 = (f32x4){bf_lo(hw.x), bf_hi(hw.x), bf_lo(hw.y), bf_hi(hw.y)}; b1 = (f32x4){bf_lo(hw.z), bf_hi(hw.z), bf_lo(hw.w), bf_hi(hw.w)}; }
                    else { b0 = *(const f32x4*)((const float*)base + off + bj * HALF); b1 = *(const f32x4*)((const float*)base + off + bj * HALF + 4); }
                    v[bj][0] = b0 * alpha + acc[ai][bj][m][0] + bv[bj][0]; v[bj][1] = b1 * alpha + acc[ai][bj][m][1] + bv[bj][1]; }
#pragma unroll
                for (int bj = 0; bj < 2; ++bj) {
                    if (RES_BF16) { *(f32x4*)((float*)out + off + bj * HALF) = v[bj][0]; *(f32x4*)((float*)out + off + bj * HALF + 4) = v[bj][1]; }
                    else { u32x4 w; w.x = cvt_pk_bf16(v[bj][0][0], v[bj][0][1]); w.y = cvt_pk_bf16(v[bj][0][2], v[bj][0][3]); w.z = cvt_pk_bf16(v[bj][1][0], v[bj][1][1]); w.w = cvt_pk_bf16(v[bj][1][2], v[bj][1][3]);
                        *(u32x4*)((bf16_t*)out + off + bj * HALF) = w; }
#pragma unroll
                    for (int n = 0; n < 2; ++n) s += (v[bj][n][0] + v[bj][n][1]) + (v[bj][n][2] + v[bj][n][3]); }
                s += __shfl_xor(s, 16); s += __shfl_xor(s, 32);
                const float mw = s * (1.0f / 64.0f); float q = 0.f;
#pragma unroll
                for (int bj = 0; bj < 2; ++bj)
#pragma unroll
                    for (int n = 0; n < 2; ++n) { const f32x4 d = v[bj][n] - mw; q += (d[0] * d[0] + d[1] * d[1]) + (d[2] * d[2] + d[3] * d[3]); }
                q += __shfl_xor(q, 16); q += __shfl_xor(q, 32);
                if (fq == 0) st[(size_t)r * 32 + u.pn * 4 + wc] = (f32x2){mw, q};
                asm volatile("" ::: "memory"); }
    }
};
struct EpiRelu2 {
    static constexpr bool PERM = true, AFTER_DRAIN = false;
    bf16_t* O; int ldc; const float* bias;
    __device__ __forceinline__ void operator()(const f32x4 (&acc)[2][2][4][2], const Unit& u, int wr, int wc, int fr, int fq) const {
        const int row0 = u.pm * BM + wr * 64 + fr, col0 = u.pn * BM + wc * 32 + 8 * fq;
        f32x4 bv[2][2];
#pragma unroll
        for (int bj = 0; bj < 2; ++bj)
#pragma unroll
            for (int n = 0; n < 2; ++n) bv[bj][n] = *(const f32x4*)(bias + col0 + bj * HALF + 4 * n);
#pragma unroll
        for (int ai = 0; ai < 2; ++ai)
#pragma unroll
            for (int m = 0; m < 4; ++m) { bf16_t* rowp = O + (size_t)(row0 + ai * HALF + m * 16) * ldc + col0;
#pragma unroll
                for (int bj = 0; bj < 2; ++bj) { f32x4 v0 = acc[ai][bj][m][0] + bv[bj][0], v1 = acc[ai][bj][m][1] + bv[bj][1];
#pragma unroll
                    for (int j = 0; j < 4; ++j) { const float a = fmaxf(v0[j], 0.f), b = fmaxf(v1[j], 0.f); v0[j] = a * a; v1[j] = b * b; }
                    u32x4 w; w.x = cvt_pk_bf16(v0[0], v0[1]); w.y = cvt_pk_bf16(v0[2], v0[3]); w.z = cvt_pk_bf16(v1[0], v1[1]); w.w = cvt_pk_bf16(v1[2], v1[3]);
                    *(u32x4*)(rowp + bj * HALF) = w; } }
    }
};

template <class Epi, class Sched, bool ALIGN_EPI = false, bool SP2 = false>
__device__ __forceinline__ void gemm_phase(PG8_LAS unsigned char* lds, const Gemm g, const Sched& S, const Epi& E) {
    const int tid = threadIdx.x, wid = __builtin_amdgcn_readfirstlane(tid >> 6), lane = tid & 63, wr = wid >> 2, wc = wid & 3, fr = lane & 15, fq = lane >> 4;
    const int K = g.K, nt = K / BK;
    unsigned voffA[2], voffB[2];
#pragma unroll
    for (int i = 0; i < 2; ++i) { int R, C; stage_rc(tid * 16 + i * 8192, R, C); const int Rb = Epi::PERM ? ((R & ~31) + perm32(R & 31)) : R;
        voffA[i] = (unsigned)(R * K + C) * 2u; voffB[i] = (unsigned)(Rb * K + C) * 2u; }
    const size_t kstep = (size_t)(BK * 2);
    const size_t hstep = (size_t)HALF * K * 2;
    const size_t tstep = 2 * hstep;
    const unsigned ldsw = (unsigned)wid * 1024u;
    const int aoff = lds_byte(wr * 64 + fr, fq * 8), boff = lds_byte(wc * 32 + fr, fq * 8);
#define PG8_SA(b, h) (((b) * 2 + (h)) * HTB)
#define PG8_SB(b, h) ((4 + (b) * 2 + (h)) * HTB)
#define PG8_STAGE(bufoff, gbase, voff) do { _Pragma("unroll") for (int _i = 0; _i < 2; ++_i) \
        __builtin_amdgcn_global_load_lds((const unsigned*)((const char*)(gbase) + (voff)[_i]), (PG8_LAS unsigned*)(lds + (bufoff) + ldsw + _i * 8192), 16, 0, 0); } while (0)
#define PG8_LDA(dst, b, h) do { _Pragma("unroll") for (int m = 0; m < 4; ++m) _Pragma("unroll") for (int k = 0; k < 2; ++k) dst[m][k] = *(const PG8_LAS bf16x8*)(lds + PG8_SA(b, h) + aoff + m * 2048 + k * 1024); } while (0)
#define PG8_LDB(dst, b, h) do { _Pragma("unroll") for (int n = 0; n < 2; ++n) _Pragma("unroll") for (int k = 0; k < 2; ++k) dst[n][k] = *(const PG8_LAS bf16x8*)(lds + PG8_SB(b, h) + boff + n * 2048 + k * 1024); } while (0)
#define PG8_MMA(ai, bj, At, Bt) do { __builtin_amdgcn_s_setprio(1); _Pragma("unroll") for (int m = 0; m < 4; ++m) _Pragma("unroll") for (int n = 0; n < 2; ++n) _Pragma("unroll") for (int k = 0; k < 2; ++k) \
        acc[ai][bj][m][n] = __builtin_amdgcn_mfma_f32_16x16x32_bf16(Bt[n][k], At[m][k], acc[ai][bj][m][n], 0, 0, 0); __builtin_amdgcn_s_setprio(0); } while (0)
#define PG8_WAIT_V(n) asm volatile("s_waitcnt vmcnt(" #n ")" ::: "memory")
#define PG8_WAIT_L(n) asm volatile("s_waitcnt lgkmcnt(" #n ")" ::: "memory")
#define PG8_BAR __builtin_amdgcn_s_barrier()
#define PG8_SCHED __builtin_amdgcn_sched_barrier(0)
    Unit cur, nxt; int ui = 0;
    if (!S.next(0, cur)) return;
    f32x4 acc[2][2][4][2];
#pragma unroll
    for (int a = 0; a < 2; ++a)
#pragma unroll
        for (int b = 0; b < 2; ++b)
#pragma unroll
            for (int m = 0; m < 4; ++m)
#pragma unroll
                for (int n = 0; n < 2; ++n) acc[a][b][m][n] = (f32x4){0.f, 0.f, 0.f, 0.f};
    bf16x8 At[4][2], B0[2][2], B1[2][2];
    const char* cA = (const char*)g.A + (size_t)cur.pm * tstep; const char* cB = (const char*)g.Bt + (size_t)cur.pn * tstep;
    S.a_ready(cur);
    if constexpr (SP2) {
        PG8_STAGE(PG8_SB(0, 0), cB, voffB); PG8_STAGE(PG8_SB(0, 1), cB + hstep, voffB); PG8_STAGE(PG8_SA(0, 0), cA, voffA); PG8_STAGE(PG8_SA(0, 1), cA + hstep, voffA);
        if (wr == 1) PG8_BAR;
        PG8_WAIT_V(2); PG8_BAR;
        PG8_STAGE(PG8_SB(1, 0), cB + kstep, voffB); PG8_STAGE(PG8_SA(1, 0), cA + kstep, voffA); PG8_STAGE(PG8_SB(1, 1), cB + hstep + kstep, voffB);
        PG8_WAIT_V(6); PG8_BAR;
    } else {
        PG8_STAGE(PG8_SB(0, 0), cB, voffB); PG8_STAGE(PG8_SA(0, 0), cA, voffA); PG8_STAGE(PG8_SB(0, 1), cB + hstep, voffB); PG8_STAGE(PG8_SA(0, 1), cA + hstep, voffA);
        if (wr == 1) PG8_BAR;
        PG8_WAIT_V(4); PG8_BAR;
        PG8_STAGE(PG8_SB(1, 0), cB + kstep, voffB); PG8_STAGE(PG8_SA(1, 0), cA + kstep, voffA); PG8_STAGE(PG8_SB(1, 1), cB + hstep + kstep, voffB);
        PG8_WAIT_V(6); PG8_BAR;
    }
    for (;;) {
        const bool has_next = S.next(ui + 1, nxt);
        const char* nA = has_next ? (const char*)g.A + (size_t)nxt.pm * tstep : cA; const char* nB = has_next ? (const char*)g.Bt + (size_t)nxt.pn * tstep : cB;
        for (int t = 0; t < nt; t += 2) {
            const bool last = (t == nt - 2);
            const char* a1 = cA + (size_t)(t + 1) * kstep;
            const char* a2 = last ? nA : cA + (size_t)(t + 2) * kstep; const char* b2 = last ? nB : cB + (size_t)(t + 2) * kstep;
            const char* a3 = a2 + kstep; const char* b3 = b2 + kstep;
            if (last && has_next) S.a_ready(nxt);
            if constexpr (SP2) {
            PG8_LDB(B0, 0, 0); PG8_LDB(B1, 0, 1); PG8_SCHED; PG8_LDA(At, 0, 0); PG8_STAGE(PG8_SA(1, 1), a1 + hstep, voffA);
            PG8_WAIT_V(8); PG8_WAIT_L(0); PG8_BAR; PG8_MMA(0, 0, At, B0); PG8_MMA(0, 1, At, B1); PG8_BAR; PG8_SCHED;
            PG8_LDA(At, 0, 1); PG8_STAGE(PG8_SB(0, 0), b2, voffB); PG8_STAGE(PG8_SB(0, 1), b2 + hstep, voffB); PG8_STAGE(PG8_SA(0, 0), a2, voffA);
            PG8_WAIT_V(8); PG8_WAIT_L(0); PG8_BAR; PG8_MMA(1, 0, At, B0); PG8_MMA(1, 1, At, B1); PG8_BAR; PG8_SCHED;
            PG8_LDB(B0, 1, 0); PG8_LDB(B1, 1, 1); PG8_SCHED; PG8_LDA(At, 1, 0); PG8_STAGE(PG8_SA(0, 1), a2 + hstep, voffA);
            PG8_WAIT_V(8); PG8_WAIT_L(0); PG8_BAR; PG8_MMA(0, 0, At, B0); PG8_MMA(0, 1, At, B1); PG8_BAR; PG8_SCHED;
            PG8_LDA(At, 1, 1); PG8_STAGE(PG8_SB(1, 0), b3, voffB); PG8_STAGE(PG8_SB(1, 1), b3 + hstep, voffB); PG8_STAGE(PG8_SA(1, 0), a3, voffA);
            PG8_WAIT_V(8); PG8_WAIT_L(0); PG8_BAR; PG8_MMA(1, 0, At, B0); PG8_MMA(1, 1, At, B1); PG8_BAR; PG8_SCHED;
            } else {
            PG8_LDB(B0, 0, 0); PG8_SCHED; PG8_LDA(At, 0, 0); PG8_STAGE(PG8_SA(1, 1), a1 + hstep, voffA);
            PG8_WAIT_L(8); PG8_BAR; PG8_WAIT_L(0); PG8_MMA(0, 0, At, B0); PG8_BAR; PG8_SCHED;
            PG8_LDB(B1, 0, 1); PG8_STAGE(PG8_SB(0, 0), b2, voffB);
            PG8_BAR; PG8_WAIT_L(0); PG8_MMA(0, 1, At, B1); PG8_BAR;
            PG8_LDA(At, 0, 1); PG8_STAGE(PG8_SA(0, 0), a2, voffA);
            PG8_BAR; PG8_WAIT_L(0); PG8_MMA(1, 0, At, B0); PG8_BAR; PG8_SCHED;
            PG8_STAGE(PG8_SB(0, 1), b2 + hstep, voffB);
            PG8_WAIT_V(6); PG8_BAR; PG8_MMA(1, 1, At, B1); PG8_BAR;
            PG8_LDB(B0, 1, 0); PG8_SCHED; PG8_LDA(At, 1, 0); PG8_STAGE(PG8_SA(0, 1), a2 + hstep, voffA);
            PG8_WAIT_L(8); PG8_BAR; PG8_WAIT_L(0); PG8_MMA(0, 0, At, B0); PG8_BAR; PG8_SCHED;
            PG8_LDB(B1, 1, 1); PG8_STAGE(PG8_SB(1, 0), b3, voffB);
            PG8_BAR; PG8_WAIT_L(0); PG8_MMA(0, 1, At, B1); PG8_BAR;
            PG8_LDA(At, 1, 1); PG8_STAGE(PG8_SA(1, 0), a3, voffA);
            PG8_BAR; PG8_WAIT_L(0); PG8_MMA(1, 0, At, B0); PG8_BAR; PG8_SCHED;
            PG8_STAGE(PG8_SB(1, 1), b3 + hstep, voffB);
            PG8_WAIT_V(6); PG8_BAR; PG8_MMA(1, 1, At, B1); PG8_BAR;
            }
        }
        if constexpr (ALIGN_EPI) { if (wr == 0) PG8_BAR; }
        if constexpr (!Epi::AFTER_DRAIN) { E(acc, cur, wr, wc, fr, fq); S.done(cur); }
        if (!has_next) break;
#pragma unroll
        for (int a = 0; a < 2; ++a)
#pragma unroll
            for (int b = 0; b < 2; ++b)
#pragma unroll
                for (int m = 0; m < 4; ++m)
#pragma unroll
                    for (int n = 0; n < 2; ++n) acc[a][b][m][n] = (f32x4){0.f, 0.f, 0.f, 0.f};
        cur = nxt; cA = nA; cB = nB; ++ui;
        if constexpr (ALIGN_EPI) { if (wr == 1) PG8_BAR; }
    }
    PG8_WAIT_V(0);
    if constexpr (!ALIGN_EPI) { if (wr == 0) PG8_BAR; }
    PG8_BAR;
    if constexpr (Epi::AFTER_DRAIN) { E.fused(acc, cur, wr, wc, fr, fq, lds, wid, lane); S.done(cur); }
#undef PG8_SA
#undef PG8_SB
#undef PG8_STAGE
#undef PG8_LDA
#undef PG8_LDB
#undef PG8_MMA
#undef PG8_WAIT_V
#undef PG8_WAIT_L
#undef PG8_BAR
#undef PG8_SCHED
}
}
#ifndef MK_ONE_LAUNCH
#define MK_ONE_LAUNCH 1
#endif
#ifndef MK_PROBE
#define MK_PROBE (-1)
#endif
#ifndef MK_NAIVE_LRU
#define MK_NAIVE_LRU 0
#endif
constexpr int NWAVES = 8, NTHR = NWAVES * 64;
constexpr int NB = 8, SEQ = 2048, MT = NB * SEQ, DM = 2048, LW = 2560, NH = 20, HD = 128, CW = 2048, DFF = 8192, INC = 12800;
constexpr float ALPHA = 1.18920711500272f;
constexpr float LN_EPS = 1e-5f;
constexpr int NPHASE = 9;
constexpr size_t MiB = 1u << 20;
constexpr size_t WS_CTL = 0, CTL_BYTES = 1 * MiB;
constexpr size_t WS_ST1 = 1 * MiB, WS_ST2 = 5 * MiB;
constexpr size_t WS_WG = 9 * MiB;
constexpr size_t WS_WLO = 12 * MiB, WS_WCO = 22 * MiB, WS_WO = 30 * MiB, WS_W1 = 38 * MiB, WS_W2 = 70 * MiB;
constexpr size_t WS_LX = 102 * MiB;
constexpr size_t WS_SEC = 182 * MiB, SEC_BYTES = 64 * MiB;
constexpr size_t WS_T1 = 102 * MiB;
constexpr size_t WS_FF = 102 * MiB;
constexpr size_t WS_H1B = WS_SEC + 3 * SEC_BYTES;
constexpr size_t WS_END = WS_SEC + 5 * SEC_BYTES;
static_assert(WS_FF + (size_t)MT * DFF * 2 <= WS_H1B, "FF overlay must end before H1B");
constexpr size_t DO_XB = 0, DO_WINT = 64 * MiB, DO_HS = 0;
constexpr int CW_ZQ = 64;
constexpr int CW_BAR = 4096;
constexpr int LDS_BYTES = 147456, MISC_OFF = 147456 - 256;

#define GAS __attribute__((address_space(1)))
#define LAS __attribute__((address_space(3)))
typedef unsigned short bf16;
typedef unsigned v4u __attribute__((ext_vector_type(4)));
typedef unsigned v2u __attribute__((ext_vector_type(2)));
typedef float f32x4 __attribute__((ext_vector_type(4)));
typedef float f32x2 __attribute__((ext_vector_type(2)));
#define LDS_WAIT() asm volatile("s_waitcnt lgkmcnt(0)" ::: "memory")
__device__ __forceinline__ unsigned f2bf(float f) { unsigned u = __builtin_bit_cast(unsigned, f); return (u + 0x7fffu + ((u >> 16) & 1u)) >> 16; }
__device__ __forceinline__ unsigned pk2(float lo, float hi) { return f2bf(lo) | (f2bf(hi) << 16); }
__device__ __forceinline__ unsigned cvtpk(float lo, float hi) { unsigned r; asm("v_cvt_pk_bf16_f32 %0, %1, %2" : "=v"(r) : "v"(lo), "v"(hi)); return r; }
__device__ __forceinline__ float bf2f(unsigned short b) { return __uint_as_float(((unsigned)b) << 16); }
__device__ __forceinline__ float bflo(unsigned w) { return __uint_as_float(w << 16); }
__device__ __forceinline__ float bfhi(unsigned w) { return __uint_as_float(w & 0xffff0000u); }

__device__ __forceinline__ void p0_transpose_item(const float* W, int K, int N, bf16* WT, LAS float* scr, int item, int lane) {
    const int nblk = N / 32, kb = item / nblk, nb = item % nblk, k0 = 64 * kb, n0 = 32 * nb;
#pragma unroll 8
    for (int i = 0; i < 32; ++i) { const int kk = 2 * i + (lane >> 5); scr[kk * 33 + (lane & 31)] = W[(size_t)(k0 + kk) * N + n0 + (lane & 31)]; }
    LDS_WAIT(); asm volatile("" ::: "memory");
    const int c = lane & 7;
#pragma unroll
    for (int j = 0; j < 4; ++j) { const int n = (lane >> 3) + 8 * j; const LAS float* s = scr + (8 * c) * 33 + n;
        v4u o; o.x = cvtpk(s[0 * 33], s[1 * 33]); o.y = cvtpk(s[2 * 33], s[3 * 33]); o.z = cvtpk(s[4 * 33], s[5 * 33]); o.w = cvtpk(s[6 * 33], s[7 * 33]);
        *(v4u*)(WT + (size_t)(n0 + n) * K + k0 + 8 * c) = o; }
    LDS_WAIT(); asm volatile("" ::: "memory");
}

__device__ __forceinline__ f32x2 ln_row_stats(const f32x2* strow, int lane) {
    const f32x2 p = strow[lane & 31];
    float ms = p.x;
#pragma unroll
    for (int o = 1; o < 32; o <<= 1) ms += __shfl_xor(ms, o);
    const float mean = ms * (1.0f / 32.0f);
    const float dm = p.x - mean; float q = p.y + 64.0f * dm * dm;
#pragma unroll
    for (int o = 1; o < 32; o <<= 1) q += __shfl_xor(q, o);
    return (f32x2){mean, 1.0f / sqrtf(q * (1.0f / 2048.0f) + LN_EPS)};
}
__device__ __forceinline__ void ln_apply_row(const float* vrow, const f32x2* strow, const float* gam, const float* bet, float* outf, int lane) {
    const f32x2 mr = ln_row_stats(strow, lane);
    const f32x4* v4 = (const f32x4*)vrow; const f32x4* g4 = (const f32x4*)gam; const f32x4* b4 = (const f32x4*)bet;
#pragma unroll
    for (int j = 0; j < 8; ++j) { const int i = 64 * j + lane; const f32x4 x = v4[i]; ((f32x4*)outf)[i] = (x - mr.x) * mr.y * g4[i] + b4[i]; }
}
__device__ __forceinline__ void ln_apply_row_bf(const bf16* vrow, const f32x2* strow, const float* gam, const float* bet, bf16* outb, int lane) {
    const f32x2 mr = ln_row_stats(strow, lane);
    const f32x4* g4 = (const f32x4*)gam; const f32x4* b4 = (const f32x4*)bet;
#pragma unroll
    for (int j = 0; j < 4; ++j) { const int i = 64 * j + lane; const v4u w = ((const v4u*)vrow)[i];
        const f32x4 x0 = {bflo(w.x), bfhi(w.x), bflo(w.y), bfhi(w.y)}, x1 = {bflo(w.z), bfhi(w.z), bflo(w.w), bfhi(w.w)};
        const f32x4 y0 = (x0 - mr.x) * mr.y * g4[2 * i] + b4[2 * i], y1 = (x1 - mr.x) * mr.y * g4[2 * i + 1] + b4[2 * i + 1];
        v4u o; o.x = cvtpk(y0[0], y0[1]); o.y = cvtpk(y0[2], y0[3]); o.z = cvtpk(y1[0], y1[1]); o.w = cvtpk(y1[2], y1[3]);
        ((v4u*)outb)[i] = o; }
}

__device__ __forceinline__ void z_item(int item, const bf16* CX, bf16* CBZ, const bf16* CC, const float* w, const float* bias, int tid) {
    const int cg = tid & 255, rh = tid >> 8, R0 = item * 32 + rh * 16, t0 = R0 & (SEQ - 1), c0 = cg * 8;
    float w0[8], w1[8], w2[8], bb[8];
#pragma unroll
    for (int j = 0; j < 8; ++j) { w0[j] = w[c0 + j]; w1[j] = w[CW + c0 + j]; w2[j] = w[2 * CW + c0 + j]; bb[j] = bias[c0 + j]; }
    const v4u zero4 = {0u, 0u, 0u, 0u};
#define MULCX(dst, a_, b_) do { dst[0] = bflo(a_.x) * bflo(b_.x); dst[1] = bfhi(a_.x) * bfhi(b_.x); dst[2] = bflo(a_.y) * bflo(b_.y); dst[3] = bfhi(a_.y) * bfhi(b_.y); \
        dst[4] = bflo(a_.z) * bflo(b_.z); dst[5] = bfhi(a_.z) * bfhi(b_.z); dst[6] = bflo(a_.w) * bflo(b_.w); dst[7] = bfhi(a_.w) * bfhi(b_.w); } while (0)
#pragma unroll 1
    for (int ck = 0; ck < 4; ++ck) {
        const int Rc = R0 + 4 * ck, tc = t0 + 4 * ck;
        v4u xa[6], xc[6], cbv[4];
#pragma unroll
        for (int k = 0; k < 6; ++k) { const bool ok = (tc + k - 1 >= 0) && (tc + k - 1 < SEQ);
            xa[k] = ok ? *(const v4u*)(CX + (size_t)(Rc + k - 1) * CW + c0) : zero4; xc[k] = ok ? *(const v4u*)(CC + (size_t)(Rc + k - 1) * CW + c0) : zero4; }
#pragma unroll
        for (int i = 0; i < 4; ++i) cbv[i] = *(const v4u*)(CBZ + (size_t)(Rc + i) * CW + c0);
        float pv[8], cu[8], nx[8];
        MULCX(pv, xa[0], xc[0]); MULCX(cu, xa[1], xc[1]);
#pragma unroll
        for (int i = 0; i < 4; ++i) {
            MULCX(nx, xa[i + 2], xc[i + 2]);
            float z[8];
#pragma unroll
            for (int j = 0; j < 8; ++j) z[j] = w0[j] * pv[j] + w1[j] * cu[j] + w2[j] * nx[j] + bb[j];
            const v4u cb = cbv[i];
            v4u o; o.x = cvtpk(bflo(cb.x) * z[0], bfhi(cb.x) * z[1]); o.y = cvtpk(bflo(cb.y) * z[2], bfhi(cb.y) * z[3]); o.z = cvtpk(bflo(cb.z) * z[4], bfhi(cb.z) * z[5]); o.w = cvtpk(bflo(cb.w) * z[6], bfhi(cb.w) * z[7]);
            *(v4u*)(CBZ + (size_t)(Rc + i) * CW + c0) = o;
#pragma unroll
            for (int j = 0; j < 8; ++j) { pv[j] = cu[j]; cu[j] = nx[j]; }
        }
    }
#undef MULCX
}

#if MK_NAIVE_LRU
__device__ __forceinline__ void lru_naive_item(int b, int hd, const bf16* LX, const float* cw, const float* cb, const float* wa, const float* ba, const float* wx, const float* bx,
                                               const float* lam, bf16* HS, LAS float* us, int tid) {
    const int dir = (tid >> 7) & 1, e = tid & 127; const bool act = tid < 256; const int ch = hd * HD + e;
    const float c0 = cw[ch], c1 = cw[LW + ch], c2 = cw[2 * LW + ch], c3 = cw[3 * LW + ch], cbias = cb[ch];
    const float b_a = ba[(dir * NH + hd) * HD + e], b_x = bx[(dir * NH + hd) * HD + e];
    const float kl = -8.0f * log1pf(expf(-lam[dir * LW + ch]));
    const float* Wa = wa + (size_t)(dir * NH + hd) * HD * HD + e; const float* Wx = wx + (size_t)(dir * NH + hd) * HD * HD + e;
    float h = 0.f;
    for (int s = 0; s < SEQ; ++s) {
        const int t = dir ? (SEQ - 1 - s) : s;
        float u = cbias;
        if (act) { const bf16* p = LX + ((size_t)b * SEQ + t) * LW + ch;
            if (t >= 2) u += c0 * bf2f(p[-2 * LW]); if (t >= 1) u += c1 * bf2f(p[-LW]); u += c2 * bf2f(p[0]); if (t + 1 < SEQ) u += c3 * bf2f(p[LW]);
            us[dir * HD + e] = u; }
        __syncthreads();
        if (act) { float ra = b_a, ri = b_x;
            for (int d = 0; d < HD; ++d) { const float ud = us[dir * HD + d]; ra += ud * Wa[d * HD]; ri += ud * Wx[d * HD]; }
            const float r = 1.0f / (1.0f + expf(-ra)), ig = 1.0f / (1.0f + expf(-ri));
            const float la = kl * r, a = expf(la), g = sqrtf(fmaxf(-expm1f(2.0f * la), 0.f)) * (ig * u);
            h = a * h + g;
            bf16* o = HS + ((size_t)b * SEQ + t) * LW + ch;
            if (s < SEQ / 2) *o = (bf16)f2bf(h); else *o = (bf16)f2bf(bf2f(*o) + h); }
        __syncthreads();
    }
}
#endif


#if !MK_NAIVE_LRU
__device__ __forceinline__ void lru_fast_item(int b, int hd, const bf16* LX, const float* cw, const float* cb, const bf16* WGt, const float* ba, const float* bx, const float* lam, bf16* HS,
                                              LAS unsigned char* lds, int tid, int lane, int wave) {
    constexpr int T = 64, S = SEQ / T; constexpr float L2E = 1.44269504089f;
    typedef short bf16x8 __attribute__((ext_vector_type(8)));
    const int q = lane >> 4, c = lane & 15, chl = 16 * wave + c, ch = hd * HD + chl;
    float nba[2], nbx[2], kl2[2], hc[2];
    bf16x8 Bf[2][2][4];
#pragma unroll
    for (int d = 0; d < 2; ++d) { nba[d] = -L2E * ba[(d * NH + hd) * HD + chl]; nbx[d] = -L2E * bx[(d * NH + hd) * HD + chl]; kl2[d] = -8.0f * L2E * log1pf(expf(-lam[d * LW + ch])); hc[d] = 0.f;
#pragma unroll
        for (int g = 0; g < 2; ++g)
#pragma unroll
            for (int ks = 0; ks < 4; ++ks) Bf[d][g][ks] = *(const bf16x8*)(WGt + ((size_t)((g * 2 + d) * NH + hd) * HD + chl) * HD + 32 * ks + 8 * q); }
    LAS float* cwl = (LAS float*)(lds + 65536 + 2 * 17408);
    for (int i = tid; i < 640; i += NTHR) { const int k = i >> 7, e = i & 127; cwl[i] = (k < 4) ? cw[k * LW + hd * HD + e] : cb[hd * HD + e]; }
    const int cg = tid & 15, rr = tid >> 4, cdir = rr >> 4, run = rr & 15;
    const bf16* lxb = LX + (size_t)b * SEQ * LW + hd * HD + 8 * cg;
    v4u xr[7];
#define LRU_LOAD7(step) do { const int ts_ = (cdir ? SEQ - ((step) + 1) * T : (step) * T) + 4 * run - 2; \
        _Pragma("unroll") for (int k_ = 0; k_ < 7; ++k_) { const int tok_ = ts_ + k_; xr[k_] = (tok_ >= 0 && tok_ < SEQ) ? *(const v4u*)(lxb + (size_t)tok_ * LW) : (v4u){0u, 0u, 0u, 0u}; } } while (0)
#define LRU_CONV_WRITE(buf) do { float wk_[5][8]; \
        _Pragma("unroll") for (int k_ = 0; k_ < 5; ++k_) { const f32x4 a_ = *(const LAS f32x4*)(cwl + k_ * 128 + 8 * cg), b_ = *(const LAS f32x4*)(cwl + k_ * 128 + 8 * cg + 4); \
            wk_[k_][0] = a_[0]; wk_[k_][1] = a_[1]; wk_[k_][2] = a_[2]; wk_[k_][3] = a_[3]; wk_[k_][4] = b_[0]; wk_[k_][5] = b_[1]; wk_[k_][6] = b_[2]; wk_[k_][7] = b_[3]; } \
        LAS unsigned char* ub_ = lds + (cdir * 2 + (buf)) * 16384; \
        _Pragma("unroll") for (int i_ = 0; i_ < 4; ++i_) { float o_[8]; \
            _Pragma("unroll") for (int j_ = 0; j_ < 8; ++j_) o_[j_] = wk_[4][j_]; \
            _Pragma("unroll") for (int k_ = 0; k_ < 4; ++k_) { const v4u x_ = xr[i_ + k_]; \
                o_[0] += wk_[k_][0] * bflo(x_.x); o_[1] += wk_[k_][1] * bfhi(x_.x); o_[2] += wk_[k_][2] * bflo(x_.y); o_[3] += wk_[k_][3] * bfhi(x_.y); \
                o_[4] += wk_[k_][4] * bflo(x_.z); o_[5] += wk_[k_][5] * bfhi(x_.z); o_[6] += wk_[k_][6] * bflo(x_.w); o_[7] += wk_[k_][7] * bfhi(x_.w); } \
            const int row_ = 4 * run + i_; v4u w_; w_.x = pk2(o_[0], o_[1]); w_.y = pk2(o_[2], o_[3]); w_.z = pk2(o_[4], o_[5]); w_.w = pk2(o_[6], o_[7]); \
            *(LAS v4u*)(ub_ + row_ * 256 + ((cg ^ (row_ & 15)) << 4)) = w_; } } while (0)
    __syncthreads();
    LRU_LOAD7(0);
    LRU_CONV_WRITE(0);
    __syncthreads();
    for (int s = 0; s < S; ++s) {
        if (s + 1 < S) LRU_LOAD7(s + 1);
        const bool first_half = s < S / 2;
        const int fd = tid >> 8, ftile0 = fd ? SEQ - (s + 1) * T : s * T;
        bf16* fbase = HS + ((size_t)b * SEQ + ftile0) * LW + hd * HD;
        v4u pr[4];
        if (!first_half) {
#pragma unroll
            for (int j = 0; j < 4; ++j) { const int id = (tid & 255) + 256 * j; pr[j] = *(const v4u*)(fbase + (size_t)(id >> 4) * LW + (id & 15) * 8); }
        }
#pragma unroll
        for (int d = 0; d < 2; ++d) {
            const LAS unsigned char* ub = lds + (d * 2 + (s & 1)) * 16384;
#pragma unroll 1
            for (int rbi = 0; rbi < 4; ++rbi) {
                const int rb = d ? 3 - rbi : rbi;
                pg8::f32x4 accA = {0.f, 0.f, 0.f, 0.f}, accX = {0.f, 0.f, 0.f, 0.f};
                const LAS unsigned char* arow = ub + (16 * rb + c) * 256;
#pragma unroll
                for (int ks = 0; ks < 4; ++ks) { const bf16x8 af = *(const LAS bf16x8*)(arow + (((q + 4 * ks) ^ c) << 4));
                    accA = __builtin_amdgcn_mfma_f32_16x16x32_bf16(af, Bf[d][0][ks], accA, 0, 0, 0);
                    accX = __builtin_amdgcn_mfma_f32_16x16x32_bf16(af, Bf[d][1][ks], accX, 0, 0, 0); }
                float av[4], gv[4];
#pragma unroll
                for (int i = 0; i < 4; ++i) { const int rowi = 16 * rb + 4 * q + i;
                    const float u = bf2f(*(const LAS unsigned short*)(ub + rowi * 256 + (((chl >> 3) ^ (rowi & 15)) << 4) + (chl & 7) * 2));
                    const float r = __builtin_amdgcn_rcpf(1.0f + __builtin_amdgcn_exp2f(accA[i] * -L2E + nba[d]));
                    const float ig = __builtin_amdgcn_rcpf(1.0f + __builtin_amdgcn_exp2f(accX[i] * -L2E + nbx[d]));
                    const float a = __builtin_amdgcn_exp2f(kl2[d] * r);
                    av[i] = a; gv[i] = __builtin_amdgcn_sqrtf(fmaxf(1.0f - a * a, 0.f)) * (ig * u); }
                float Ap[4], Hp[4], hv[4];
                if (d == 0) {
                    Ap[0] = av[0]; Hp[0] = gv[0];
#pragma unroll
                    for (int i = 1; i < 4; ++i) { Ap[i] = av[i] * Ap[i - 1]; Hp[i] = av[i] * Hp[i - 1] + gv[i]; }
                    float IA = Ap[3], IH = Hp[3];
                    { const float pa = __shfl_up(IA, 16), ph = __shfl_up(IH, 16); if (q >= 1) { IH = IA * ph + IH; IA = IA * pa; } }
                    { const float pa = __shfl_up(IA, 32), ph = __shfl_up(IH, 32); if (q >= 2) { IH = IA * ph + IH; IA = IA * pa; } }
                    float EA = __shfl_up(IA, 16), EH = __shfl_up(IH, 16); if (q == 0) { EA = 1.f; EH = 0.f; }
                    const float hin = EA * hc[d] + EH;
#pragma unroll
                    for (int i = 0; i < 4; ++i) hv[i] = Ap[i] * hin + Hp[i];
                    hc[d] = __shfl(hv[3], 48 + c);
                } else {
                    Ap[3] = av[3]; Hp[3] = gv[3];
#pragma unroll
                    for (int i = 2; i >= 0; --i) { Ap[i] = av[i] * Ap[i + 1]; Hp[i] = av[i] * Hp[i + 1] + gv[i]; }
                    float IA = Ap[0], IH = Hp[0];
                    { const float pa = __shfl_down(IA, 16), ph = __shfl_down(IH, 16); if (q <= 2) { IH = IA * ph + IH; IA = IA * pa; } }
                    { const float pa = __shfl_down(IA, 32), ph = __shfl_down(IH, 32); if (q <= 1) { IH = IA * ph + IH; IA = IA * pa; } }
                    float EA = __shfl_down(IA, 16), EH = __shfl_down(IH, 16); if (q == 3) { EA = 1.f; EH = 0.f; }
                    const float hin = EA * hc[d] + EH;
#pragma unroll
                    for (int i = 0; i < 4; ++i) hv[i] = Ap[i] * hin + Hp[i];
                    hc[d] = __shfl(hv[0], c);
                }
                LAS unsigned char* hp = lds + 65536 + d * 17408 + (16 * rb + 4 * q) * 272 + chl * 2;
#pragma unroll
                for (int i = 0; i < 4; ++i) *(LAS unsigned short*)(hp + i * 272) = (unsigned short)f2bf(hv[i]);
            }
        }
        __syncthreads();
        {
            const LAS unsigned char* hb = lds + 65536 + fd * 17408;
#pragma unroll
            for (int j = 0; j < 4; ++j) { const int id = (tid & 255) + 256 * j; v4u hw = *(const LAS v4u*)(hb + (id >> 4) * 272 + (id & 15) * 16);
                if (!first_half) { const v4u p = pr[j];
                    hw.x = pk2(bflo(hw.x) + bflo(p.x), bfhi(hw.x) + bfhi(p.x)); hw.y = pk2(bflo(hw.y) + bflo(p.y), bfhi(hw.y) + bfhi(p.y));
                    hw.z = pk2(bflo(hw.z) + bflo(p.z), bfhi(hw.z) + bfhi(p.z)); hw.w = pk2(bflo(hw.w) + bflo(p.w), bfhi(hw.w) + bfhi(p.w)); }
                *(v4u*)(fbase + (size_t)(id >> 4) * LW + (id & 15) * 8) = hw; }
        }
        if (s + 1 < S) LRU_CONV_WRITE((s + 1) & 1);
        asm volatile("s_waitcnt vmcnt(0)" ::: "memory");
        __syncthreads();
    }
#undef LRU_LOAD7
#undef LRU_CONV_WRITE
}
#endif


#if !MK_NAIVE_LRU
__device__ __forceinline__ void lru2_item(int b, int hd, const bf16* LX, const float* cw, const float* cb, const bf16* WGt, const float* ba, const float* bx, const float* lam, bf16* HS,
                                          const bf16* zrow, LAS unsigned char* lds, int tid, int lane, int wave, unsigned long long& pacc) {
    constexpr int T = 64, S = SEQ / T; constexpr float L2E = 1.44269504089f;
    unsigned long long ptm = 0ull;
#define LP(k) do { if (MK_PROBE == (k)) ptm = __builtin_amdgcn_s_memrealtime(); } while (0)
#define LQ(k) do { if (MK_PROBE == (k)) pacc += __builtin_amdgcn_s_memrealtime() - ptm; } while (0)
    constexpr int U_OFF = 0, UT_OFF = 32768, UT_STRIDE = 144, UT_BYTES = 128 * UT_STRIDE, H_OFF = UT_OFF + 2 * UT_BYTES, H_STRIDE = 272, H_BYTES = 64 * H_STRIDE, CWL_OFF = H_OFF + 2 * H_BYTES,
                  RAW_OFF = CWL_OFF + 2560, RAW_BYTES = 68 * 256;
    static_assert(RAW_OFF + 2 * RAW_BYTES <= MISC_OFF, "LRU LDS map");
    typedef short bf16x8 __attribute__((ext_vector_type(8)));
    typedef float f32x16 __attribute__((ext_vector_type(16)));
    const int wd = wave >> 2, chg = wave & 3, r = lane & 31, h = lane >> 5, chl = 32 * chg + r, ch = hd * HD + chl;
    const float nba = -L2E * ba[(wd * NH + hd) * HD + chl], nbx = -L2E * bx[(wd * NH + hd) * HD + chl], kl2 = -8.0f * L2E * log1pf(expf(-lam[wd * LW + ch]));
    bf16x8 Bf[2][8];
#pragma unroll
    for (int g = 0; g < 2; ++g)
#pragma unroll
        for (int ks = 0; ks < 8; ++ks) Bf[g][ks] = *(const bf16x8*)(WGt + ((size_t)((g * 2 + wd) * NH + hd) * HD + chl) * HD + 16 * ks + 8 * h);
    LAS float* cwl = (LAS float*)(lds + CWL_OFF);
    for (int i = tid; i < 640; i += NTHR) { const int k = i >> 7, e = i & 127; cwl[i] = (k < 4) ? cw[k * LW + hd * HD + e] : cb[hd * HD + e]; }
    const int cg = tid & 15, rr = tid >> 4, cdir = rr >> 4, run = rr & 15;
    const bf16* lxh = LX + (size_t)b * SEQ * LW + hd * HD;
    const int tau = 16 * ((r >> 2) & 1) + 4 * (r >> 3) + (r & 3);
#define LRU_LOAD7(step) do { for (int n_ = wave; n_ < 34; n_ += 8) { const int dd_ = n_ >= 17 ? 1 : 0, j_ = n_ - 17 * dd_, rr_ = 4 * j_ + (lane >> 4); \
            const int tok_ = (dd_ ? SEQ - ((step) + 1) * T : (step) * T) - 2 + rr_; \
            const bf16* src_ = (tok_ >= 0 && tok_ < SEQ && rr_ < 67) ? lxh + (size_t)tok_ * LW + 8 * (lane & 15) : zrow + 8 * (lane & 15); \
            __builtin_amdgcn_global_load_lds((const unsigned*)src_, (LAS unsigned*)(lds + RAW_OFF + dd_ * RAW_BYTES + j_ * 1024), 16, 0, 0); } } while (0)
#define LRU_CONV_WRITE(cg, run) do { _Pragma("unroll 1") for (int hf_ = 0; hf_ < 2; ++hf_) { f32x2 wk_[5][2]; v2u xr[7];     \
        _Pragma("unroll") for (int k_ = 0; k_ < 7; ++k_) xr[k_] = *(const LAS v2u*)(lds + RAW_OFF + cdir * RAW_BYTES + (4 * (run) + k_) * 256 + (cg) * 16 + 8 * hf_); \
        _Pragma("unroll") for (int k_ = 0; k_ < 5; ++k_) { const f32x4 a_ = *(const LAS f32x4*)(cwl + k_ * 128 + 8 * (cg) + 4 * hf_); \
            wk_[k_][0] = (f32x2){a_[0], a_[1]}; wk_[k_][1] = (f32x2){a_[2], a_[3]}; } \
        LAS unsigned char* ub_ = lds + U_OFF + cdir * 16384; LAS unsigned char* ut_ = lds + UT_OFF + cdir * UT_BYTES; unsigned pk_[4][2]; \
        _Pragma("unroll") for (int i_ = 0; i_ < 4; ++i_) { f32x2 o0_ = wk_[4][0], o1_ = wk_[4][1]; \
            _Pragma("unroll") for (int k_ = 0; k_ < 4; ++k_) { const v2u x_ = xr[i_ + k_]; \
                o0_ += wk_[k_][0] * (f32x2){bflo(x_.x), bfhi(x_.x)}; o1_ += wk_[k_][1] * (f32x2){bflo(x_.y), bfhi(x_.y)}; } \
            const int row_ = 4 * (run) + i_; pk_[i_][0] = cvtpk(o0_.x, o0_.y); pk_[i_][1] = cvtpk(o1_.x, o1_.y); \
            v2u w_; w_.x = pk_[i_][0]; w_.y = pk_[i_][1]; \
            *(LAS v2u*)(ub_ + row_ * 256 + (((cg) ^ (row_ & 15)) << 4) + 8 * hf_) = w_; } \
        _Pragma("unroll") for (int jj_ = 0; jj_ < 2; ++jj_) {     \
            v2u lo_, hi_; \
            lo_.x = __builtin_amdgcn_perm(pk_[1][jj_], pk_[0][jj_], 0x05040100u); lo_.y = __builtin_amdgcn_perm(pk_[3][jj_], pk_[2][jj_], 0x05040100u); \
            hi_.x = __builtin_amdgcn_perm(pk_[1][jj_], pk_[0][jj_], 0x07060302u); hi_.y = __builtin_amdgcn_perm(pk_[3][jj_], pk_[2][jj_], 0x07060302u); \
            *(LAS v2u*)(ut_ + (8 * (cg) + 4 * hf_ + 2 * jj_) * UT_STRIDE + 8 * (run)) = lo_; *(LAS v2u*)(ut_ + (8 * (cg) + 4 * hf_ + 2 * jj_ + 1) * UT_STRIDE + 8 * (run)) = hi_; } } } while (0)
    LRU_LOAD7(0);
    asm volatile("s_waitcnt vmcnt(0)" ::: "memory");
    __syncthreads();
    LRU_CONV_WRITE(cg, run);
    __syncthreads();
    float hc = 0.f;
    for (int s = 0; s < S; ++s) {
        LP(21);
        int tau_l = tau, cg_l = cg, run_l = run, chl_l = chl;
        asm volatile("" : "+v"(tau_l), "+v"(cg_l), "+v"(run_l), "+v"(chl_l));
        if (s + 1 < S) LRU_LOAD7(s + 1);
        const bool first_half = s < S / 2;
        const int fd = tid >> 8, ftile0 = fd ? SEQ - (s + 1) * T : s * T;
        bf16* fbase = HS + ((size_t)b * SEQ + ftile0) * LW + hd * HD;
        v4u pr[4];
        if (!first_half) {
#pragma unroll
            for (int j = 0; j < 4; ++j) { const int id = (tid & 255) + 256 * j; pr[j] = *(const v4u*)(fbase + (size_t)(id >> 4) * LW + (id & 15) * 8); }
        }
        {
            const LAS unsigned char* ub = lds + U_OFF + wd * 16384; const LAS unsigned char* ut = lds + UT_OFF + wd * UT_BYTES + chl_l * UT_STRIDE;
#pragma unroll 1
            for (int bi = 0; bi < 2; ++bi) {
                const int blk = wd ? 1 - bi : bi, rowp = 32 * blk + tau_l;
                const LAS unsigned char* arow = ub + rowp * 256;
                f32x16 accA, accX;
#pragma unroll
                for (int i = 0; i < 16; ++i) { accA[i] = 0.f; accX[i] = 0.f; }
#pragma unroll
                for (int ks = 0; ks < 8; ++ks) { const bf16x8 af = *(const LAS bf16x8*)(arow + (((2 * ks + h) ^ (rowp & 15)) << 4));
                    accA = __builtin_amdgcn_mfma_f32_32x32x16_bf16(af, Bf[0][ks], accA, 0, 0, 0); }
                float Ap[16], Hp[16];
#pragma unroll
                for (int i = 0; i < 16; i += 2) {
                    const f32x2 t = (f32x2){accA[i], accA[i + 1]} * (-L2E) + nba;
                    const f32x2 d = (f32x2){__builtin_amdgcn_exp2f(t.x), __builtin_amdgcn_exp2f(t.y)} + 1.0f;
                    const f32x2 la = (f32x2){__builtin_amdgcn_rcpf(d.x), __builtin_amdgcn_rcpf(d.y)} * kl2;
                    const f32x2 a = (f32x2){__builtin_amdgcn_exp2f(la.x), __builtin_amdgcn_exp2f(la.y)};
                    const f32x2 m2 = 1.0f - a * a;
                    Ap[i] = a.x; Ap[i + 1] = a.y; Hp[i] = __builtin_amdgcn_sqrtf(m2.x); Hp[i + 1] = __builtin_amdgcn_sqrtf(m2.y); }
                asm volatile("" ::: "memory");
#pragma unroll
                for (int ks = 0; ks < 8; ++ks) { const bf16x8 af = *(const LAS bf16x8*)(arow + (((2 * ks + h) ^ (rowp & 15)) << 4));
                    accX = __builtin_amdgcn_mfma_f32_32x32x16_bf16(af, Bf[1][ks], accX, 0, 0, 0); }
                const v4u u0 = *(const LAS v4u*)(ut + (32 * blk + 16 * h) * 2), u1 = *(const LAS v4u*)(ut + (32 * blk + 16 * h) * 2 + 16);
                float uv[16];
                uv[0] = bflo(u0.x); uv[1] = bfhi(u0.x); uv[2] = bflo(u0.y); uv[3] = bfhi(u0.y); uv[4] = bflo(u0.z); uv[5] = bfhi(u0.z); uv[6] = bflo(u0.w); uv[7] = bfhi(u0.w);
                uv[8] = bflo(u1.x); uv[9] = bfhi(u1.x); uv[10] = bflo(u1.y); uv[11] = bfhi(u1.y); uv[12] = bflo(u1.z); uv[13] = bfhi(u1.z); uv[14] = bflo(u1.w); uv[15] = bfhi(u1.w);
#pragma unroll
                for (int i = 0; i < 16; i += 2) {
                    const f32x2 t = (f32x2){accX[i], accX[i + 1]} * (-L2E) + nbx;
                    const f32x2 d = (f32x2){__builtin_amdgcn_exp2f(t.x), __builtin_amdgcn_exp2f(t.y)} + 1.0f;
                    const f32x2 g = (f32x2){Hp[i], Hp[i + 1]} * ((f32x2){__builtin_amdgcn_rcpf(d.x), __builtin_amdgcn_rcpf(d.y)} * (f32x2){uv[i], uv[i + 1]});
                    Hp[i] = g.x; Hp[i + 1] = g.y; }
                float hin;
                if (wd == 0) {
#pragma unroll
                    for (int i = 1; i < 16; ++i) { Hp[i] = Ap[i] * Hp[i - 1] + Hp[i]; Ap[i] = Ap[i] * Ap[i - 1]; }
                    const float oa = __shfl_xor(Ap[15], 32), oh = __shfl_xor(Hp[15], 32);
                    const float t0a = h ? oa : Ap[15], t0h = h ? oh : Hp[15], t1a = h ? Ap[15] : oa, t1h = h ? Hp[15] : oh;
                    const float hin1 = t0a * hc + t0h; hin = h ? hin1 : hc; hc = t1a * hin1 + t1h;
                } else {
#pragma unroll
                    for (int i = 14; i >= 0; --i) { Hp[i] = Ap[i] * Hp[i + 1] + Hp[i]; Ap[i] = Ap[i] * Ap[i + 1]; }
                    const float oa = __shfl_xor(Ap[0], 32), oh = __shfl_xor(Hp[0], 32);
                    const float t0a = h ? oa : Ap[0], t0h = h ? oh : Hp[0], t1a = h ? Ap[0] : oa, t1h = h ? Hp[0] : oh;
                    const float hin0 = t1a * hc + t1h; hin = h ? hc : hin0; hc = t0a * hin0 + t0h;
                }
                LAS unsigned char* hp = lds + H_OFF + wd * H_BYTES + (32 * blk + 16 * h) * H_STRIDE + chl_l * 2;
#pragma unroll
                for (int i = 0; i < 16; i += 2) { const f32x2 hv = (f32x2){Ap[i], Ap[i + 1]} * hin + (f32x2){Hp[i], Hp[i + 1]}; const unsigned w = cvtpk(hv.x, hv.y);
                    *(LAS unsigned short*)(hp + i * H_STRIDE) = (unsigned short)w; *(LAS unsigned short*)(hp + (i + 1) * H_STRIDE) = (unsigned short)(w >> 16); }
            }
        }
        LQ(21); LP(22);
        asm volatile("s_waitcnt vmcnt(0)" ::: "memory");
        LQ(22); LP(24);
        __syncthreads();
        LQ(24); LP(23);
        {
            const LAS unsigned char* hb = lds + H_OFF + fd * H_BYTES;
#pragma unroll
            for (int j = 0; j < 4; ++j) { const int id = (tid & 255) + 256 * j; v4u hw = *(const LAS v4u*)(hb + (id >> 4) * H_STRIDE + (id & 15) * 16);
                if (!first_half) { const v4u p = pr[j];
                    hw.x = cvtpk(bflo(hw.x) + bflo(p.x), bfhi(hw.x) + bfhi(p.x)); hw.y = cvtpk(bflo(hw.y) + bflo(p.y), bfhi(hw.y) + bfhi(p.y));
                    hw.z = cvtpk(bflo(hw.z) + bflo(p.z), bfhi(hw.z) + bfhi(p.z)); hw.w = cvtpk(bflo(hw.w) + bflo(p.w), bfhi(hw.w) + bfhi(p.w)); }
                *(v4u*)(fbase + (size_t)(id >> 4) * LW + (id & 15) * 8) = hw; }
        }
        __builtin_amdgcn_sched_barrier(0);
        if (s + 1 < S) LRU_CONV_WRITE(cg_l, run_l);
        if (s == S / 2 - 1) asm volatile("s_waitcnt vmcnt(0)" ::: "memory");
        LQ(23); LP(25);
        __syncthreads();
        LQ(25);
    }
    asm volatile("s_waitcnt vmcnt(0)" ::: "memory");
#undef LRU_LOAD7
#undef LRU_CONV_WRITE
#undef LP
#undef LQ
}
#endif

#define XB_TMO      128
#define XB_XCNT(j)  (256  + 64 * (j))
#define XB_XSUB(j)  (1280 + 64 * (j))
#define XB_XGEN(j)  (2304 + 64 * (j))
#define XB_TOP      3328
#define XB_TOPGEN   3392
#define XCD_BAR_WORDS 3456
#define XB_SPIN_CAP (1u << 18)

__device__ __forceinline__ unsigned xb_ld(unsigned* p)              { return __hip_atomic_load(p, __ATOMIC_RELAXED, __HIP_MEMORY_SCOPE_AGENT); }
__device__ __forceinline__ unsigned xb_add(unsigned* p, unsigned v) { return __hip_atomic_fetch_add(p, v, __ATOMIC_RELAXED, __HIP_MEMORY_SCOPE_AGENT); }
__device__ __forceinline__ unsigned xb_xcc_id() { return (unsigned)__builtin_amdgcn_s_getreg((3 << 11) | 20) & 0xFu; }
#define XB_SPIN(cond, bar) do { unsigned _sp = 0; while (cond) { __builtin_amdgcn_s_sleep(1); \
    if ((++_sp & 255u) == 0u) { if (xb_ld(&(bar)[XB_TMO])) break; if (_sp > XB_SPIN_CAP) { atomicAdd(&(bar)[XB_TMO], 1u); break; } } } } while (0)

struct XcdBarrier {
    unsigned* bar; unsigned x;
    volatile LAS unsigned* st;
};

__device__ __forceinline__ XcdBarrier xcd_barrier_post(unsigned* bar, volatile LAS unsigned* st) {
    XcdBarrier b; b.bar = bar; b.x = xb_xcc_id(); b.st = st;
    if (threadIdx.x == 0) (void)xb_add(&bar[XB_XCNT(b.x)], 1u);
    return b;
}
__device__ __forceinline__ void xcd_barrier_complete(unsigned* bar, unsigned x, unsigned& nloc, unsigned& nx) {
    const unsigned G = gridDim.x * gridDim.y * gridDim.z;
    unsigned sum, cnt, mine, sp = 0u;
    for (;;) {
        sum = 0u; cnt = 0u; mine = 0u;
#pragma unroll
        for (unsigned j = 0; j < 16; ++j) { const unsigned c = xb_ld(&bar[XB_XCNT(j)]); sum += c; cnt += (c > 0u) ? 1u : 0u; mine = (j == x) ? c : mine; }
        if (sum == G) break;
        __builtin_amdgcn_s_sleep(1);
        if ((++sp & 255u) == 0u) { if (xb_ld(&bar[XB_TMO])) break; if (sp > XB_SPIN_CAP) { atomicAdd(&bar[XB_TMO], 1u); break; } }
    }
    nloc = mine > 0u ? mine : 1u; nx = cnt > 0u ? cnt : 1u;
}

__device__ __forceinline__ void xcd_barrier(const XcdBarrier& b) {
    asm volatile("s_waitcnt vmcnt(0)" ::: "memory");
    __syncthreads();
    if (threadIdx.x == 0) {
        unsigned* bar = b.bar;
        __builtin_amdgcn_s_waitcnt(0);
        unsigned nloc = b.st[0], nx = b.st[1];
        if (nloc == 0u) { xcd_barrier_complete(bar, b.x, nloc, nx); b.st[0] = nloc; b.st[1] = nx; }
        const unsigned old = xb_add(&bar[XB_XSUB(b.x)], 1u);
        const unsigned gen = old / nloc;
        if (old + 1u == (gen + 1u) * nloc) {
            __builtin_amdgcn_fence(__ATOMIC_RELEASE, "agent");
            asm volatile("s_waitcnt vmcnt(0)" ::: "memory");
            const unsigned og = xb_add(&bar[XB_TOP], 1u);
            const unsigned tg = og / nx;
            if (og + 1u == (tg + 1u) * nx) xb_add(&bar[XB_TOPGEN], 1u);
            else XB_SPIN(xb_ld(&bar[XB_TOPGEN]) == tg, bar);
            __builtin_amdgcn_fence(__ATOMIC_ACQUIRE, "agent");
            xb_add(&bar[XB_XGEN(b.x)], 1u);
            asm volatile("s_waitcnt vmcnt(0)" ::: "memory");
        } else {
            XB_SPIN(xb_ld(&bar[XB_XGEN(b.x)]) == gen, bar);
            __builtin_amdgcn_fence(__ATOMIC_ACQUIRE, "agent");
            asm volatile("s_waitcnt vmcnt(0)" ::: "memory");
        }
    }
    __syncthreads();
}

struct Args { const float* in[22]; float* out; unsigned char* ws; int ph_lo, ph_hi; };

__global__ void __launch_bounds__(NTHR, 2) mk_fwd(Args args) {
    extern __shared__ __attribute__((aligned(16))) unsigned char lds_raw[];
    LAS unsigned char* lds = (LAS unsigned char*)lds_raw;
    volatile LAS unsigned* MISC = (volatile LAS unsigned*)(lds + MISC_OFF);
    const int tid = threadIdx.x, lane = tid & 63, wave = __builtin_amdgcn_readfirstlane(tid >> 6);
    const int G = gridDim.x, bx = blockIdx.x;
    const int gw = bx * NWAVES + wave, NGW = G * NWAVES;
    unsigned char* ws = args.ws; unsigned char* dob = (unsigned char*)args.out;
    unsigned* ctl = (unsigned*)(ws + WS_CTL);
    const float* x = args.in[0]; const float* w_in = args.in[1]; const float* lru_conv_w = args.in[2]; const float* lru_conv_b = args.in[3];
    const float* lru_w_a = args.in[4]; const float* lru_b_a = args.in[5]; const float* lru_w_x = args.in[6]; const float* lru_b_x = args.in[7];
    const float* lru_lambda = args.in[8]; const float* w_lru_out = args.in[9]; const float* sc_conv_w = args.in[10]; const float* sc_conv_b = args.in[11];
    const float* w_conv_out = args.in[12]; const float* w_o = args.in[13]; const float* ln1_g = args.in[14]; const float* ln1_b = args.in[15];
    const float* mlp_w1 = args.in[16]; const float* mlp_b1 = args.in[17]; const float* mlp_w2 = args.in[18]; const float* mlp_b2 = args.in[19];
    const float* ln2_g = args.in[20]; const float* ln2_b = args.in[21];
    bf16* XB = (bf16*)(dob + DO_XB); bf16* WINT = (bf16*)(dob + DO_WINT); bf16* HS = (bf16*)(dob + DO_HS); float* OUTF = args.out;
    bf16* WG = (bf16*)(ws + WS_WG); bf16* WLO = (bf16*)(ws + WS_WLO); bf16* WCO = (bf16*)(ws + WS_WCO); bf16* WO = (bf16*)(ws + WS_WO); bf16* W1 = (bf16*)(ws + WS_W1); bf16* W2 = (bf16*)(ws + WS_W2);
    bf16* LX = (bf16*)(ws + WS_LX); bf16* SEC = (bf16*)(ws + WS_SEC); constexpr size_t SEC_ELEMS = SEC_BYTES / 2;
    bf16* CXR = SEC; bf16* CBZ = SEC + SEC_ELEMS; bf16* CCC = SEC + 2 * SEC_ELEMS; bf16* GL = SEC + 3 * SEC_ELEMS; bf16* GC = SEC + 4 * SEC_ELEMS;
    bf16* V1B = (bf16*)(dob + 0); bf16* FFB = (bf16*)(ws + WS_FF); bf16* H1B = (bf16*)(ws + WS_H1B);
    f32x2* ST1 = (f32x2*)(ws + WS_ST1); f32x2* ST2 = (f32x2*)(ws + WS_ST2);

    const int lo = args.ph_lo, hi = args.ph_hi;
#if MK_ONE_LAUNCH
    cg::grid_group grid = cg::this_grid();
    if (tid < 32) MISC[tid] = 0u;
    __syncthreads();
    const XcdBarrier xbar = xcd_barrier_post(ctl + CW_BAR, MISC + 8);
#define SEAM(k) do { if (lo <= (k) && (k) + 1 < hi) { if ((k) == 0) grid.sync(); else xcd_barrier(xbar); } } while (0)
#else
#define SEAM(k) do { } while (0)
#endif
#define IN(k) (lo <= (k) && (k) < hi)
    unsigned long long pr_t0 = 0ull, pr_dt = 0ull;
#define PB(k) do { if (MK_PROBE == (k)) pr_t0 = __builtin_amdgcn_s_memrealtime(); } while (0)
#define PE(k) do { if (MK_PROBE == (k)) pr_dt = __builtin_amdgcn_s_memrealtime() - pr_t0; } while (0)

    PB(0);
    if (IN(0)) {
        LAS float* scr = (LAS float*)(lds + wave * 8448);
        constexpr int I_IN = (DM / 64) * (INC / 32);
        constexpr int I_G = 2 * 2 * NH * 8;
        constexpr int NITEMS = I_IN + I_G;
        for (int it = gw; it < NITEMS; it += NGW) {
            int r = it;
            if (r < I_IN) { p0_transpose_item(w_in, DM, INC, WINT, scr, r, lane); continue; } r -= I_IN;
            { const int mat = r >> 3, sub = r & 7, gate = mat / (2 * NH), dh = mat % (2 * NH);
              const float* src = (gate ? lru_w_x : lru_w_a) + (size_t)dh * HD * HD;
              p0_transpose_item(src, HD, HD, WG + (size_t)mat * HD * HD, scr, sub, lane); }
        }
        for (int m = gw; m < MT; m += NGW) {
            const f32x4* xr = (const f32x4*)(x + (size_t)m * DM) + lane; v2u* o8 = (v2u*)(XB + (size_t)m * DM) + lane;
#pragma unroll
            for (int j = 0; j < 8; ++j) { const f32x4 v = xr[64 * j]; v2u w; w.x = cvtpk(v[0], v[1]); w.y = cvtpk(v[2], v[3]); o8[64 * j] = w; }
        }
    }
    SEAM(0); PE(0);
    PB(1);
    if (IN(1)) {
        pg8::Gemm g{XB, WINT, MT, INC, DM}; pg8::StaticOrder S; S.init(MT, INC, G, bx);
        pg8::EpiProj E{LX, SEC, SEC_ELEMS};
        pg8::gemm_phase<pg8::EpiProj, pg8::StaticOrder, true, true>(lds, g, S, E);
    }
    SEAM(1); PE(1);
    PB(2);
    if (IN(2)) {
#if MK_NAIVE_LRU
        if (bx < NB * NH) lru_naive_item(bx / NH, bx % NH, LX, lru_conv_w, lru_conv_b, lru_w_a, lru_b_a, lru_w_x, lru_b_x, lru_lambda, HS, (LAS float*)(lds), tid);
#else
        PB(20);
        if (bx < NB * NH) lru2_item(bx / NH, bx % NH, LX, lru_conv_w, lru_conv_b, WG, lru_b_a, lru_b_x, lru_lambda, HS, (const bf16*)(ctl + 256), lds, tid, lane, wave, pr_dt);
        PE(20);
#endif
        for (;;) {
            __syncthreads();
            if (tid == 0) MISC[0] = atomicAdd(ctl + CW_ZQ, 1u);
            __syncthreads();
            const int item = (int)MISC[0];
            constexpr int NZ = MT / 32;
            constexpr int I_LO = (LW / 64) * (DM / 32), I_CO = (CW / 64) * (DM / 32), I_O = (DM / 64) * (DM / 32), I_1 = (DM / 64) * (DFF / 32), I_2 = (DFF / 64) * (DM / 32);
            constexpr int NTB = (I_LO + I_CO + I_O + I_1 + I_2) / 8;
            if (item >= NZ + NTB) break;
            if (item < NZ) { z_item(item, CXR, CBZ, CCC, sc_conv_w, sc_conv_b, tid); continue; }
            { LAS float* scr = (LAS float*)(lds + wave * 8448); int r = (item - NZ) * 8 + wave;
              const float* Wsrc = w_lru_out; bf16* Wdst = WLO; int Kd = LW, Nd = DM;
              if (r >= I_LO) { r -= I_LO; Wsrc = w_conv_out; Wdst = WCO; Kd = CW;
                if (r >= I_CO) { r -= I_CO; Wsrc = w_o; Wdst = WO; Kd = DM;
                  if (r >= I_O) { r -= I_O; Wsrc = mlp_w1; Wdst = W1; Kd = DM; Nd = DFF;
                    if (r >= I_1) { r -= I_1; Wsrc = mlp_w2; Wdst = W2; Kd = DFF; Nd = DM; } } } }
              p0_transpose_item(Wsrc, Kd, Nd, Wdst, scr, r, lane); }
        }
        __syncthreads();
    }
    SEAM(2); PE(2);
    PB(3);
    if (IN(3)) {
        { pg8::Gemm g{HS, WLO, MT, DM, LW}; pg8::StaticOrder S; S.init(MT, DM, G, bx);
          pg8::EpiGate1 E{GL};
          pg8::gemm_phase<pg8::EpiGate1, pg8::StaticOrder, true, true>(lds, g, S, E); }
        __syncthreads();
        { pg8::Gemm g{CBZ, WCO, MT, DM, CW}; pg8::StaticOrder S; S.init(MT, DM, G, bx);
          pg8::EpiGate2 E{GC, GL};
          pg8::gemm_phase<pg8::EpiGate2, pg8::StaticOrder, true, true>(lds, g, S, E); }
    }
    SEAM(3); PE(3);
    PB(4);
    if (IN(4)) {
        pg8::Gemm g{GC, WO, MT, DM, DM}; pg8::StaticOrder S; S.init(MT, DM, G, bx);
        pg8::EpiResStats<false> E{x, V1B, nullptr, (pg8::f32x2*)ST1, ALPHA};
        pg8::gemm_phase<pg8::EpiResStats<false>, pg8::StaticOrder, true, true>(lds, g, S, E);
    }
    SEAM(4); PE(4);
    PB(5);
    if (IN(5)) {
        for (int m = gw; m < MT; m += NGW) ln_apply_row_bf(V1B + (size_t)m * DM, ST1 + (size_t)m * 32, ln1_g, ln1_b, H1B + (size_t)m * DM, lane);
    }
    SEAM(5); PE(5);
    PB(6);
    if (IN(6)) {
        pg8::Gemm g{H1B, W1, MT, DFF, DM}; pg8::StaticOrder S; S.init(MT, DFF, G, bx);
        pg8::EpiRelu2 E{FFB, DFF, mlp_b1};
        pg8::gemm_phase<pg8::EpiRelu2, pg8::StaticOrder, true, true>(lds, g, S, E);
    }
    SEAM(6); PE(6);
    PB(7);
    if (IN(7)) {
        pg8::Gemm g{FFB, W2, MT, DM, DFF}; pg8::StaticOrder S; S.init(MT, DM, G, bx);
        pg8::EpiResStats<true> E{H1B, OUTF, mlp_b2, (pg8::f32x2*)ST2, ALPHA};
        pg8::gemm_phase<pg8::EpiResStats<true>, pg8::StaticOrder, true, true>(lds, g, S, E);
    }
    SEAM(7); PE(7);
    PB(8);
    if (IN(8)) {
        for (int m = gw; m < MT; m += NGW) ln_apply_row(OUTF + (size_t)m * DM, ST2 + (size_t)m * 32, ln2_g, ln2_b, OUTF + (size_t)m * DM, lane);
    }
    PE(8);
    if (MK_PROBE >= 0 && bx == 0) { const unsigned long long t1 = __builtin_amdgcn_s_memrealtime(); while (__builtin_amdgcn_s_memrealtime() - t1 < 4ull * pr_dt) __builtin_amdgcn_s_sleep(8); }
#undef IN
#undef SEAM
}

extern "C" void kernel_launch(void* const* d_in, const int* in_sizes, int n_in, void* d_out, int out_size, void* d_ws, size_t ws_size, hipStream_t stream) {
    static int grid = 0;
    if (grid == 0) {
        if (n_in != 22 || in_sizes[0] != MT * DM || out_size != MT * DM || ws_size < WS_END) {
            fprintf(stderr, "kernel_launch: unexpected shapes (n_in %d, in0 %d, out %d, ws %zu; need ws >= %zu)\n", n_in, n_in > 0 ? in_sizes[0] : -1, out_size, ws_size, (size_t)WS_END); grid = -1; return; }
        int dev = 0, cus = 0, per_cu = 0;
        if (hipGetDevice(&dev) != hipSuccess || hipDeviceGetAttribute(&cus, hipDeviceAttributeMultiprocessorCount, dev) != hipSuccess) { grid = -1; return; }
        if (hipFuncSetAttribute((const void*)mk_fwd, hipFuncAttributeMaxDynamicSharedMemorySize, LDS_BYTES) != hipSuccess) { fprintf(stderr, "kernel_launch: hipFuncSetAttribute failed\n"); grid = -1; return; }
        if (hipOccupancyMaxActiveBlocksPerMultiprocessor(&per_cu, (const void*)mk_fwd, NTHR, LDS_BYTES) != hipSuccess || per_cu < 1) { fprintf(stderr, "kernel_launch: occupancy query says %d blocks/CU\n", per_cu); (void)hipGetLastError(); grid = -1; return; }
        grid = cus * 1;
        fprintf(stderr, "kernel_launch: %d CUs, occupancy %d blocks/CU, grid %d\n", cus, per_cu, grid);
    }
    if (grid < 0) return;
    (void)hipMemsetAsync((char*)d_ws + WS_CTL, 0, CTL_BYTES, stream);
    Args a{};
    for (int i = 0; i < 22; ++i) a.in[i] = (const float*)d_in[i];
    a.out = (float*)d_out; a.ws = (unsigned char*)d_ws;
#if MK_ONE_LAUNCH
    a.ph_lo = 0; a.ph_hi = NPHASE;
    void* kargs[] = {&a};
    hipError_t e = hipLaunchCooperativeKernel((const void*)mk_fwd, dim3(grid), dim3(NTHR), kargs, LDS_BYTES, stream);
    if (e != hipSuccess) fprintf(stderr, "kernel_launch: cooperative launch failed: %s (grid %d)\n", hipGetErrorString(e), grid);
#else
    for (int p = 0; p < NPHASE; ++p) { a.ph_lo = p; a.ph_hi = p + 1; hipLaunchKernelGGL(mk_fwd, dim3(grid), dim3(NTHR), LDS_BYTES, stream, a); }
#endif
}
```
